# Optimizing an MI355X kernel written in HIP

```python
import jax, jax.numpy as jnp
from jax import lax
import numpy as np

D_MODEL = 1024
BATCH = 4
SEQ = 8192
DEPTH = 4

GRID_W = 64
CTX_LEN = 256
HEAD_DIM = 64
A_HEADS = 8
A_KV_HEADS = 2
A_GROUP = A_HEADS // A_KV_HEADS
B_HEADS = 4
C_CHANNELS = 256
CONV_WIDTH = 31
NA_WIN_ROWS = 8
NA_WIN_COLS = 16
Q_BLOCK = 128
N_EXPERTS = 16
EXPERT_DIM = 2048
CAPACITY_FACTOR = 2
ROPE_THETA = 10000.0
EPS = 1e-6
A_WIDTH = A_HEADS * HEAD_DIM
A_KV_WIDTH = A_KV_HEADS * HEAD_DIM
B_WIDTH = B_HEADS * HEAD_DIM
MIX_WIDTH = A_WIDTH + B_WIDTH + C_CHANNELS
IN_WIDTH = A_WIDTH + 2 * A_KV_WIDTH + 3 * B_WIDTH + 2 * C_CHANNELS

kernel_name = "hybrid_gqa_natten_conformer_ecmoe_dit"


def rms_norm(x, g):
    xf = x.astype(jnp.float32)
    y = xf * lax.rsqrt(jnp.mean(xf * xf, axis=-1, keepdims=True) + EPS)
    return (y * g.astype(jnp.float32)).astype(x.dtype)


def layer_norm(x, g, b):
    xf = x.astype(jnp.float32)
    mu = jnp.mean(xf, axis=-1, keepdims=True)
    var = jnp.mean(jnp.square(xf - mu), axis=-1, keepdims=True)
    y = (xf - mu) * lax.rsqrt(var + EPS)
    return (y * g.astype(jnp.float32) + b.astype(jnp.float32)).astype(x.dtype)


def modulate(h, shift, scale):
    return h * (1 + scale) + shift


def rope_axis(x, pos):
    half = x.shape[-1] // 2
    inv = ROPE_THETA ** (-jnp.arange(half, dtype=jnp.float32) / half)
    ang = pos.astype(jnp.float32)[:, None] * inv[None, :]
    cos = jnp.cos(ang)[:, None, :]
    sin = jnp.sin(ang)[:, None, :]
    xf = x.astype(jnp.float32)
    x1, x2 = xf[..., :half], xf[..., half:]
    return jnp.concatenate([x1 * cos - x2 * sin, x2 * cos + x1 * sin], axis=-1).astype(x.dtype)


def rope_2d(x, pos_row, pos_col):
    h = x.shape[-1] // 2
    return jnp.concatenate([rope_axis(x[..., :h], pos_row), rope_axis(x[..., h:], pos_col)], axis=-1)


def gqa_attend(q, k, v):
    b, nq = q.shape[0], q.shape[1]
    s = jnp.einsum('bqkgd,btkd->bkgqt', q, k).astype(jnp.float32) * (q.shape[-1] ** -0.5)
    p = jax.nn.softmax(s, axis=-1).astype(v.dtype)
    o = jnp.einsum('bkgqt,btkd->bqkgd', p, v)
    return o.reshape(b, nq, -1)


def axial_gqa_mixer(qa_l, ka_l, va_l, qa_c, ka_c, va_c, q_norm_g, k_norm_g, pos_row, pos_col, ctx_queries):
    b, n, _ = qa_l.shape
    nc = ka_c.shape[1]
    q_l = rope_2d(rms_norm(qa_l.reshape(b, n, A_HEADS, HEAD_DIM), q_norm_g), pos_row, pos_col)
    k_l = rope_2d(rms_norm(ka_l.reshape(b, n, A_KV_HEADS, HEAD_DIM), k_norm_g), pos_row, pos_col)
    v_l = va_l.reshape(b, n, A_KV_HEADS, HEAD_DIM)
    k_c = rms_norm(ka_c.reshape(b, nc, A_KV_HEADS, HEAD_DIM), k_norm_g)
    v_c = va_c.reshape(b, nc, A_KV_HEADS, HEAD_DIM)
    k_all = jnp.concatenate([k_c, k_l], axis=1)
    v_all = jnp.concatenate([v_c, v_l], axis=1)
    q_blocks = jnp.moveaxis(q_l.reshape(b, n // Q_BLOCK, Q_BLOCK, A_KV_HEADS, A_GROUP, HEAD_DIM), 1, 0)
    out = lax.map(lambda qb: gqa_attend(qb, k_all, v_all), q_blocks)
    a_lat = jnp.moveaxis(out, 0, 1).reshape(b, n, A_WIDTH)
    a_ctx = None
    if ctx_queries:
        q_c = rms_norm(qa_c.reshape(b, nc, A_HEADS, HEAD_DIM), q_norm_g)
        a_ctx = gqa_attend(q_c.reshape(b, nc, A_KV_HEADS, A_GROUP, HEAD_DIM), k_c, v_c)
    return a_lat, a_ctx


def neighbourhood_mixer(qb_l, kb_l, vb_l, qb_c, kb_c, vb_c, rpb, ctx_queries):
    b, n, _ = qb_l.shape
    nc = kb_c.shape[1]
    rows = n // GRID_W
    wr = min(NA_WIN_ROWS, rows)
    wc = NA_WIN_COLS
    scale = HEAD_DIM ** -0.5
    qg = qb_l.reshape(b, rows, GRID_W, B_HEADS, HEAD_DIM)
    kg = kb_l.reshape(b, rows, GRID_W, B_HEADS, HEAD_DIM)
    vg = vb_l.reshape(b, rows, GRID_W, B_HEADS, HEAD_DIM)
    k_c = kb_c.reshape(b, nc, B_HEADS, HEAD_DIM)
    v_c = vb_c.reshape(b, nc, B_HEADS, HEAD_DIM)
    col = jnp.arange(GRID_W)
    col_start = jnp.clip(col - wc // 2, 0, GRID_W - wc)
    col_idx = col_start[:, None] + jnp.arange(wc)[None, :]
    dc = col_idx - col[:, None] + (NA_WIN_COLS - 1)

    def row_block(args):
        r, q_row = args
        rs = jnp.clip(r - wr // 2, 0, rows - wr)
        k_rows = lax.dynamic_slice_in_dim(kg, rs, wr, axis=1)
        v_rows = lax.dynamic_slice_in_dim(vg, rs, wr, axis=1)
        k_nb = k_rows[:, :, col_idx]
        v_nb = v_rows[:, :, col_idx]
        dr = rs + jnp.arange(wr) - r + (NA_WIN_ROWS - 1)
        bias = rpb[:, dr[None, :, None], dc[:, None, :]].astype(jnp.float32)
        s_nb = jnp.einsum('bqhd,bwqjhd->bhqwj', q_row, k_nb).astype(jnp.float32) * scale + bias[None]
        s_nb = s_nb.reshape(b, B_HEADS, GRID_W, wr * wc)
        s_cx = jnp.einsum('bqhd,bchd->bhqc', q_row, k_c).astype(jnp.float32) * scale
        p = jax.nn.softmax(jnp.concatenate([s_nb, s_cx], axis=-1), axis=-1).astype(v_c.dtype)
        p_nb = p[..., :wr * wc].reshape(b, B_HEADS, GRID_W, wr, wc)
        p_cx = p[..., wr * wc:]
        return (jnp.einsum('bhqwj,bwqjhd->bqhd', p_nb, v_nb)
                + jnp.einsum('bhqc,bchd->bqhd', p_cx, v_c))

    out = lax.map(row_block, (jnp.arange(rows), jnp.moveaxis(qg, 1, 0)))
    b_lat = jnp.moveaxis(out, 0, 1).reshape(b, n, B_WIDTH)
    b_ctx = None
    if ctx_queries:
        q_c = qb_c.reshape(b, nc, B_HEADS, 1, HEAD_DIM)
        b_ctx = gqa_attend(q_c, k_c, v_c)
    return b_lat, b_ctx


def conformer_conv(val, gate, conv_w, conv_b, ln_g, ln_b):
    u = val * jax.nn.sigmoid(gate)
    y = lax.conv_general_dilated(
        u, conv_w[:, None, :].astype(u.dtype), window_strides=(1,),
        padding=[(CONV_WIDTH // 2, CONV_WIDTH // 2)],
        dimension_numbers=('NWC', 'WIO', 'NWC'), feature_group_count=C_CHANNELS)
    y = y + conv_b
    return jax.nn.silu(layer_norm(y, ln_g, ln_b))


def expert_choice_moe(h, w_router, w_gate, w_up, w_down):
    b, n, d = h.shape
    cap = CAPACITY_FACTOR * n // N_EXPERTS
    aff = jax.nn.softmax(jnp.einsum('bnd,de->bne', h, w_router).astype(jnp.float32), axis=-1)
    gate, idx = lax.top_k(jnp.swapaxes(aff, 1, 2), cap)

    def one_expert(args):
        wg, wu, wd, idx_e, gate_e = args
        xe = jax.vmap(lambda hb, ib: hb[ib])(h, idx_e)
        ye = (jax.nn.silu(xe @ wg) * (xe @ wu)) @ wd
        return ye * gate_e[..., None].astype(ye.dtype)

    y = lax.map(one_expert, (w_gate, w_up, w_down, jnp.swapaxes(idx, 0, 1), jnp.swapaxes(gate, 0, 1)))
    y = jnp.swapaxes(y, 0, 1).reshape(b, N_EXPERTS * cap, d)
    idx_flat = idx.reshape(b, N_EXPERTS * cap)
    return jax.vmap(lambda yb, ib: jnp.zeros((n, d), yb.dtype).at[ib].add(yb))(y, idx_flat)


def split_in_proj(p):
    sizes = (A_WIDTH, A_KV_WIDTH, A_KV_WIDTH, B_WIDTH, B_WIDTH, B_WIDTH, C_CHANNELS, C_CHANNELS)
    offsets = [int(v) for v in np.cumsum(sizes)[:-1]]
    return jnp.split(p, offsets, axis=-1)


def hybrid_layer(x_lat, x_ctx, mod_lat, mod_ctx, pos_row, pos_col, norm1_g, norm2_g, w_in, q_norm_g, k_norm_g,
                 na_rpb, conv_w, conv_b, conv_ln_g, conv_ln_b, w_out, w_router, w_gate, w_up, w_down, last):
    s1, sc1, g1, s2, sc2, g2 = jnp.split(mod_lat, 6, axis=-1)
    cs1, csc1, cg1, cs2, csc2, cg2 = jnp.split(mod_ctx, 6, axis=-1)
    ctx_queries = not last

    h_lat = modulate(rms_norm(x_lat, norm1_g), s1, sc1)
    h_ctx = modulate(rms_norm(x_ctx, norm1_g), cs1, csc1)
    qa_l, ka_l, va_l, qb_l, kb_l, vb_l, cv_l, cg_l = split_in_proj(h_lat @ w_in)
    qa_c, ka_c, va_c, qb_c, kb_c, vb_c, cv_c, cg_c = split_in_proj(h_ctx @ w_in)

    a_lat, a_ctx = axial_gqa_mixer(qa_l, ka_l, va_l, qa_c, ka_c, va_c, q_norm_g, k_norm_g,
                                   pos_row, pos_col, ctx_queries)
    b_lat, b_ctx = neighbourhood_mixer(qb_l, kb_l, vb_l, qb_c, kb_c, vb_c, na_rpb, ctx_queries)
    c_lat = conformer_conv(cv_l, cg_l, conv_w, conv_b, conv_ln_g, conv_ln_b)

    x_lat = x_lat + g1 * (jnp.concatenate([a_lat, b_lat, c_lat], axis=-1) @ w_out)
    h2 = modulate(rms_norm(x_lat, norm2_g), s2, sc2)
    x_lat = x_lat + g2 * expert_choice_moe(h2, w_router, w_gate, w_up, w_down)

    if ctx_queries:
        c_ctx_out = conformer_conv(cv_c, cg_c, conv_w, conv_b, conv_ln_g, conv_ln_b)
        x_ctx = x_ctx + cg1 * (jnp.concatenate([a_ctx, b_ctx, c_ctx_out], axis=-1) @ w_out)
        hc2 = modulate(rms_norm(x_ctx, norm2_g), cs2, csc2)
        x_ctx = x_ctx + cg2 * expert_choice_moe(hc2, w_router, w_gate, w_up, w_down)
    return x_lat, x_ctx


def setup_inputs(seed: int = 0) -> dict:
    key = jax.random.key(seed)
    ks = jax.random.split(key, 24)
    f32 = jnp.float32

    def nrm(k, shape, scale):
        return jax.random.normal(k, shape, f32) * scale

    d = D_MODEL
    return {
        "x": nrm(ks[0], (BATCH, SEQ, d), 1.0),
        "c": nrm(ks[1], (BATCH, d), 1.0),
        "ctx": nrm(ks[2], (BATCH, CTX_LEN, d), 1.0),
        "c_ctx": nrm(ks[3], (d,), 1.0),
        "w_ada": nrm(ks[4], (DEPTH, d, 6 * d), 0.5 * d ** -0.5),
        "b_ada": nrm(ks[5], (DEPTH, 6 * d), 0.02),
        "norm1_g": 1.0 + nrm(ks[6], (DEPTH, d), 0.05),
        "norm2_g": 1.0 + nrm(ks[7], (DEPTH, d), 0.05),
        "w_in": nrm(ks[8], (DEPTH, d, IN_WIDTH), d ** -0.5),
        "q_norm_g": 1.0 + nrm(ks[9], (DEPTH, HEAD_DIM), 0.05),
        "k_norm_g": 1.0 + nrm(ks[10], (DEPTH, HEAD_DIM), 0.05),
        "na_rpb": nrm(ks[11], (DEPTH, B_HEADS, 2 * NA_WIN_ROWS - 1, 2 * NA_WIN_COLS - 1), 0.1),
        "conv_w": nrm(ks[12], (DEPTH, CONV_WIDTH, C_CHANNELS), CONV_WIDTH ** -0.5),
        "conv_b": nrm(ks[13], (DEPTH, C_CHANNELS), 0.02),
        "conv_ln_g": 1.0 + nrm(ks[14], (DEPTH, C_CHANNELS), 0.05),
        "conv_ln_b": nrm(ks[15], (DEPTH, C_CHANNELS), 0.02),
        "w_out": nrm(ks[16], (DEPTH, MIX_WIDTH, d), MIX_WIDTH ** -0.5),
        "w_router": nrm(ks[17], (DEPTH, d, N_EXPERTS), d ** -0.5),
        "w_gate": nrm(ks[18], (DEPTH, N_EXPERTS, d, EXPERT_DIM), d ** -0.5),
        "w_up": nrm(ks[19], (DEPTH, N_EXPERTS, d, EXPERT_DIM), d ** -0.5),
        "w_down": nrm(ks[20], (DEPTH, N_EXPERTS, EXPERT_DIM, d), EXPERT_DIM ** -0.5),
        "final_norm_g": 1.0 + nrm(ks[21], (d,), 0.05),
    }


def reference(x, c, ctx, c_ctx, w_ada, b_ada, norm1_g, norm2_g, w_in, q_norm_g, k_norm_g, na_rpb,
              conv_w, conv_b, conv_ln_g, conv_ln_b, w_out, w_router, w_gate, w_up, w_down, final_norm_g):
    n = x.shape[1]
    t = jnp.arange(n)
    pos_row = t // GRID_W
    pos_col = t % GRID_W
    silu_c = jax.nn.silu(c)
    silu_cc = jax.nn.silu(c_ctx)
    x_lat, x_ctx = x, ctx
    for i in range(DEPTH):
        mod_lat = (silu_c @ w_ada[i] + b_ada[i])[:, None, :]
        mod_ctx = (silu_cc @ w_ada[i] + b_ada[i])[None, None, :]
        x_lat, x_ctx = hybrid_layer(
            x_lat, x_ctx, mod_lat, mod_ctx, pos_row, pos_col, norm1_g[i], norm2_g[i], w_in[i],
            q_norm_g[i], k_norm_g[i], na_rpb[i], conv_w[i], conv_b[i], conv_ln_g[i], conv_ln_b[i],
            w_out[i], w_router[i], w_gate[i], w_up[i], w_down[i], i == DEPTH - 1)
    return rms_norm(x_lat, final_norm_g)
```

```cpp
#include <hip/hip_runtime.h>
#include <cstdio>
#include <cstdint>
namespace pg8 {
#define PG8_LAS __attribute__((address_space(3)))
typedef unsigned short bf16_t;
typedef short bf16x8 __attribute__((ext_vector_type(8)));
typedef float f32x4 __attribute__((ext_vector_type(4)));
typedef unsigned u32x4 __attribute__((ext_vector_type(4)));
constexpr int BM = 256, BK = 64, HALF = 128, HTB = HALF * BK * 2  , STAGE_BYTES = 8 * HTB, NXCD = 8, WGM = 8;

__host__ __device__ __forceinline__ int lds_byte(int r, int c) { const int st = (r >> 4) * 2 + (c >> 5), rr = r & 15, cc = c & 31, ob = rr * 64 + cc * 2; return st * 1024 + (ob ^ (((ob >> 9) & 1) << 5)); }
__host__ __device__ __forceinline__ void stage_rc(int b, int& R, int& C) { const int st = b / 1024, sb = b % 1024, swz = sb ^ (((sb >> 9) & 1) << 5); R = (st >> 1) * 16 + swz / 64; C = (st & 1) * 32 + (swz % 64) / 2; }
__host__ __device__ __forceinline__ int perm32(int rho) { const int n = rho >> 4, i = rho & 15; return 8 * (i >> 2) + 4 * n + (i & 3); }

struct Unit { int pm, pn, pb; };
struct Gemm { const bf16_t* A; const bf16_t* Bt; int M, N, K; };

struct StaticOrder {
    int nM, nN, nwg, G, c, tpg;
    __host__ __device__ void init(int M, int N, int G_, int c_, int tpg_ = 0) { nM = M / BM; nN = N / BM; nwg = nM * nN; G = G_; c = c_; tpg = tpg_; }
    __host__ __device__ bool next(int i, Unit& u) const {
        const long L = (long)i * G + c; if (L >= nwg) return false;
        int wgid = (int)L; { const int q = nwg / NXCD, r = nwg % NXCD, xcd = wgid % NXCD, off = wgid / NXCD; wgid = (xcd < r ? xcd * (q + 1) : r * (q + 1) + (xcd - r) * q) + off; }
        const int nig = WGM * nN, gid = wgid / nig, fm = gid * WGM, gsz = (nM - fm) < WGM ? (nM - fm) : WGM;
        u.pm = fm + ((wgid % nig) % gsz); u.pn = (wgid % nig) / gsz; u.pb = tpg ? (u.pm / tpg) * nN + u.pn : u.pn; return true;
    }
    __device__ __forceinline__ void a_ready(const Unit&) const {}
    __device__ __forceinline__ void done(const Unit&) const {}
};

__device__ __forceinline__ unsigned cvt_pk_bf16(float lo, float hi) { unsigned r; asm volatile("v_cvt_pk_bf16_f32 %0, %1, %2" : "=v"(r) : "v"(lo), "v"(hi)); return r; }
typedef float f32x2 __attribute__((ext_vector_type(2)));
__device__ __forceinline__ f32x2 gelu_pk(f32x2 v) {
    const f32x2 av = __builtin_elementwise_abs(v), d = av * 0.2316418882f + 1.0f;
    f32x2 t; t.x = __builtin_amdgcn_rcpf(d.x); t.y = __builtin_amdgcn_rcpf(d.y);
    f32x2 q = t * 0.5307027145f + (-0.7265760135f); q = q * t + 0.7107068705f; q = q * t + (-0.142248368f); q = q * t + 0.127414796f; q = q * t;
    const f32x2 s = (v * v) * (-0.72134752044f);
    f32x2 e; e.x = __builtin_amdgcn_exp2f(s.x); e.y = __builtin_amdgcn_exp2f(s.y);
    const f32x2 m = v * (q * e), r = v - m;
    f32x2 o; o.x = v.x < 0.f ? m.x : r.x; o.y = v.y < 0.f ? m.y : r.y; return o;
}

template <int ACT  > struct EpiBf16 {
    static constexpr bool PERM = true, AFTER_DRAIN = false; static_assert(ACT == 0 || ACT == 1, "EpiBf16: ACT is 0 (none) or 1 (gelu_pk)");
    bf16_t* O; int ldc; const float* bias; int split_cols; size_t split_stride; float scale0;
    __device__ __forceinline__ void operator()(const f32x4 (&acc)[2][2][4][2], const Unit& u, int wr, int wc, int fr, int fq) const {
        const int row0 = u.pm * BM + wr * 64 + fr; int colt = u.pn * BM; bf16_t* base = O;
        float sc = 1.f; if (split_cols) { const int t = colt / split_cols; base += (size_t)t * split_stride; colt -= t * split_cols; if (t == 0) sc = scale0; }
        const int col0 = colt + wc * 32 + 8 * fq, bcol0 = u.pn * BM + wc * 32 + 8 * fq;
        f32x4 bv[2][2];
#pragma unroll
        for (int bj = 0; bj < 2; ++bj)
#pragma unroll
            for (int n = 0; n < 2; ++n) bv[bj][n] = bias ? *(const f32x4*)(bias + bcol0 + bj * HALF + 4 * n) : (f32x4){0.f, 0.f, 0.f, 0.f};
#pragma unroll
        for (int ai = 0; ai < 2; ++ai)
#pragma unroll
            for (int m = 0; m < 4; ++m) { bf16_t* rowp = base + (size_t)(row0 + ai * HALF + m * 16) * ldc + col0;
#pragma unroll
                for (int bj = 0; bj < 2; ++bj) { f32x4 v0 = acc[ai][bj][m][0] + bv[bj][0], v1 = acc[ai][bj][m][1] + bv[bj][1];
                    if (ACT == 1) { f32x2 a = gelu_pk((f32x2){v0[0], v0[1]}), b = gelu_pk((f32x2){v0[2], v0[3]}), c = gelu_pk((f32x2){v1[0], v1[1]}), d = gelu_pk((f32x2){v1[2], v1[3]});
                        v0 = (f32x4){a.x, a.y, b.x, b.y}; v1 = (f32x4){c.x, c.y, d.x, d.y}; }
                    v0 = v0 * sc; v1 = v1 * sc; u32x4 w; w.x = cvt_pk_bf16(v0[0], v0[1]); w.y = cvt_pk_bf16(v0[2], v0[3]); w.z = cvt_pk_bf16(v1[0], v1[1]); w.w = cvt_pk_bf16(v1[2], v1[3]);
                    *(u32x4*)(rowp + bj * HALF) = w; } }
    }
};


struct EpiResGate {
    static constexpr bool PERM = false, AFTER_DRAIN = false;
    float* X; int ldc; const float* gates; int q;
    __device__ __forceinline__ void operator()(const f32x4 (&acc)[2][2][4][2], const Unit& u, int wr, int wc, int fr, int fq) const {
        const int b = u.pm / 33, s = (u.pm % 33 == 0) ? 4 : b;
        const float* gv = gates + (size_t)(s * 6 + q) * 1024;
        const int col0 = u.pn * BM + wc * 32 + 4 * fq;
        f32x4 g[2][2];
#pragma unroll
        for (int bj = 0; bj < 2; ++bj)
#pragma unroll
            for (int n = 0; n < 2; ++n) g[bj][n] = *(const f32x4*)(gv + col0 + bj * HALF + n * 16);
#pragma unroll
        for (int ai = 0; ai < 2; ++ai)
#pragma unroll
            for (int m = 0; m < 4; ++m) { float* rowp = X + (size_t)(u.pm * BM + ai * HALF + wr * 64 + m * 16 + fr) * ldc + col0;
#pragma unroll
                for (int bj = 0; bj < 2; ++bj)
#pragma unroll
                    for (int n = 0; n < 2; ++n) { f32x4* p = (f32x4*)(rowp + bj * HALF + n * 16); f32x4 v = *p; v = v + g[bj][n] * acc[ai][bj][m][n]; *p = v; }
                if (m & 1) asm volatile("" ::: "memory"); }
    }
};
struct EpiSwiGLU {
    static constexpr bool PERM = true, AFTER_DRAIN = false;
    bf16_t* O; int ldc;
    __device__ __forceinline__ static float swi(float g, float u) { const float e = __builtin_amdgcn_exp2f(-1.4426950408889634f * g); return g * __builtin_amdgcn_rcpf(1.0f + e) * u; }
    __device__ __forceinline__ void operator()(const f32x4 (&acc)[2][2][4][2], const Unit& u, int wr, int wc, int fr, int fq) const {
        const int row0 = u.pm * BM + wr * 64 + fr, col0 = u.pn * HALF + wc * 32 + 8 * fq;
#pragma unroll
        for (int ai = 0; ai < 2; ++ai)
#pragma unroll
            for (int m = 0; m < 4; ++m) { bf16_t* rowp = O + (size_t)(row0 + ai * HALF + m * 16) * ldc + col0;
                const f32x4 g0 = acc[ai][0][m][0], g1 = acc[ai][0][m][1], u0 = acc[ai][1][m][0], u1 = acc[ai][1][m][1];
                u32x4 w; w.x = cvt_pk_bf16(swi(g0[0], u0[0]), swi(g0[1], u0[1])); w.y = cvt_pk_bf16(swi(g0[2], u0[2]), swi(g0[3], u0[3]));
                w.z = cvt_pk_bf16(swi(g1[0], u1[0]), swi(g1[1], u1[1])); w.w = cvt_pk_bf16(swi(g1[2], u1[2]), swi(g1[3], u1[3]));
                *(u32x4*)rowp = w; }
    }
};
template <class Epi, class Sched, bool ALIGN_EPI = false, bool SP2 = false>
__device__ __forceinline__ void gemm_phase(PG8_LAS unsigned char* lds, const Gemm g, const Sched& S, const Epi& E) {
    int tid_ = threadIdx.x; asm volatile("" : "+v"(tid_));
    const int tid = tid_, wid = __builtin_amdgcn_readfirstlane(tid >> 6), lane = tid & 63, wr = wid >> 2, wc = wid & 3, fr = lane & 15, fq = lane >> 4;
    const int K = g.K, nt = K / BK;
    unsigned voffA[2], voffB[2];
#pragma unroll
    for (int i = 0; i < 2; ++i) { int R, C; stage_rc(tid * 16 + i * 8192, R, C); const int Rb = Epi::PERM ? ((R & ~31) + perm32(R & 31)) : R;
        voffA[i] = (unsigned)(R * K + C) * 2u; voffB[i] = (unsigned)(Rb * K + C) * 2u; }
    const size_t kstep = (size_t)(BK * 2);
    const size_t hstep = (size_t)HALF * K * 2;
    const size_t tstep = 2 * hstep;
    const unsigned ldsw = (unsigned)wid * 1024u;
    const int aoff = lds_byte(wr * 64 + fr, fq * 8), boff = lds_byte(wc * 32 + fr, fq * 8);
#define PG8_SA(b, h) (((b) * 2 + (h)) * HTB)
#define PG8_SB(b, h) ((4 + (b) * 2 + (h)) * HTB)
#define PG8_STAGE(bufoff, gbase, voff) do { _Pragma("unroll") for (int _i = 0; _i < 2; ++_i) \
        __builtin_amdgcn_global_load_lds((const unsigned*)((const char*)(gbase) + (voff)[_i]), (PG8_LAS unsigned*)(lds + (bufoff) + ldsw + _i * 8192), 16, 0, 0); } while (0)
#define PG8_LDA(dst, b, h) do { _Pragma("unroll") for (int m = 0; m < 4; ++m) _Pragma("unroll") for (int k = 0; k < 2; ++k) dst[m][k] = *(const PG8_LAS bf16x8*)(lds + PG8_SA(b, h) + aoff + m * 2048 + k * 1024); } while (0)
#define PG8_LDB(dst, b, h) do { _Pragma("unroll") for (int n = 0; n < 2; ++n) _Pragma("unroll") for (int k = 0; k < 2; ++k) dst[n][k] = *(const PG8_LAS bf16x8*)(lds + PG8_SB(b, h) + boff + n * 2048 + k * 1024); } while (0)
#define PG8_MMA(ai, bj, At, Bt) do { __builtin_amdgcn_s_setprio(1); _Pragma("unroll") for (int m = 0; m < 4; ++m) _Pragma("unroll") for (int n = 0; n < 2; ++n) _Pragma("unroll") for (int k = 0; k < 2; ++k) \
        acc[ai][bj][m][n] = __builtin_amdgcn_mfma_f32_16x16x32_bf16(Bt[n][k], At[m][k], acc[ai][bj][m][n], 0, 0, 0); __builtin_amdgcn_s_setprio(0); } while (0)
#define PG8_WAIT_V(n) asm volatile("s_waitcnt vmcnt(" #n ")" ::: "memory")
#define PG8_WAIT_L(n) asm volatile("s_waitcnt lgkmcnt(" #n ")" ::: "memory")
#define PG8_BAR __builtin_amdgcn_s_barrier()
#define PG8_SCHED __builtin_amdgcn_sched_barrier(0)
    Unit cur, nxt; int ui = 0;
    if (!S.next(0, cur)) return;
    f32x4 acc[2][2][4][2];
#pragma unroll
    for (int a = 0; a < 2; ++a)
#pragma unroll
        for (int b = 0; b < 2; ++b)
#pragma unroll
            for (int m = 0; m < 4; ++m)
#pragma unroll
                for (int n = 0; n < 2; ++n) acc[a][b][m][n] = (f32x4){0.f, 0.f, 0.f, 0.f};
    bf16x8 At[4][2], B0[2][2], B1[2][2];
    const char* cA = (const char*)g.A + (size_t)cur.pm * tstep; const char* cB = (const char*)g.Bt + (size_t)cur.pb * tstep;
    S.a_ready(cur);
    if constexpr (SP2) {
        PG8_STAGE(PG8_SB(0, 0), cB, voffB); PG8_STAGE(PG8_SB(0, 1), cB + hstep, voffB); PG8_STAGE(PG8_SA(0, 0), cA, voffA); PG8_STAGE(PG8_SA(0, 1), cA + hstep, voffA);
        if (wr == 1) PG8_BAR;
        PG8_WAIT_V(2); PG8_BAR;
        PG8_STAGE(PG8_SB(1, 0), cB + kstep, voffB); PG8_STAGE(PG8_SA(1, 0), cA + kstep, voffA); PG8_STAGE(PG8_SB(1, 1), cB + hstep + kstep, voffB);
        PG8_WAIT_V(6); PG8_BAR;
    } else {
        PG8_STAGE(PG8_SB(0, 0), cB, voffB); PG8_STAGE(PG8_SA(0, 0), cA, voffA); PG8_STAGE(PG8_SB(0, 1), cB + hstep, voffB); PG8_STAGE(PG8_SA(0, 1), cA + hstep, voffA);
        if (wr == 1) PG8_BAR;
        PG8_WAIT_V(4); PG8_BAR;
        PG8_STAGE(PG8_SB(1, 0), cB + kstep, voffB); PG8_STAGE(PG8_SA(1, 0), cA + kstep, voffA); PG8_STAGE(PG8_SB(1, 1), cB + hstep + kstep, voffB);
        PG8_WAIT_V(6); PG8_BAR;
    }
    for (;;) {
        const bool has_next = S.next(ui + 1, nxt);
        const char* nA = has_next ? (const char*)g.A + (size_t)nxt.pm * tstep : cA; const char* nB = has_next ? (const char*)g.Bt + (size_t)nxt.pb * tstep : cB;
        for (int t = 0; t < nt; t += 2) {
            const bool last = (t == nt - 2);
            const char* a1 = cA + (size_t)(t + 1) * kstep;
            const char* a2 = last ? nA : cA + (size_t)(t + 2) * kstep; const char* b2 = last ? nB : cB + (size_t)(t + 2) * kstep;
            const char* a3 = a2 + kstep; const char* b3 = b2 + kstep;
            if (last && has_next) S.a_ready(nxt);
            if constexpr (SP2) {
            PG8_LDB(B0, 0, 0); PG8_LDB(B1, 0, 1); PG8_SCHED; PG8_LDA(At, 0, 0); PG8_STAGE(PG8_SA(1, 1), a1 + hstep, voffA);
            PG8_WAIT_V(8); PG8_WAIT_L(0); PG8_BAR; PG8_MMA(0, 0, At, B0); PG8_MMA(0, 1, At, B1); PG8_BAR; PG8_SCHED;
            PG8_LDA(At, 0, 1); PG8_STAGE(PG8_SB(0, 0), b2, voffB); PG8_STAGE(PG8_SB(0, 1), b2 + hstep, voffB); PG8_STAGE(PG8_SA(0, 0), a2, voffA);
            PG8_WAIT_V(8); PG8_WAIT_L(0); PG8_BAR; PG8_MMA(1, 0, At, B0); PG8_MMA(1, 1, At, B1); PG8_BAR; PG8_SCHED;
            PG8_LDB(B0, 1, 0); PG8_LDB(B1, 1, 1); PG8_SCHED; PG8_LDA(At, 1, 0); PG8_STAGE(PG8_SA(0, 1), a2 + hstep, voffA);
            PG8_WAIT_V(8); PG8_WAIT_L(0); PG8_BAR; PG8_MMA(0, 0, At, B0); PG8_MMA(0, 1, At, B1); PG8_BAR; PG8_SCHED;
            PG8_LDA(At, 1, 1); PG8_STAGE(PG8_SB(1, 0), b3, voffB); PG8_STAGE(PG8_SB(1, 1), b3 + hstep, voffB); PG8_STAGE(PG8_SA(1, 0), a3, voffA);
            PG8_WAIT_V(8); PG8_WAIT_L(0); PG8_BAR; PG8_MMA(1, 0, At, B0); PG8_MMA(1, 1, At, B1); PG8_BAR; PG8_SCHED;
            } else {
            PG8_LDB(B0, 0, 0); PG8_SCHED; PG8_LDA(At, 0, 0); PG8_STAGE(PG8_SA(1, 1), a1 + hstep, voffA);
            PG8_WAIT_L(8); PG8_BAR; PG8_WAIT_L(0); PG8_MMA(0, 0, At, B0); PG8_BAR; PG8_SCHED;
            PG8_LDB(B1, 0, 1); PG8_STAGE(PG8_SB(0, 0), b2, voffB);
            PG8_BAR; PG8_WAIT_L(0); PG8_MMA(0, 1, At, B1); PG8_BAR;
            PG8_LDA(At, 0, 1); PG8_STAGE(PG8_SA(0, 0), a2, voffA);
            PG8_BAR; PG8_WAIT_L(0); PG8_MMA(1, 0, At, B0); PG8_BAR; PG8_SCHED;
            PG8_STAGE(PG8_SB(0, 1), b2 + hstep, voffB);
            PG8_WAIT_V(6); PG8_BAR; PG8_MMA(1, 1, At, B1); PG8_BAR;
            PG8_LDB(B0, 1, 0); PG8_SCHED; PG8_LDA(At, 1, 0); PG8_STAGE(PG8_SA(0, 1), a2 + hstep, voffA);
            PG8_WAIT_L(8); PG8_BAR; PG8_WAIT_L(0); PG8_MMA(0, 0, At, B0); PG8_BAR; PG8_SCHED;
            PG8_LDB(B1, 1, 1); PG8_STAGE(PG8_SB(1, 0), b3, voffB);
            PG8_BAR; PG8_WAIT_L(0); PG8_MMA(0, 1, At, B1); PG8_BAR;
            PG8_LDA(At, 1, 1); PG8_STAGE(PG8_SA(1, 0), a3, voffA);
            PG8_BAR; PG8_WAIT_L(0); PG8_MMA(1, 0, At, B0); PG8_BAR; PG8_SCHED;
            PG8_STAGE(PG8_SB(1, 1), b3 + hstep, voffB);
            PG8_WAIT_V(6); PG8_BAR; PG8_MMA(1, 1, At, B1); PG8_BAR;
            }
        }
        if constexpr (ALIGN_EPI) { if (wr == 0) PG8_BAR; }
        if constexpr (!Epi::AFTER_DRAIN) { E(acc, cur, wr, wc, fr, fq); S.done(cur); }
        if (!has_next) break;
#pragma unroll
        for (int a = 0; a < 2; ++a)
#pragma unroll
            for (int b = 0; b < 2; ++b)
#pragma unroll
                for (int m = 0; m < 4; ++m)
#pragma unroll
                    for (int n = 0; n < 2; ++n) acc[a][b][m][n] = (f32x4){0.f, 0.f, 0.f, 0.f};
        cur = nxt; cA = nA; cB = nB; ++ui;
        if constexpr (ALIGN_EPI) { if (wr == 1) PG8_BAR; }
    }
    PG8_WAIT_V(0);
    if constexpr (!ALIGN_EPI) { if (wr == 0) PG8_BAR; }
    PG8_BAR;
    if constexpr (Epi::AFTER_DRAIN) { E.fused(acc, cur, wr, wc, fr, fq, lds, wid, lane); S.done(cur); }
#undef PG8_SA
#undef PG8_SB
#undef PG8_STAGE
#undef PG8_LDA
#undef PG8_LDB
#undef PG8_MMA
#undef PG8_WAIT_V
#undef PG8_WAIT_L
#undef PG8_BAR
#undef PG8_SCHED
}
}


#include <hip/hip_bf16.h>
#include <cmath>
namespace attn_body {
using bf16=__hip_bfloat16;
using bf16x8=__attribute__((ext_vector_type(8)))short;
using s16x4=__attribute__((ext_vector_type(4)))short;
using f32x16=__attribute__((ext_vector_type(16)))float;
using u32x4=__attribute__((ext_vector_type(4)))unsigned;
constexpr int D=64,KP=2048,OP=1024;
constexpr int NW=8,QBLK=32,QB=QBLK*NW,KVBLK=64;
__device__ __forceinline__ int crow(int r,int hi){return (r&3)+8*(r>>2)+4*hi;}
#define SBAR() __builtin_amdgcn_sched_barrier(0)
typedef __attribute__((address_space(3))) const float* lds_cfptr;
__device__ __forceinline__ void na_mask(f32x16&p0,f32x16&p1,bool rowok,int bidx,int d0,lds_cfptr tab){
  const float NEG=-INFINITY;
  if(!rowok){
    #pragma unroll
    for(int r=0;r<16;++r){p0[r]=NEG;p1[r]=NEG;}
  } else {
    #pragma unroll
    for(int r=0;r<16;++r){ const int c=(r&3)+8*(r>>2);
      const bool v0=(unsigned)(d0+c)<16u, v1=(unsigned)(d0+c+32)<16u;
      const float b0=tab[v0?bidx+c:0], b1=tab[v1?bidx+c+32:0];
      p0[r]=v0?p0[r]+b0:NEG; p1[r]=v1?p1[r]+b1:NEG; }
  }
}

constexpr int NSLOT=3, SLOTB=8192;
constexpr int LDS_K=0, LDS_V=NSLOT*SLOTB, LDS_WS=2*NSLOT*SLOTB, LDS_OST=LDS_WS+NW*64*4, LDS_BYTES=LDS_OST+NW*4096;
constexpr float C2=0.125f*1.4426950408889634f;
__device__ __forceinline__ void glds16(const void*gsrc,unsigned lds_dst){unsigned keep;
  asm volatile("s_mov_b32 %0, m0\n\ts_mov_b32 m0, %2\n\ts_nop 0\n\tglobal_load_lds_dwordx4 %1, off\n\ts_mov_b32 m0, %0":"=&s"(keep):"v"(gsrc),"s"(lds_dst):"memory");}
__device__ __forceinline__ float max3f(float a,float b,float c){float r;asm("v_max3_f32 %0, %1, %2, %3":"=v"(r):"v"(a),"v"(b),"v"(c));return r;}
__device__ __forceinline__ float max2f(float a,float b){float r;asm("v_max_f32_e32 %0, %1, %2":"=v"(r):"v"(a),"v"(b));return r;}
__device__ __forceinline__ float fadd_s(float a,float b){float r;asm("v_add_f32_e32 %0, %1, %2":"=v"(r):"v"(a),"v"(b));return r;}
__device__ __forceinline__ float fsub_s(float a,float b){float r;asm("v_sub_f32_e32 %0, %1, %2":"=v"(r):"v"(a),"v"(b));return r;}
typedef float f32x2_t __attribute__((ext_vector_type(2))); typedef __bf16 bf16x2_t __attribute__((ext_vector_type(2)));
__device__ __forceinline__ unsigned cvtpk_s(float lo,float hi){f32x2_t v={lo,hi};bf16x2_t b=__builtin_convertvector(v,bf16x2_t);return __builtin_bit_cast(unsigned,b);}
#define WAIT_BAR(N) asm volatile("s_waitcnt vmcnt(" #N ") lgkmcnt(0)\n\ts_barrier":::"memory")

__device__ __forceinline__ void qkt(f32x16&p0,f32x16&p1,const char*Kslot,const bf16x8*qr,const f32x16&negm,int r32,int hi){
  const char*kb=Kslot+hi*1024+r32*16;
  #pragma unroll
  for(int d0=0;d0<4;++d0){
    const bf16x8 b0=*reinterpret_cast<const bf16x8*>(kb+d0*2048);
    const bf16x8 b1=*reinterpret_cast<const bf16x8*>(kb+d0*2048+512);
    if(d0==0){p0=__builtin_amdgcn_mfma_f32_32x32x16_bf16(b0,qr[0],negm,0,0,0);p1=__builtin_amdgcn_mfma_f32_32x32x16_bf16(b1,qr[0],negm,0,0,0);}
    else{p0=__builtin_amdgcn_mfma_f32_32x32x16_bf16(b0,qr[d0],p0,0,0,0);p1=__builtin_amdgcn_mfma_f32_32x32x16_bf16(b1,qr[d0],p1,0,0,0);}}
}
typedef __attribute__((address_space(3))) const char* lds_cptr;
typedef short v4i16_t __attribute__((ext_vector_type(4)));
__device__ __forceinline__ void kload8(bf16x8*kf,lds_cptr kp){
  kf[0]=*(const __attribute__((address_space(3))) bf16x8*)(kp);      kf[1]=*(const __attribute__((address_space(3))) bf16x8*)(kp+512);
  kf[2]=*(const __attribute__((address_space(3))) bf16x8*)(kp+2048); kf[3]=*(const __attribute__((address_space(3))) bf16x8*)(kp+2560);
  kf[4]=*(const __attribute__((address_space(3))) bf16x8*)(kp+4096); kf[5]=*(const __attribute__((address_space(3))) bf16x8*)(kp+4608);
  kf[6]=*(const __attribute__((address_space(3))) bf16x8*)(kp+6144); kf[7]=*(const __attribute__((address_space(3))) bf16x8*)(kp+6656);
}
__device__ __forceinline__ void kload2(bf16x8*kf,lds_cptr kp,int j){ kf[2*j]=*(const __attribute__((address_space(3))) bf16x8*)(kp+j*2048); kf[2*j+1]=*(const __attribute__((address_space(3))) bf16x8*)(kp+j*2048+512); }
__device__ __forceinline__ s16x4 vtr(lds_cptr p){ return __builtin_bit_cast(s16x4,__builtin_amdgcn_ds_read_tr16_b64_v4i16((__attribute__((address_space(3))) v4i16_t*)p)); }
__device__ __forceinline__ float rowmax(const f32x16&p0,const f32x16&p1){
  float a=max3f(p0[0],p0[1],p1[0]),b=max3f(p0[2],p0[3],p1[1]);a=max3f(a,p1[2],p1[3]);
  #pragma unroll
  for(int r=4;r<16;r+=4){a=max3f(a,p0[r],p0[r+1]);b=max3f(b,p0[r+2],p0[r+3]);a=max3f(a,p1[r],p1[r+1]);b=max3f(b,p1[r+2],p1[r+3]);}
  const float m=max2f(a,b);
  auto rr=__builtin_amdgcn_permlane32_swap(__float_as_uint(m),__float_as_uint(m),false,false);
  return max2f(__uint_as_float(rr[0]),__uint_as_float(rr[1]));
}
__device__ __forceinline__ void pv(f32x16*o,int vb,bf16x8 pa0,bf16x8 pa1,bf16x8 pa2,bf16x8 pa3){
  #pragma unroll
  for(int d0=0;d0<2;++d0){s16x4 lo[4],hi[4];
    #pragma unroll
    for(int ks=0;ks<4;++ks){
      asm volatile("ds_read_b64_tr_b16 %0,%1 offset:%c2":"=&v"(lo[ks]):"v"(vb),"i"(d0*4096+ks*1024):"memory");
      asm volatile("ds_read_b64_tr_b16 %0,%1 offset:%c2":"=&v"(hi[ks]):"v"(vb),"i"(d0*4096+ks*1024+512):"memory");}
    asm volatile("s_waitcnt lgkmcnt(0)":::"memory");SBAR();
    #define PK(k) (bf16x8){lo[k][0],lo[k][1],lo[k][2],lo[k][3],hi[k][0],hi[k][1],hi[k][2],hi[k][3]}
    o[d0]=__builtin_amdgcn_mfma_f32_32x32x16_bf16(pa0,PK(0),o[d0],0,0,0);
    o[d0]=__builtin_amdgcn_mfma_f32_32x32x16_bf16(pa1,PK(1),o[d0],0,0,0);
    o[d0]=__builtin_amdgcn_mfma_f32_32x32x16_bf16(pa2,PK(2),o[d0],0,0,0);
    o[d0]=__builtin_amdgcn_mfma_f32_32x32x16_bf16(pa3,PK(3),o[d0],0,0,0);
    #undef PK
  }
}

#ifndef ATTN_STORE16
#define ATTN_STORE16(p,v) (*(u32x4*)(p)=(v))
#endif
template<int THRL,bool NA> __device__ __forceinline__ void attn_unit(const bf16*Qu,const bf16*__restrict__ Kh,const bf16*__restrict__ Vh,bf16*Ou,const int NT,const int tskip,const int gr0,const int kr0,const float*rpbh,char*shm){
  int tid_=threadIdx.x; asm volatile("":"+v"(tid_));
  const int tid=tid_,lane=tid&63,r32=lane&31,hi=lane>>5; const int wid=__builtin_amdgcn_readfirstlane(tid>>6);
  const bf16*Qw=Qu+(long)(wid*QBLK)*KP;
  const unsigned lds0=(unsigned)(uintptr_t)shm;
  float*wsf=(float*)(shm+LDS_WS)+wid*64;
  const bf16*ksrc=Kh+(long)lane*KP+wid*8;
  const bf16*vsrc=Vh+(long)(16*(wid&3)+(lane>>2))*KP+(wid>>2)*32+(lane&3)*8;
  const unsigned kdst=lds0+LDS_K+wid*1024, vdst=lds0+LDS_V+wid*1024;
  #define TROW(t) ((long)(((t)<4)?(t):(t)+tskip)*(KVBLK*KP))
  #define DMA_K(t,slot) glds16(ksrc+TROW(t),(unsigned)__builtin_amdgcn_readfirstlane(kdst+(slot)))
  #define DMA_V(t,slot) glds16(vsrc+TROW(t),(unsigned)__builtin_amdgcn_readfirstlane(vdst+(slot)))
  const int vb0=(int)(lds0+LDS_V)+((lane>>4)&1)*32+(lane&3)*8+(4*hi+((lane&15)>>2))*64;
  const char*Kbase=shm+LDS_K; bf16x8 kf[8];
  const lds_cptr shm3=(lds_cptr)shm; const lds_cptr kp0=shm3+LDS_K+hi*1024+r32*16; const lds_cptr vp0=shm3+LDS_V+((lane>>4)&1)*32+(lane&3)*8+(4*hi+((lane&15)>>2))*64;
  DMA_K(0,0);DMA_V(0,0);DMA_K(1,SLOTB);
  bf16x8 qr[4];
  #pragma unroll
  for(int d0=0;d0<4;++d0)qr[d0]=*reinterpret_cast<const bf16x8*>(&Qw[(long)r32*KP+d0*16+hi*8]);
  float mhat=0.f,l_reg=0.f;f32x16 o[2];o[0]=f32x16{};o[1]=f32x16{};f32x16 negm=f32x16{};asm volatile("":"+v"(negm));
  const int gr_=gr0+(wid>>1), gc_=32*(wid&1)+r32, rs_=min(max(gr_-4,0),120), cs_=min(max(gc_-8,0),48), bb_=15-gc_+4*hi, d0_=4*hi-cs_;
  const lds_cfptr tab=(lds_cfptr)(shm3+LDS_BYTES);
  if constexpr(NA){ __attribute__((address_space(3))) float*tw=(__attribute__((address_space(3))) float*)(shm3+LDS_BYTES); for(int i=tid;i<465;i+=NW*64)tw[i]=rpbh[i]*1.4426950408889634f; }
  #define CMASK(P0,P1,t) do{ if constexpr(NA){ if((t)>=4){ const int kr_=kr0+(t)-4; na_mask(P0,P1,(kr_>=rs_&&kr_<rs_+8),(kr_-gr_+7)*31+bb_,d0_,tab); } } }while(0)
  bool resc=false;
  #define START(P0,P1) do{ const float rm=rowmax(P0,P1); resc=false; \
    { const float dl=rm; mhat=fadd_s(mhat,dl); \
      _Pragma("unroll") for(int r=0;r<16;++r){P0[r]=fsub_s(P0[r],dl);P1[r]=fsub_s(P1[r],dl);} \
      _Pragma("unroll") for(int r=0;r<16;++r)negm[r]=-mhat; asm volatile("":"+v"(negm)); } \
    _Pragma("unroll") for(int r=0;r<16;++r)P0[r]=__builtin_amdgcn_exp2f(P0[r]); }while(0)
  #define RESC() do{ if(resc){ asm volatile("s_waitcnt lgkmcnt(0)":::"memory"); \
      _Pragma("unroll") for(int d_=0;d_<2;++d_) _Pragma("unroll") for(int r=0;r<16;++r)o[d_][r]*=wsf[crow(r,hi)]; } }while(0)
  f32x16 pA0,pA1,pB0,pB1;
  int sl_prev=0,sl_cur=0,sl_next=SLOTB;
  #define ROT() do{sl_prev=sl_cur;sl_cur=sl_next;sl_next=(sl_next==(NSLOT-1)*SLOTB)?0:sl_next+SLOTB;}while(0)
  DMA_K(2,2*SLOTB);
  WAIT_BAR(3);
  qkt(pA0,pA1,Kbase,qr,negm,r32,hi);asm volatile("s_nop 15\n\ts_nop 7":"+v"(pA0),"+v"(pA1));CMASK(pA0,pA1,0);
  START(pA0,pA1);
  _Pragma("unroll") for(int r=0;r<16;++r)pA1[r]=__builtin_amdgcn_exp2f(pA1[r]);
  WAIT_BAR(0);
  DMA_K(3,0);DMA_V(1,SLOTB);
  ROT();
  kload8(kf,kp0+sl_cur);
  WAIT_BAR(2);
  s16x4 vlo[8],vhi[8]; u32x4 pw0,pw1,pw2,pw3;
  #define PKW(P,B) cvtpk_s(P[B],P[B+1])
  #define PAF(k) __builtin_bit_cast(bf16x8,pw##k)
  #define VFR(i) (bf16x8){vlo[i][0],vlo[i][1],vlo[i][2],vlo[i][3],vhi[i][0],vhi[i][1],vhi[i][2],vhi[i][3]}
  #define PIN(x) asm volatile("":"+v"(x))
  #define MX3(a,b,c) __builtin_fmaxf(__builtin_fmaxf((a),(b)),(c))
  #define GAPA(MF,A0,A1,A2,A3,W0,W1,PW) do{ MF; sacc+=A0; sacc+=A1; sacc+=A2; sacc+=A3; PIN(sacc); W0; W1; PIN(PW); SBAR(); }while(0)
  #define EX(v) __builtin_amdgcn_exp2f(v)
  #define GAPB(MF,X,B) do{ MF; X[B]=EX(X[B]); X[B+1]=EX(X[B+1]); X[B+2]=EX(X[B+2]); X[B+3]=EX(X[B+3]); PIN(X); SBAR(); }while(0)
  #define VRD(i) do{ vlo[i]=vtr(vp_+(((i)>>2)*4096+((i)&3)*1024)); vhi[i]=vtr(vp_+(((i)>>2)*4096+((i)&3)*1024+512)); }while(0)
  #define KRD(G,j) do{ if(G){ kload2(kf,kp0+sl_next,j); SBAR(); } }while(0)
  #define STEP(C0,C1,P0,P1,t,GK,GV,GL) do{ SBAR(); \
    const lds_cptr vp_=vp0+sl_prev; \
    VRD(0); SBAR(); float sacc=(P0[0]+P0[1]); \
    GAPA(C0=__builtin_amdgcn_mfma_f32_32x32x16_bf16(kf[0],qr[0],negm,0,0,0), P0[2],P0[3],P0[4],P0[5],     pw0[0]=PKW(P0,0), pw0[1]=PKW(P0,2), pw0); \
    VRD(4); SBAR(); GAPA(C1=__builtin_amdgcn_mfma_f32_32x32x16_bf16(kf[1],qr[0],negm,0,0,0), P0[6],P0[7],P0[8],P0[9],     pw0[2]=PKW(P0,4), pw0[3]=PKW(P0,6), pw0); \
    VRD(1); SBAR(); GAPA(C0=__builtin_amdgcn_mfma_f32_32x32x16_bf16(kf[2],qr[1],C0,0,0,0),   P0[10],P0[11],P0[12],P0[13], pw1[0]=PKW(P0,8), pw1[1]=PKW(P0,10), pw1); \
    VRD(5); SBAR(); GAPA(C1=__builtin_amdgcn_mfma_f32_32x32x16_bf16(kf[3],qr[1],C1,0,0,0),   P0[14],P0[15],P1[0],P1[1],   pw1[2]=PKW(P0,12),pw1[3]=PKW(P0,14), pw1); \
    VRD(2); SBAR(); GAPA(C0=__builtin_amdgcn_mfma_f32_32x32x16_bf16(kf[4],qr[2],C0,0,0,0),   P1[2],P1[3],P1[4],P1[5],     pw2[0]=PKW(P1,0), pw2[1]=PKW(P1,2), pw2); \
    VRD(6); SBAR(); GAPA(C1=__builtin_amdgcn_mfma_f32_32x32x16_bf16(kf[5],qr[2],C1,0,0,0),   P1[6],P1[7],P1[8],P1[9],     pw2[2]=PKW(P1,4), pw2[3]=PKW(P1,6), pw2); \
    VRD(3); SBAR(); GAPA(C0=__builtin_amdgcn_mfma_f32_32x32x16_bf16(kf[6],qr[3],C0,0,0,0),   P1[10],P1[11],P1[12],P1[13], pw3[0]=PKW(P1,8), pw3[1]=PKW(P1,10), pw3); \
    VRD(7); SBAR(); GAPA(C1=__builtin_amdgcn_mfma_f32_32x32x16_bf16(kf[7],qr[3],C1,0,0,0),   P1[14],P1[15],0.f,0.f,       pw3[2]=PKW(P1,12),pw3[3]=PKW(P1,14), pw3); \
    l_reg+=sacc; \
    if(GK){DMA_K((t)+3,sl_cur);} if(GV){DMA_V((t)+1,sl_next);} \
    CMASK(C0,C1,t); \
    { float a=MX3(C0[0],C0[1],C1[0]),b=MX3(C0[2],C0[3],C1[1]); a=MX3(a,C1[2],C1[3]); \
      _Pragma("unroll") for(int r=4;r<16;r+=4){a=MX3(a,C0[r],C0[r+1]);b=MX3(b,C0[r+2],C0[r+3]);a=MX3(a,C1[r],C1[r+1]);b=MX3(b,C1[r+2],C1[r+3]);} \
      float rm=__builtin_fmaxf(a,b); { auto rr=__builtin_amdgcn_permlane32_swap(__float_as_uint(rm),__float_as_uint(rm),false,false); rm=__builtin_fmaxf(__uint_as_float(rr[0]),__uint_as_float(rr[1])); } \
      resc=false; \
      if(__builtin_expect(__any(rm>(float)THRL),0)){ const float dl=__builtin_fmaxf(rm,0.f); mhat+=dl; \
        _Pragma("unroll") for(int r=0;r<16;++r){C0[r]-=dl;C1[r]-=dl;} \
        _Pragma("unroll") for(int r=0;r<16;++r)negm[r]=-mhat; asm volatile("":"+v"(negm)); \
        const float f=__builtin_amdgcn_exp2f(-dl); l_reg*=f; if(hi==0)wsf[r32]=f; resc=true; } } \
    SBAR(); \
    GAPB(o[0]=__builtin_amdgcn_mfma_f32_32x32x16_bf16(PAF(0),VFR(0),o[0],0,0,0), C0,0); \
    GAPB(o[1]=__builtin_amdgcn_mfma_f32_32x32x16_bf16(PAF(0),VFR(4),o[1],0,0,0), C0,4); \
    KRD(GL,0); GAPB(o[0]=__builtin_amdgcn_mfma_f32_32x32x16_bf16(PAF(1),VFR(1),o[0],0,0,0), C0,8); \
    KRD(GL,1); GAPB(o[1]=__builtin_amdgcn_mfma_f32_32x32x16_bf16(PAF(1),VFR(5),o[1],0,0,0), C0,12); \
    KRD(GL,2); GAPB(o[0]=__builtin_amdgcn_mfma_f32_32x32x16_bf16(PAF(2),VFR(2),o[0],0,0,0), C1,0); \
    KRD(GL,3); GAPB(o[1]=__builtin_amdgcn_mfma_f32_32x32x16_bf16(PAF(2),VFR(6),o[1],0,0,0), C1,4); \
    GAPB(o[0]=__builtin_amdgcn_mfma_f32_32x32x16_bf16(PAF(3),VFR(3),o[0],0,0,0), C1,8); \
    GAPB(o[1]=__builtin_amdgcn_mfma_f32_32x32x16_bf16(PAF(3),VFR(7),o[1],0,0,0), C1,12); \
    }while(0)
  int t=1;
  for(;t+5<NT;t+=2){
    STEP(pB0,pB1,pA0,pA1,t,true,true,true);     WAIT_BAR(2); RESC(); ROT();
    STEP(pA0,pA1,pB0,pB1,t+1,true,true,true);   WAIT_BAR(2); RESC(); ROT();
  }
  #define ENDW(tt) do{ if((tt)+3<NT){WAIT_BAR(2);} else if((tt)+2<NT){WAIT_BAR(1);} else {WAIT_BAR(0);} }while(0)
  for(;t+1<NT;t+=2){
    STEP(pB0,pB1,pA0,pA1,t,(t+3<NT),(t+1<NT),(t+1<NT));       ENDW(t);   RESC(); ROT();
    STEP(pA0,pA1,pB0,pB1,t+1,(t+4<NT),(t+2<NT),(t+2<NT));     ENDW(t+1); RESC(); ROT();
  }
  STEP(pB0,pB1,pA0,pA1,NT-1,false,false,false); RESC();
  { float sacc=pB0[0]+pB0[1]; _Pragma("unroll") for(int r=2;r<16;++r)sacc+=pB0[r]; _Pragma("unroll") for(int r=0;r<16;++r)sacc+=pB1[r]; l_reg+=sacc;
    pw0=(u32x4){PKW(pB0,0),PKW(pB0,2),PKW(pB0,4),PKW(pB0,6)};pw1=(u32x4){PKW(pB0,8),PKW(pB0,10),PKW(pB0,12),PKW(pB0,14)};pw2=(u32x4){PKW(pB1,0),PKW(pB1,2),PKW(pB1,4),PKW(pB1,6)};pw3=(u32x4){PKW(pB1,8),PKW(pB1,10),PKW(pB1,12),PKW(pB1,14)};
    SBAR(); pv(o,vb0+sl_cur,PAF(0),PAF(1),PAF(2),PAF(3)); }
  #undef PKW
  #undef PAF
  #undef VFR
  #undef PIN
  #undef MX3
  #undef GAPA
  #undef GAPB
  #undef EX
  #undef VRD
  #undef KRD
  #undef STEP
  #undef ENDW
  {auto rr=__builtin_amdgcn_permlane32_swap(__float_as_uint(l_reg),__float_as_uint(l_reg),false,false);l_reg=__uint_as_float(rr[0])+__uint_as_float(rr[1]);}
  if(hi==0)wsf[32+r32]=l_reg;asm volatile("s_waitcnt lgkmcnt(0)":::"memory");
  float rli[16];
  #pragma unroll
  for(int r=0;r<16;++r)rli[r]=__builtin_amdgcn_rcpf(wsf[32+crow(r,hi)]);
  bf16*Ow=Ou+(long)(wid*QBLK)*OP;
  { bf16*stg=(bf16*)(shm+LDS_OST)+wid*2048;
    #pragma unroll
    for(int r=0;r<16;++r){const int orow=crow(r,hi);
      #pragma unroll
      for(int d0=0;d0<2;++d0)stg[orow*64+d0*32+r32]=__float2bfloat16(o[d0][r]*rli[r]);}
    asm volatile("s_waitcnt lgkmcnt(0)":::"memory");
    #pragma unroll
    for(int i=0;i<4;++i){const int row=i*8+(lane>>3),ch=lane&7; const u32x4 v=*(const u32x4*)(stg+row*64+ch*8); ATTN_STORE16(Ow+(long)row*OP+ch*8,v);} }
  asm volatile("s_waitcnt lgkmcnt(0)\n\ts_barrier":::"memory");
  #undef DMA_K
  #undef DMA_V
  #undef TROW
  #undef CMASK
  #undef START
  #undef RESC
  #undef ROT
}
constexpr int ATTN_LDS_BYTES=LDS_BYTES;
#undef SBAR
#undef WAIT_BAR
}

constexpr int NWAVES = 8;
constexpr int DM = 1024, NBATCH = 4, SEQL = 8192, CTXL = 256, TPB = SEQL + CTXL, NROW = NBATCH * TPB, DEPTH = 4;
constexpr int INW = 2048, NEXP = 16, EDIM = 2048, CAPL = 1024, CAPC = 32, ETILES = 17, ESLOTS = ETILES * 256, EUSED = NBATCH * (CAPL + CAPC);
constexpr int COL_QA = 0, COL_KA = 512, COL_VA = 640, COL_QB = 768, COL_KB = 1024, COL_VB = 1280, COL_CV = 1536, COL_CG = 1792;
constexpr int MIX_A = 0, MIX_B = 512, MIX_C = 768;
constexpr float LOG2E = 1.4426950408889634f, C2 = 0.125f * LOG2E, EPS = 1e-6f;
constexpr int NPL = 10;
constexpr int PH_FINAL = 1 + DEPTH * NPL, NPH = PH_FINAL + 1;
enum { LP_NORM1 = 0, LP_INPROJ = 1, LP_POST = 2, LP_MIX = 3, LP_OUTPROJ = 4, LP_NORM2 = 5, LP_TOPK = 6, LP_DISPATCH = 7, LP_G1 = 8, LP_G2 = 9 };

constexpr size_t MiB = 1u << 20;
constexpr size_t WS_CTL = 0, CTL_ZERO_BYTES = 1 * MiB;
constexpr size_t WS_MODV = 1 * MiB;
constexpr size_t WS_ROPE = 2 * MiB;
constexpr size_t WS_WIN = 4 * MiB;
constexpr size_t WS_WOUT = 20 * MiB;
constexpr size_t WS_WGU = 32 * MiB;
constexpr size_t WS_WD = 544 * MiB;
constexpr size_t WS_X = 800 * MiB;
constexpr size_t WS_HN = 932 * MiB;
constexpr size_t WS_P = 998 * MiB;
constexpr size_t WS_MIX = 1130 * MiB;
constexpr size_t WS_AFF = 1196 * MiB;
constexpr size_t WS_SLOT = 1199 * MiB;
constexpr size_t WS_IDX = 1202 * MiB;
constexpr size_t WS_XE = 1204 * MiB;
constexpr size_t WS_H1 = 1340 * MiB;
constexpr size_t WS_Y = 1612 * MiB;
constexpr size_t WS_END = 1748 * MiB;
constexpr int CW_TMO = 0, CW_CODE = 1, CW_BAR = 4096;

constexpr int RING_OFF = 0, RING_BYTES = 139264;
constexpr int LDSCTL_OFF = RING_BYTES, MISC_OFF = LDSCTL_OFF + 320;
constexpr int LDS_BYTES = 147456;
static_assert(MISC_OFF + 128 <= LDS_BYTES, "LDS map");

#define GAS __attribute__((address_space(1)))
#define LAS __attribute__((address_space(3)))
typedef unsigned short bf16;
typedef unsigned v4u __attribute__((ext_vector_type(4)));
typedef float f32x4 __attribute__((ext_vector_type(4)));
typedef short bf16x8 __attribute__((ext_vector_type(8)));
typedef GAS unsigned gu32;
typedef GAS unsigned long long gu64;
#define RLX_AGENT __ATOMIC_RELAXED, __HIP_MEMORY_SCOPE_AGENT
#define LDS_WAIT() asm volatile("s_waitcnt lgkmcnt(0)" ::: "memory")
#define VM_WAIT() asm volatile("s_waitcnt vmcnt(0)" ::: "memory")
__device__ __forceinline__ unsigned long long rt() { return __builtin_amdgcn_s_memrealtime(); }
__device__ __forceinline__ unsigned f2bf(float f) { unsigned u = __builtin_bit_cast(unsigned, f); return (u + 0x7fffu + ((u >> 16) & 1u)) >> 16; }
__device__ __forceinline__ unsigned pk2(float lo, float hi) { return f2bf(lo) | (f2bf(hi) << 16); }

#define XB_TMO      128
#define XB_XCNT(j)  (256  + 64 * (j))
#define XB_XSUB(j)  (1280 + 64 * (j))
#define XB_XGEN(j)  (2304 + 64 * (j))
#define XB_TOP      3328
#define XB_TOPGEN   3392
#define XCD_BAR_WORDS 3456
#define XB_SPIN_CAP (1u << 18)

__device__ __forceinline__ unsigned xb_ld(unsigned* p)              { return __hip_atomic_load(p, __ATOMIC_RELAXED, __HIP_MEMORY_SCOPE_AGENT); }
__device__ __forceinline__ unsigned xb_add(unsigned* p, unsigned v) { return __hip_atomic_fetch_add(p, v, __ATOMIC_RELAXED, __HIP_MEMORY_SCOPE_AGENT); }
__device__ __forceinline__ unsigned xb_xcc_id() { return (unsigned)__builtin_amdgcn_s_getreg((3 << 11) | 20) & 0xFu; }
#define XB_SPIN(cond, bar) do { unsigned _sp = 0; while (cond) { __builtin_amdgcn_s_sleep(1); \
    if ((++_sp & 255u) == 0u) { if (xb_ld(&(bar)[XB_TMO])) break; if (_sp > XB_SPIN_CAP) { atomicAdd(&(bar)[XB_TMO], 1u); break; } } } } while (0)

struct XcdBarrier {
    unsigned* bar; unsigned x;
    volatile LAS unsigned* st;
};

__device__ __forceinline__ XcdBarrier xcd_barrier_post(unsigned* bar, volatile LAS unsigned* st) {
    XcdBarrier b; b.bar = bar; b.x = xb_xcc_id(); b.st = st;
    if (threadIdx.x == 0) (void)xb_add(&bar[XB_XCNT(b.x)], 1u);
    return b;
}
__device__ __forceinline__ void xcd_barrier_complete(unsigned* bar, unsigned x, unsigned& nloc, unsigned& nx) {
    const unsigned G = gridDim.x * gridDim.y * gridDim.z;
    unsigned sum, cnt, mine, sp = 0u;
    for (;;) {
        sum = 0u; cnt = 0u; mine = 0u;
#pragma unroll
        for (unsigned j = 0; j < 16; ++j) { const unsigned c = xb_ld(&bar[XB_XCNT(j)]); sum += c; cnt += (c > 0u) ? 1u : 0u; mine = (j == x) ? c : mine; }
        if (sum == G) break;
        __builtin_amdgcn_s_sleep(1);
        if ((++sp & 255u) == 0u) { if (xb_ld(&bar[XB_TMO])) break; if (sp > XB_SPIN_CAP) { atomicAdd(&bar[XB_TMO], 1u); break; } }
    }
    nloc = mine > 0u ? mine : 1u; nx = cnt > 0u ? cnt : 1u;
}

__device__ __forceinline__ void xcd_barrier(const XcdBarrier& b) {
    asm volatile("s_waitcnt vmcnt(0)" ::: "memory");
    __syncthreads();
    if (threadIdx.x == 0) {
        unsigned* bar = b.bar;
        __builtin_amdgcn_s_waitcnt(0);
        unsigned nloc = b.st[0], nx = b.st[1];
        if (nloc == 0u) { xcd_barrier_complete(bar, b.x, nloc, nx); b.st[0] = nloc; b.st[1] = nx; }
        const unsigned old = xb_add(&bar[XB_XSUB(b.x)], 1u);
        const unsigned gen = old / nloc;
        if (old + 1u == (gen + 1u) * nloc) {
            __builtin_amdgcn_fence(__ATOMIC_RELEASE, "agent");
            asm volatile("s_waitcnt vmcnt(0)" ::: "memory");
            const unsigned og = xb_add(&bar[XB_TOP], 1u);
            const unsigned tg = og / nx;
            if (og + 1u == (tg + 1u) * nx) xb_add(&bar[XB_TOPGEN], 1u);
            else XB_SPIN(xb_ld(&bar[XB_TOPGEN]) == tg, bar);
            __builtin_amdgcn_fence(__ATOMIC_ACQUIRE, "agent");
            xb_add(&bar[XB_XGEN(b.x)], 1u);
            asm volatile("s_waitcnt vmcnt(0)" ::: "memory");
        } else {
            XB_SPIN(xb_ld(&bar[XB_XGEN(b.x)]) == gen, bar);
            __builtin_amdgcn_fence(__ATOMIC_ACQUIRE, "agent");
            asm volatile("s_waitcnt vmcnt(0)" ::: "memory");
        }
    }
    __syncthreads();
}


typedef unsigned u2v __attribute__((ext_vector_type(2)));
__device__ __forceinline__ float bf2f(unsigned short b) { return __uint_as_float((unsigned)b << 16); }
__device__ __forceinline__ float bflo(unsigned w) { return __uint_as_float(w << 16); }
__device__ __forceinline__ float bfhi(unsigned w) { return __uint_as_float(w & 0xffff0000u); }
__device__ __forceinline__ float fexp2(float x) { return __builtin_amdgcn_exp2f(x); }
__device__ __forceinline__ float fsigmoid(float x) { return __builtin_amdgcn_rcpf(1.0f + fexp2(-LOG2E * x)); }

struct Frame {
    LAS unsigned char* lds;
    volatile LAS unsigned* MISC;
    gu32* ctl;
    int tid, lane, wave;
    int vcu, G;
    const float* in[22];
    float* out;
    unsigned char* ws;
};
#define WSP(T, off) ((T*)(F.ws + (off)))

__device__ __forceinline__ float wave_sum(float v) {
#pragma unroll
    for (int o = 1; o < 64; o <<= 1) v += __shfl_xor(v, o);
    return v;
}

__device__ __forceinline__ void tr_item(const float* W0, int N, bf16* Wt0, int K, LAS float* scr, int lane) {
#pragma unroll 4
    for (int i = 0; i < 16; ++i) { const int kk = 4 * i + (lane >> 4), n4 = (lane & 15) * 4; const f32x4 v = *(const GAS f32x4*)(W0 + (size_t)kk * N + n4);
        LAS float* d = scr + kk * 65 + n4; d[0] = v.x; d[1] = v.y; d[2] = v.z; d[3] = v.w; }
    LDS_WAIT(); asm volatile("" ::: "memory");
    const int c = lane & 7;
#pragma unroll
    for (int j = 0; j < 8; ++j) { const int n = (lane >> 3) + 8 * j; const LAS float* s = scr + (8 * c) * 65 + n;
        v4u o; o.x = pk2(s[0 * 65], s[1 * 65]); o.y = pk2(s[2 * 65], s[3 * 65]); o.z = pk2(s[4 * 65], s[5 * 65]); o.w = pk2(s[6 * 65], s[7 * 65]);
        *(GAS v4u*)(Wt0 + (size_t)n * K + 8 * c) = o; }
    LDS_WAIT(); asm volatile("" ::: "memory");
}
__device__ __forceinline__ void sincos_d(double a, double& s, double& c) {
    const double n = __builtin_rint(a * 0.63661977236758134308);
    double r = __builtin_fma(-n, 1.57079632679489655800e+00, a); r = __builtin_fma(-n, 6.12323399573676603587e-17, r);
    const double r2 = r * r;
    double sp = -7.6471637318198164759e-13; sp = sp * r2 + 1.6059043836821614599e-10; sp = sp * r2 - 2.5052108385441718775e-08; sp = sp * r2 + 2.7557319223985890653e-06;
    sp = sp * r2 - 1.9841269841269841270e-04; sp = sp * r2 + 8.3333333333333333333e-03; sp = sp * r2 - 1.6666666666666666667e-01; const double sr = r + r * r2 * sp;
    double cp = 4.7794773323873852974e-14; cp = cp * r2 - 1.1470745597729724714e-11; cp = cp * r2 + 2.0876756987868098979e-09; cp = cp * r2 - 2.7557319223985890653e-07;
    cp = cp * r2 + 2.4801587301587301587e-05; cp = cp * r2 - 1.3888888888888888889e-03; cp = cp * r2 + 4.1666666666666666667e-02; cp = cp * r2 - 0.5; const double cr = 1.0 + r2 * cp;
    const int q = ((int)n) & 3;
    s = (q == 0) ? sr : (q == 1) ? cr : (q == 2) ? -sr : -cr;
    c = (q == 0) ? cr : (q == 1) ? -sr : (q == 2) ? -cr : sr;
}
__device__ __forceinline__ void p0_prologue(Frame& F) {
    {
        LAS float* sil = (LAS float*)F.lds;
        LAS float* part = sil + 8192;
        for (int i = F.tid; i < 5 * 1024; i += NWAVES * 64) { const int s = i >> 10, k = i & 1023; const float c = (s < 4) ? F.in[1][s * 1024 + k] : F.in[3][k]; sil[k * 8 + s] = c * fsigmoid(c); }
        __syncthreads();
        for (int it = blockIdx.x; it < DEPTH * 96; it += F.G) {
            const int l = it / 96, j0 = (it % 96) * 64;
            const float* wa = F.in[4] + (size_t)l * 1024 * 6144 + j0 + F.lane;
            float a0 = 0.f, a1 = 0.f, a2 = 0.f, a3 = 0.f, a4 = 0.f;
            const int kb = F.wave * 128;
#pragma unroll 8
            for (int k = 0; k < 128; ++k) { const float w = wa[(size_t)(kb + k) * 6144]; const f32x4 sv = *(const LAS f32x4*)(sil + (kb + k) * 8); const float s4 = sil[(kb + k) * 8 + 4];
                a0 += w * sv.x; a1 += w * sv.y; a2 += w * sv.z; a3 += w * sv.w; a4 += w * s4; }
            LAS float* pw = part + F.wave * 320 + F.lane; pw[0] = a0; pw[64] = a1; pw[128] = a2; pw[192] = a3; pw[256] = a4;
            __syncthreads();
            if (F.wave < 5) { const int s = F.wave; float t = 0.f;
#pragma unroll
                for (int w = 0; w < 8; ++w) t += part[w * 320 + s * 64 + F.lane];
                const int j = j0 + F.lane, q = j >> 10, kk = j & 1023; t += F.in[5][l * 6144 + j];
                if (q == 1) t = F.in[6][l * 1024 + kk] * (1.0f + t); else if (q == 4) t = F.in[7][l * 1024 + kk] * (1.0f + t);
                WSP(float, WS_MODV)[(size_t)((l * 5 + s) * 6 + q) * 1024 + kk] = t; }
            __syncthreads();
        }
    }
    if ((int)blockIdx.x == F.G - 1) {
        for (int i = F.tid; i < 2048; i += NWAVES * 64) { const int pos = i >> 4, j = i & 15;
            double inv = 1.0; for (int q = 0; q < j; ++q) inv *= 0.56234132519034908039;
            double s, c; sincos_d((double)pos * (double)(float)inv, s, c);
            WSP(float, WS_ROPE)[i] = (float)c; WSP(float, WS_ROPE)[2048 + i] = (float)s; }
    }
    {
        LAS float* scr = (LAS float*)(F.lds + F.wave * 16640);
        const int gw = F.vcu * NWAVES + F.wave, NGW = F.G * NWAVES;
        constexpr int I_IN = DEPTH * 16 * 32, I_OUT = DEPTH * 16 * 16, I_G = DEPTH * NEXP * 16 * 32, I_D = DEPTH * NEXP * 32 * 16;
        constexpr int NITEMS = I_IN + I_OUT + 2 * I_G + I_D;
        for (int it = gw; it < NITEMS; it += NGW) {
            int r = it;
            if (r < I_IN) { const int mat = r >> 9, t = r & 511, kb = t >> 5, nb = t & 31;
                tr_item(F.in[8] + (size_t)mat * 1024 * 2048 + (size_t)(64 * kb) * 2048 + 64 * nb, 2048, WSP(bf16, WS_WIN) + (size_t)mat * 2048 * 1024 + (size_t)(64 * nb) * 1024 + 64 * kb, 1024, scr, F.lane); continue; }
            r -= I_IN;
            if (r < I_OUT) { const int mat = r >> 8, t = r & 255, kb = t >> 4, nb = t & 15;
                tr_item(F.in[16] + (size_t)mat * 1024 * 1024 + (size_t)(64 * kb) * 1024 + 64 * nb, 1024, WSP(bf16, WS_WOUT) + (size_t)mat * 1024 * 1024 + (size_t)(64 * nb) * 1024 + 64 * kb, 1024, scr, F.lane); continue; }
            r -= I_OUT;
            if (r < 2 * I_G) { const int up = r >= I_G ? 1 : 0; if (up) r -= I_G; const int mat = r >> 9, t = r & 511, kb = t >> 5, nb = t & 31;
                const int n0 = 64 * nb, drow = (n0 >> 7) * 256 + up * 128 + (n0 & 127);
                tr_item((up ? F.in[19] : F.in[18]) + (size_t)mat * 1024 * 2048 + (size_t)(64 * kb) * 2048 + n0, 2048, WSP(bf16, WS_WGU) + (size_t)mat * 4096 * 1024 + (size_t)drow * 1024 + 64 * kb, 1024, scr, F.lane); continue; }
            r -= 2 * I_G;
            { const int mat = r >> 9, t = r & 511, kb = t >> 4, nb = t & 15;
                tr_item(F.in[20] + (size_t)mat * 2048 * 1024 + (size_t)(64 * kb) * 1024 + 64 * nb, 1024, WSP(bf16, WS_WD) + (size_t)mat * 1024 * 2048 + (size_t)(64 * nb) * 2048 + 64 * kb, 2048, scr, F.lane); }
        }
    }
}

__device__ __forceinline__ int row_set(int r) { const int b = r / TPB, t = r - b * TPB; return t < CTXL ? 4 : b; }
__device__ __forceinline__ void combine_moe(Frame& F, int r, int lprev, int s, f32x4 (&v)[4]) {
    const int sl = (F.lane < 16) ? WSP(const int, WS_SLOT)[(size_t)r * 16 + F.lane] : -1;
    const float af = (F.lane < 16) ? WSP(const float, WS_AFF)[(size_t)r * 16 + F.lane] : 0.f;
    f32x4 acc[4];
#pragma unroll
    for (int j = 0; j < 4; ++j) acc[j] = (f32x4){0.f, 0.f, 0.f, 0.f};
#pragma unroll
    for (int e = 0; e < NEXP; ++e) {
        const int se = __builtin_amdgcn_readlane(sl, e);
        if (se >= 0) { const float ge = __uint_as_float(__builtin_amdgcn_readlane(__float_as_uint(af), e));
            const GAS u2v* yr = (const GAS u2v*)(WSP(const bf16, WS_Y) + ((size_t)e * ESLOTS + se) * DM) + F.lane;
#pragma unroll
            for (int j = 0; j < 4; ++j) { const u2v w = yr[64 * j]; acc[j] = acc[j] + ge * (f32x4){bflo(w.x), bfhi(w.x), bflo(w.y), bfhi(w.y)}; } }
    }
    const GAS f32x4* g2 = (const GAS f32x4*)(WSP(const float, WS_MODV) + (size_t)((lprev * 5 + s) * 6 + 5) * 1024) + F.lane;
#pragma unroll
    for (int j = 0; j < 4; ++j) v[j] = v[j] + g2[64 * j] * acc[j];
}
__device__ __forceinline__ float row_rstd(const f32x4 (&v)[4]) {
    float s = 0.f;
#pragma unroll
    for (int j = 0; j < 4; ++j) s += (v[j].x * v[j].x + v[j].y * v[j].y) + (v[j].z * v[j].z + v[j].w * v[j].w);
    return 1.0f / sqrtf(wave_sum(s) * (1.0f / DM) + EPS);
}
__device__ __forceinline__ void ph_norm1(Frame& F, int l) {
    for (int ch = blockIdx.x; ch < 256; ch += F.G) {
        for (int i = F.wave; i < 132; i += NWAVES) {
            const int r = ch * 132 + i, b = r / TPB, t = r - b * TPB, s = t < CTXL ? 4 : b;
            f32x4 v[4];
            GAS f32x4* xr = (GAS f32x4*)(WSP(float, WS_X) + (size_t)r * DM) + F.lane;
            if (l == 0) { const GAS f32x4* src = (const GAS f32x4*)(t < CTXL ? F.in[2] + ((size_t)b * CTXL + t) * DM : F.in[0] + ((size_t)b * SEQL + (t - CTXL)) * DM) + F.lane;
#pragma unroll
                for (int j = 0; j < 4; ++j) v[j] = src[64 * j]; }
            else {
#pragma unroll
                for (int j = 0; j < 4; ++j) v[j] = xr[64 * j];
                combine_moe(F, r, l - 1, s, v); }
#pragma unroll
            for (int j = 0; j < 4; ++j) xr[64 * j] = v[j];
            const float rstd = row_rstd(v);
            const GAS f32x4* A = (const GAS f32x4*)(WSP(const float, WS_MODV) + (size_t)((l * 5 + s) * 6 + 1) * 1024) + F.lane;
            const GAS f32x4* B = (const GAS f32x4*)(WSP(const float, WS_MODV) + (size_t)((l * 5 + s) * 6 + 0) * 1024) + F.lane;
            GAS u2v* o = (GAS u2v*)(WSP(bf16, WS_HN) + (size_t)r * DM) + F.lane;
#pragma unroll
            for (int j = 0; j < 4; ++j) { const f32x4 h = v[j] * rstd * A[64 * j] + B[64 * j]; u2v w; w.x = pk2(h.x, h.y); w.y = pk2(h.z, h.w); o[64 * j] = w; }
        }
    }
}
__device__ __forceinline__ void ph_norm2(Frame& F, int l) {
    LAS float* wr = (LAS float*)F.lds;
    for (int i = F.tid; i < 16 * 1024; i += NWAVES * 64) { const int k = i >> 4, e = i & 15; wr[e * 1024 + k] = F.in[17][(size_t)l * 1024 * 16 + i]; }
    __syncthreads();
    for (int ch = blockIdx.x; ch < 256; ch += F.G) {
        for (int i = F.wave; i < 132; i += NWAVES) {
            const int r = ch * 132 + i, s = row_set(r);
            f32x4 v[4];
            const GAS f32x4* xr = (const GAS f32x4*)(WSP(const float, WS_X) + (size_t)r * DM) + F.lane;
#pragma unroll
            for (int j = 0; j < 4; ++j) v[j] = xr[64 * j];
            const float rstd = row_rstd(v);
            const GAS f32x4* A = (const GAS f32x4*)(WSP(const float, WS_MODV) + (size_t)((l * 5 + s) * 6 + 4) * 1024) + F.lane;
            const GAS f32x4* B = (const GAS f32x4*)(WSP(const float, WS_MODV) + (size_t)((l * 5 + s) * 6 + 3) * 1024) + F.lane;
            GAS u2v* o = (GAS u2v*)(WSP(bf16, WS_HN) + (size_t)r * DM) + F.lane;
#pragma unroll
            for (int j = 0; j < 4; ++j) { v[j] = v[j] * rstd * A[64 * j] + B[64 * j]; u2v w; w.x = pk2(v[j].x, v[j].y); w.y = pk2(v[j].z, v[j].w); o[64 * j] = w; }
            float lg[16];
#pragma unroll
            for (int e = 0; e < 16; ++e) { float a = 0.f;
#pragma unroll
                for (int j = 0; j < 4; ++j) { const f32x4 w = *(const LAS f32x4*)(wr + e * 1024 + 4 * (F.lane + 64 * j)); a += (v[j].x * w.x + v[j].y * w.y) + (v[j].z * w.z + v[j].w * w.w); }
                lg[e] = wave_sum(a); if (e & 1) __builtin_amdgcn_sched_barrier(0); }
            float mx = lg[0];
#pragma unroll
            for (int e = 1; e < 16; ++e) mx = fmaxf(mx, lg[e]);
            float sum = 0.f;
#pragma unroll
            for (int e = 0; e < 16; ++e) { lg[e] = fexp2((lg[e] - mx) * LOG2E); sum += lg[e]; }
            const float inv = 1.0f / sum; float mine = 0.f;
#pragma unroll
            for (int e = 0; e < 16; ++e) mine = (F.lane == e) ? lg[e] * inv : mine;
            if (F.lane < 16) WSP(float, WS_AFF)[(size_t)r * 16 + F.lane] = mine;
        }
    }
    __syncthreads();
}
__device__ __forceinline__ void ph_final(Frame& F) {
    for (int ch = blockIdx.x; ch < 256; ch += F.G) {
        for (int i = F.wave; i < 132; i += NWAVES) {
            const int r = ch * 132 + i, b = r / TPB, t = r - b * TPB;
            if (t < CTXL) continue;
            f32x4 v[4];
            const GAS f32x4* xr = (const GAS f32x4*)(WSP(const float, WS_X) + (size_t)r * DM) + F.lane;
#pragma unroll
            for (int j = 0; j < 4; ++j) v[j] = xr[64 * j];
            combine_moe(F, r, DEPTH - 1, b, v);
            const float rstd = row_rstd(v);
            const GAS f32x4* g = (const GAS f32x4*)F.in[21] + F.lane;
            GAS f32x4* o = (GAS f32x4*)(F.out + ((size_t)b * SEQL + (t - CTXL)) * DM) + F.lane;
#pragma unroll
            for (int j = 0; j < 4; ++j) o[64 * j] = v[j] * rstd * g[64 * j];
        }
    }
}

__device__ __forceinline__ void ph_conv(Frame& F, int l) {
    LAS float* U = (LAS float*)F.lds;
    const float* cw = F.in[12] + (size_t)l * 31 * 256 + 4 * F.lane;
    f32x4 w[31];
#pragma unroll
    for (int j = 0; j < 31; ++j) w[j] = *(const GAS f32x4*)(cw + j * 256);
    const f32x4 cbv = *(const GAS f32x4*)(F.in[13] + l * 256 + 4 * F.lane), lgv = *(const GAS f32x4*)(F.in[14] + l * 256 + 4 * F.lane), lbv = *(const GAS f32x4*)(F.in[15] + l * 256 + 4 * F.lane);
    const bf16* P = WSP(const bf16, WS_P);
    for (int tile = blockIdx.x; tile < NROW / 64; tile += F.G) {
        const int r0 = tile * 64, b = r0 / TPB, t0 = r0 - b * TPB;
        const int seg_lo = (t0 < CTXL) ? b * TPB : b * TPB + CTXL, seg_hi = (t0 < CTXL) ? b * TPB + CTXL : (b + 1) * TPB;
        for (int it = F.tid; it < 94 * 32; it += NWAVES * 64) { const int lr = it >> 5, chn = (it & 31) * 8, r = r0 - 15 + lr;
            f32x4 u0 = (f32x4){0.f, 0.f, 0.f, 0.f}, u1 = u0;
            if (r >= seg_lo && r < seg_hi) { const v4u cv = *(const GAS v4u*)(P + (size_t)r * INW + COL_CV + chn), cg = *(const GAS v4u*)(P + (size_t)r * INW + COL_CG + chn);
                u0.x = bflo(cv.x) * fsigmoid(bflo(cg.x)); u0.y = bfhi(cv.x) * fsigmoid(bfhi(cg.x)); u0.z = bflo(cv.y) * fsigmoid(bflo(cg.y)); u0.w = bfhi(cv.y) * fsigmoid(bfhi(cg.y));
                u1.x = bflo(cv.z) * fsigmoid(bflo(cg.z)); u1.y = bfhi(cv.z) * fsigmoid(bfhi(cg.z)); u1.z = bflo(cv.w) * fsigmoid(bflo(cg.w)); u1.w = bfhi(cv.w) * fsigmoid(bfhi(cg.w)); }
            *(LAS f32x4*)(U + lr * 256 + chn) = u0; *(LAS f32x4*)(U + lr * 256 + chn + 4) = u1; }
        __syncthreads();
        for (int i = F.wave; i < 64; i += NWAVES) {
            f32x4 y = cbv;
#pragma unroll
            for (int j = 0; j < 31; ++j) y = y + w[j] * *(const LAS f32x4*)(U + (i + j) * 256 + 4 * F.lane);
            const float mean = wave_sum((y.x + y.y) + (y.z + y.w)) * (1.0f / 256.0f);
            const f32x4 d = y - mean;
            const float var = wave_sum((d.x * d.x + d.y * d.y) + (d.z * d.z + d.w * d.w)) * (1.0f / 256.0f);
            const float rstd = 1.0f / sqrtf(var + EPS);
            f32x4 z = d * rstd * lgv + lbv;
            z.x *= fsigmoid(z.x); z.y *= fsigmoid(z.y); z.z *= fsigmoid(z.z); z.w *= fsigmoid(z.w);
            u2v o; o.x = pk2(z.x, z.y); o.y = pk2(z.z, z.w);
            *(GAS u2v*)(WSP(bf16, WS_MIX) + (size_t)(r0 + i) * DM + MIX_C + 4 * F.lane) = o;
        }
        __syncthreads();
    }
}

__device__ __forceinline__ int block_excl_scan(Frame& F, int v, LAS int* sc) {
    int inc = v;
#pragma unroll
    for (int o = 1; o < 64; o <<= 1) { const int t = __shfl_up(inc, o); if (F.lane >= o) inc += t; }
    if (F.lane == 63) sc[F.wave] = inc;
    __syncthreads();
    int base = 0;
#pragma unroll
    for (int w = 0; w < NWAVES; ++w) base += (w < F.wave) ? sc[w] : 0;
    __syncthreads();
    return base + inc - v;
}
__device__ __forceinline__ void topk_unit(Frame& F, int kind, int b, int e) {
    LAS unsigned* vals = (LAS unsigned*)F.lds;
    LAS unsigned* hist = vals + 8192;
    LAS int* sc = (LAS int*)(hist + 256);
    const int n = kind ? CTXL : SEQL, cap = kind ? CAPC : CAPL;
    const int row0 = b * TPB + (kind ? 0 : CTXL), slot0 = kind ? NBATCH * CAPL + b * CAPC : b * CAPL;
    const float* aff = WSP(const float, WS_AFF);
    for (int i = F.tid; i < n; i += NWAVES * 64) vals[i] = __float_as_uint(aff[(size_t)(row0 + i) * 16 + e]);
    __syncthreads();
    unsigned prefix = 0u; int need = cap;
    for (int round = 0; round < 4; ++round) {
        const int shift = 24 - 8 * round;
        if (F.tid < 256) hist[F.tid] = 0u;
        __syncthreads();
        for (int i = F.tid; i < n; i += NWAVES * 64) { const unsigned v = vals[i]; const bool match = (round == 0) || ((v >> (shift + 8)) == prefix); if (match) atomicAdd((unsigned*)&hist[(v >> shift) & 255u], 1u); }
        __syncthreads();
        if (F.wave == 0) {
            const unsigned h0 = hist[4 * F.lane], h1 = hist[4 * F.lane + 1], h2 = hist[4 * F.lane + 2], h3 = hist[4 * F.lane + 3];
            const unsigned s = h0 + h1 + h2 + h3; unsigned suf = s;
#pragma unroll
            for (int o = 1; o < 64; o <<= 1) { const unsigned t = __shfl_down(suf, o); if (F.lane + o < 64) suf += t; }
            const unsigned above = suf - s;
            if (above < (unsigned)need && (unsigned)need <= above + s) {
                unsigned a = above; int bin, nn;
                if ((unsigned)need <= a + h3) { bin = 3; nn = need - (int)a; } else { a += h3;
                if ((unsigned)need <= a + h2) { bin = 2; nn = need - (int)a; } else { a += h2;
                if ((unsigned)need <= a + h1) { bin = 1; nn = need - (int)a; } else { a += h1; bin = 0; nn = need - (int)a; } } }
                sc[0] = 4 * F.lane + bin; sc[1] = nn; }
        }
        __syncthreads();
        prefix = (prefix << 8) | (unsigned)sc[0]; need = sc[1];
        __syncthreads();
    }
    const unsigned T = prefix;
    const int cnt = kind ? (F.tid < CTXL ? 1 : 0) : 16, start = kind ? F.tid : 16 * F.tid;
    int ngt = 0, neq = 0;
    for (int i = 0; i < cnt; ++i) { const unsigned v = vals[start + i]; ngt += v > T ? 1 : 0; neq += v == T ? 1 : 0; }
    const int eqpre = block_excl_scan(F, neq, sc);
    int take = need - eqpre; take = take < 0 ? 0 : (take > neq ? neq : take);
    int pos = block_excl_scan(F, ngt + take, sc);
    int* idx = WSP(int, WS_IDX) + (size_t)e * ESLOTS + slot0;
    int* slot = WSP(int, WS_SLOT);
    for (int i = 0; i < cnt; ++i) { const unsigned v = vals[start + i]; int sl = -1;
        if (v > T) sl = pos++; else if (v == T && take > 0) { sl = pos++; --take; }
        const int r = row0 + start + i;
        slot[(size_t)r * 16 + e] = sl >= 0 ? slot0 + sl : -1;
        if (sl >= 0) idx[sl] = r; }
    if (kind == 1 && b == 0 && F.tid < ESLOTS - EUSED) WSP(int, WS_IDX)[(size_t)e * ESLOTS + EUSED + F.tid] = 0;
    __syncthreads();
}
__device__ __forceinline__ void ph_topk(Frame& F) {
    for (int u = blockIdx.x; u < 2 * NBATCH * NEXP; u += F.G) topk_unit(F, u / (NBATCH * NEXP), (u % (NBATCH * NEXP)) / NEXP, u % NEXP);
}
__device__ __forceinline__ void ph_dispatch(Frame& F) {
    const int gw = F.vcu * NWAVES + F.wave, NGW = F.G * NWAVES;
    for (int q = gw; q < NEXP * ESLOTS; q += NGW) {
        const int r = WSP(const int, WS_IDX)[q];
        const GAS v4u* s = (const GAS v4u*)(WSP(const bf16, WS_HN) + (size_t)r * DM) + F.lane;
        GAS v4u* d = (GAS v4u*)(WSP(bf16, WS_XE) + (size_t)q * DM) + F.lane;
        const v4u a = s[0], b2 = s[64]; d[0] = a; d[64] = b2;
    }
}


__device__ __forceinline__ void ph_attn(Frame& F, int l, bool last, char* shm) {
    typedef attn_body::bf16 abf;
    const abf* P = (const abf*)WSP(const bf16, WS_P); abf* MIX = (abf*)WSP(bf16, WS_MIX);
    for (int L = F.vcu; L < 7 * 256; L += F.G) {
        const int i = L >> 8, v = L & 255, x = v >> 5, j = v & 31;
        if (i == 4 || i == 5) {
            const int b = x >> 1, h = (x & 1) * 2 + (i - 4), gr0 = 4 * j, kr0 = gr0 - 4 < 0 ? 0 : (gr0 - 4 > 116 ? 116 : gr0 - 4);
            const size_t row0 = (size_t)b * TPB + CTXL + 256 * j, k0 = (size_t)b * TPB;
            attn_body::attn_unit<8, true>(P + row0 * INW + COL_QB + h * 64, P + k0 * INW + COL_KB + h * 64, P + k0 * INW + COL_VB + h * 64, MIX + row0 * DM + MIX_B + h * 64, 16, kr0, gr0, kr0,
                                          F.in[11] + (size_t)(l * 4 + h) * 465, shm);
        } else {
            size_t row0, k0; int qc, kc, vc, oc, NT;
            if (i < 4) { const int b = x >> 1, kvh = x & 1, h = kvh * 4 + i; row0 = (size_t)b * TPB + CTXL + 256 * j; k0 = (size_t)b * TPB; qc = COL_QA + h * 64; kc = COL_KA + kvh * 64; vc = COL_VA + kvh * 64; oc = MIX_A + h * 64; NT = TPB / 64; }
            else { int u = j * 8 + x; if (last || u >= 48) continue;
                if (u < 32) { const int b = u >> 3, h = u & 7; row0 = k0 = (size_t)b * TPB; qc = COL_QA + h * 64; kc = COL_KA + (h >> 2) * 64; vc = COL_VA + (h >> 2) * 64; oc = MIX_A + h * 64; }
                else { u -= 32; const int b = u >> 2, h = u & 3; row0 = k0 = (size_t)b * TPB; qc = COL_QB + h * 64; kc = COL_KB + h * 64; vc = COL_VB + h * 64; oc = MIX_B + h * 64; }
                NT = CTXL / 64; }
            attn_body::attn_unit<8, false>(P + row0 * INW + qc, P + k0 * INW + kc, P + k0 * INW + vc, MIX + row0 * DM + oc, NT, 0, 0, 0, nullptr, shm);
        }
    }
}

__device__ __forceinline__ void ph_post(Frame& F, int l) {
    bf16* P = WSP(bf16, WS_P); const float* qg = F.in[9] + l * 64; const float* kg = F.in[10] + l * 64; const float* rope = WSP(const float, WS_ROPE);
    for (int gid = blockIdx.x * (NWAVES * 64) + F.tid; gid < NROW * 14; gid += F.G * NWAVES * 64) {
    const int r = gid / 14, hs = gid % 14, b = r / TPB, t = r - b * TPB;
    bf16* p = P + (size_t)r * INW + (hs < 8 ? COL_QA + hs * 64 : hs < 10 ? COL_KA + (hs - 8) * 64 : COL_QB + (hs - 10) * 64);
    float v[64];
#pragma unroll
    for (int d = 0; d < 64; ++d) v[d] = bf2f(p[d]);
    if (hs < 10) {
        float ss = 0.f;
#pragma unroll
        for (int d = 0; d < 64; ++d) ss += v[d] * v[d];
        const float rstd = 1.0f / sqrtf(ss * (1.0f / 64.0f) + EPS);
        const float* g = hs < 8 ? qg : kg;
#pragma unroll
        for (int d = 0; d < 64; ++d) v[d] = v[d] * rstd * g[d];
        if (t >= CTXL) { const int tl = t - CTXL, pr = tl >> 6, pc = tl & 63;
#pragma unroll
            for (int j = 0; j < 16; ++j) {
                { const float c = rope[pr * 16 + j], s = rope[2048 + pr * 16 + j], x1 = v[j], x2 = v[16 + j]; v[j] = x1 * c - x2 * s; v[16 + j] = x2 * c + x1 * s; }
                { const float c = rope[pc * 16 + j], s = rope[2048 + pc * 16 + j], x1 = v[32 + j], x2 = v[48 + j]; v[32 + j] = x1 * c - x2 * s; v[48 + j] = x2 * c + x1 * s; } } }
    }
    const float sc = (hs < 8 || hs >= 10) ? C2 : 1.0f;
#pragma unroll
    for (int d = 0; d < 64; ++d) p[d] = (bf16)f2bf(v[d] * sc);
}
}

struct Args { const float* in[22]; float* out; unsigned char* ws; int ph_lo, ph_hi; };
__global__ void __launch_bounds__(NWAVES * 64, 2) mk_fwd(Args args) {
    extern __shared__ __attribute__((aligned(16))) unsigned char lds[];
    Frame F;
    F.lds = (LAS unsigned char*)lds;
    F.MISC = (volatile LAS unsigned*)(F.lds + MISC_OFF);
    F.tid = threadIdx.x; F.lane = F.tid & 63; F.wave = __builtin_amdgcn_readfirstlane(F.tid >> 6);
    F.G = gridDim.x; { const int bx = blockIdx.x; F.vcu = (F.G % 8 == 0) ? (bx % 8) * (F.G / 8) + bx / 8 : bx; }
    F.ws = args.ws; F.ctl = (gu32*)(args.ws + WS_CTL); F.out = args.out;
#pragma unroll
    for (int i = 0; i < 22; ++i) F.in[i] = args.in[i];
    for (int u = F.tid; u < (LDS_BYTES - LDSCTL_OFF) / 4; u += NWAVES * 64) ((LAS unsigned*)(F.lds + LDSCTL_OFF))[u] = 0u;
    __syncthreads();
    const int lo = args.ph_lo, hi = args.ph_hi;
    const bool multi = (hi - lo) > 1;
    XcdBarrier bar; bar.bar = (unsigned*)(F.ctl + CW_BAR); bar.x = 0; bar.st = nullptr;
    if (multi) bar = xcd_barrier_post((unsigned*)(F.ctl + CW_BAR), F.MISC + 8);
#define IN(k) (lo <= (k) && (k) < hi)
#define PHB() do { int t_ = threadIdx.x; asm volatile("" : "+v"(t_)); F.tid = t_; F.lane = t_ & 63; F.wave = __builtin_amdgcn_readfirstlane(t_ >> 6); } while (0)
#define SEAM(k) do { if (IN((k) + 1)) xcd_barrier(bar); } while (0)

    if (IN(0)) { PHB(); p0_prologue(F); SEAM(0); }
    for (int l = 0; l < DEPTH; ++l) {
        const int pb = 1 + l * NPL;
        if (IN(pb + LP_NORM1)) { PHB(); ph_norm1(F, l); SEAM(pb + LP_NORM1); }
        if (IN(pb + LP_INPROJ)) {
            pg8::Gemm g{WSP(const bf16, WS_HN), WSP(const bf16, WS_WIN) + (size_t)l * INW * DM, NROW, INW, DM}; pg8::StaticOrder S; S.init(NROW, INW, F.G, (int)blockIdx.x);
            pg8::EpiBf16<0> E{WSP(bf16, WS_P), INW, nullptr, 0, 0, 1.f};
            pg8::gemm_phase<pg8::EpiBf16<0>, pg8::StaticOrder, true, true>(F.lds + RING_OFF, g, S, E);
            SEAM(pb + LP_INPROJ);
        }
        if (IN(pb + LP_POST)) { PHB(); ph_post(F, l); SEAM(pb + LP_POST); }
        if (IN(pb + LP_MIX)) { PHB(); ph_attn(F, l, l == DEPTH - 1, (char*)lds + RING_OFF); PHB(); ph_conv(F, l); SEAM(pb + LP_MIX); }
        if (IN(pb + LP_OUTPROJ)) {
            pg8::Gemm g{WSP(const bf16, WS_MIX), WSP(const bf16, WS_WOUT) + (size_t)l * DM * DM, NROW, DM, DM}; pg8::StaticOrder S; S.init(NROW, DM, F.G, (int)blockIdx.x);
            pg8::EpiResGate E{WSP(float, WS_X), DM, WSP(const float, WS_MODV) + (size_t)l * 5 * 6 * 1024, 2};
            pg8::gemm_phase<pg8::EpiResGate, pg8::StaticOrder, true, true>(F.lds + RING_OFF, g, S, E);
            SEAM(pb + LP_OUTPROJ);
        }
        if (IN(pb + LP_NORM2)) { PHB(); ph_norm2(F, l); SEAM(pb + LP_NORM2); }
        if (IN(pb + LP_TOPK)) { PHB(); ph_topk(F); SEAM(pb + LP_TOPK); }
        if (IN(pb + LP_DISPATCH)) { PHB(); ph_dispatch(F); SEAM(pb + LP_DISPATCH); }
        if (IN(pb + LP_G1)) {
            pg8::Gemm g{WSP(const bf16, WS_XE), WSP(const bf16, WS_WGU) + (size_t)l * NEXP * 4096 * DM, NEXP * ESLOTS, 4096, DM}; pg8::StaticOrder S; S.init(NEXP * ESLOTS, 4096, F.G, (int)blockIdx.x, ETILES);
            pg8::EpiSwiGLU E{WSP(bf16, WS_H1), EDIM};
            pg8::gemm_phase<pg8::EpiSwiGLU, pg8::StaticOrder, true, true>(F.lds + RING_OFF, g, S, E);
            SEAM(pb + LP_G1);
        }
        if (IN(pb + LP_G2)) {
            pg8::Gemm g{WSP(const bf16, WS_H1), WSP(const bf16, WS_WD) + (size_t)l * NEXP * DM * EDIM, NEXP * ESLOTS, DM, EDIM}; pg8::StaticOrder S; S.init(NEXP * ESLOTS, DM, F.G, (int)blockIdx.x, ETILES);
            pg8::EpiBf16<0> E{WSP(bf16, WS_Y), DM, nullptr, 0, 0, 1.f};
            pg8::gemm_phase<pg8::EpiBf16<0>, pg8::StaticOrder, true, true>(F.lds + RING_OFF, g, S, E);
            SEAM(pb + LP_G2);
        }
    }
    if (IN(PH_FINAL)) { PHB(); ph_final(F); };
#undef IN
#undef SEAM
}

__global__ void __launch_bounds__(256) naive_attn_a(const bf16* P, bf16* MIX) {
    const int pm = blockIdx.x >> 3, h = blockIdx.x & 7, r = pm * 256 + threadIdx.x, b = pm / 33;
    const bool isctx = (pm % 33) == 0;
    const int k0 = b * TPB, nk = isctx ? CTXL : TPB, kvh = h >> 2;
    float q[64], o[64];
    const bf16* qp = P + (size_t)r * INW + COL_QA + h * 64;
#pragma unroll
    for (int d = 0; d < 64; ++d) { q[d] = bf2f(qp[d]); o[d] = 0.f; }
    float m = -1e30f, l = 0.f;
    for (int kk = 0; kk < nk; ++kk) {
        const bf16* kp = P + (size_t)(k0 + kk) * INW + COL_KA + kvh * 64; const bf16* vp = P + (size_t)(k0 + kk) * INW + COL_VA + kvh * 64;
        float s = 0.f;
#pragma unroll
        for (int d = 0; d < 64; ++d) s += q[d] * bf2f(kp[d]);
        const float mn = fmaxf(m, s), a = fexp2(m - mn), pp = fexp2(s - mn);
        l = l * a + pp;
#pragma unroll
        for (int d = 0; d < 64; ++d) o[d] = o[d] * a + pp * bf2f(vp[d]);
        m = mn;
    }
    const float il = 1.0f / l;
    bf16* op = MIX + (size_t)r * DM + MIX_A + h * 64;
#pragma unroll
    for (int d = 0; d < 64; ++d) op[d] = (bf16)f2bf(o[d] * il);
}
__global__ void __launch_bounds__(256) naive_attn_b(const bf16* P, bf16* MIX, const float* rpb  ) {
    const int pm = blockIdx.x >> 2, h = blockIdx.x & 3, r = pm * 256 + threadIdx.x, b = pm / 33;
    const bool isctx = (pm % 33) == 0;
    const int k0 = b * TPB;
    float q[64], o[64];
    const bf16* qp = P + (size_t)r * INW + COL_QB + h * 64;
#pragma unroll
    for (int d = 0; d < 64; ++d) { q[d] = bf2f(qp[d]); o[d] = 0.f; }
    float m = -1e30f, l = 0.f;
    const int tl = r - k0 - CTXL, gr = tl >> 6, gc = tl & 63;
    const int rs = min(max(gr - 4, 0), 120), cs = min(max(gc - 8, 0), 48);
    const int nk = isctx ? CTXL : CTXL + 128;
    for (int kk = 0; kk < nk; ++kk) {
        int krow; float bias = 0.f;
        if (kk < CTXL) krow = k0 + kk;
        else { const int w = (kk - CTXL) >> 4, j = (kk - CTXL) & 15, kr = rs + w, kc = cs + j; krow = k0 + CTXL + kr * 64 + kc; bias = rpb[(h * 15 + (kr - gr + 7)) * 31 + (kc - gc + 15)] * LOG2E; }
        const bf16* kp = P + (size_t)krow * INW + COL_KB + h * 64; const bf16* vp = P + (size_t)krow * INW + COL_VB + h * 64;
        float s = bias;
#pragma unroll
        for (int d = 0; d < 64; ++d) s += q[d] * bf2f(kp[d]);
        const float mn = fmaxf(m, s), a = fexp2(m - mn), pp = fexp2(s - mn);
        l = l * a + pp;
#pragma unroll
        for (int d = 0; d < 64; ++d) o[d] = o[d] * a + pp * bf2f(vp[d]);
        m = mn;
    }
    const float il = 1.0f / l;
    bf16* op = MIX + (size_t)r * DM + MIX_B + h * 64;
#pragma unroll
    for (int d = 0; d < 64; ++d) op[d] = (bf16)f2bf(o[d] * il);
}

extern "C" void kernel_launch(void* const* d_in, const int* in_sizes, int n_in, void* d_out, int out_size, void* d_ws, size_t ws_size, hipStream_t stream) {
    static int grid = 0;
    if (grid == 0) {
        if (n_in != 22 || in_sizes[0] != NBATCH * SEQL * DM || out_size != NBATCH * SEQL * DM || ws_size < WS_END) {
            fprintf(stderr, "kernel_launch: unexpected shapes (n_in %d, in0 %d, out %d, ws %zu; need ws >= %zu); nothing launched\n", n_in, n_in > 0 ? in_sizes[0] : -1, out_size, ws_size, (size_t)WS_END); grid = -1; return; }
        int dev = 0, cus = 0, per_cu = 0;
        if (hipGetDevice(&dev) != hipSuccess || hipDeviceGetAttribute(&cus, hipDeviceAttributeMultiprocessorCount, dev) != hipSuccess) { grid = -1; return; }
        if (hipFuncSetAttribute((const void*)mk_fwd, hipFuncAttributeMaxDynamicSharedMemorySize, LDS_BYTES) != hipSuccess) { fprintf(stderr, "kernel_launch: hipFuncSetAttribute failed\n"); grid = -1; return; }
        if (hipOccupancyMaxActiveBlocksPerMultiprocessor(&per_cu, (const void*)mk_fwd, NWAVES * 64, LDS_BYTES) != hipSuccess || per_cu < 1)
            fprintf(stderr, "kernel_launch: note: occupancy query reports %d workgroups per CU\n", per_cu);
        (void)hipGetLastError();
        grid = cus;
    }
    if (grid < 0) return;
    (void)hipMemsetAsync((char*)d_ws + WS_CTL, 0, CTL_ZERO_BYTES, stream);
    Args a{};
    for (int i = 0; i < 22; ++i) a.in[i] = (const float*)d_in[i];
    a.out = (float*)d_out; a.ws = (unsigned char*)d_ws;
    unsigned char* ws = (unsigned char*)d_ws;
#ifndef MK_PER_PHASE
    a.ph_lo = 0; a.ph_hi = NPH;
    hipLaunchKernelGGL(mk_fwd, dim3(grid), dim3(NWAVES * 64), LDS_BYTES, stream, a);
#else
    for (int ph = 0; ph < NPH; ++ph) { a.ph_lo = ph; a.ph_hi = ph + 1; hipLaunchKernelGGL(mk_fwd, dim3(grid), dim3(NWAVES * 64), LDS_BYTES, stream, a); }
#endif
}
```

```cpp
#include <hip/hip_runtime.h>
#include <cstdio>
#include <cstdint>
namespace pg8 {
#define PG8_LAS __attribute__((address_space(3)))
typedef unsigned short bf16_t;
typedef short bf16x8 __attribute__((ext_vector_type(8)));
typedef float f32x4 __attribute__((ext_vector_type(4)));
typedef unsigned u32x4 __attribute__((ext_vector_type(4)));
constexpr int BM = 256, BK = 64, HALF = 128, HTB = HALF * BK * 2  , STAGE_BYTES = 8 * HTB, NXCD = 8, WGM = 8;

__host__ __device__ __forceinline__ int lds_byte(int r, int c) { const int st = (r >> 4) * 2 + (c >> 5), rr = r & 15, cc = c & 31, ob = rr * 64 + cc * 2; return st * 1024 + (ob ^ (((ob >> 9) & 1) << 5)); }
__host__ __device__ __forceinline__ void stage_rc(int b, int& R, int& C) { const int st = b / 1024, sb = b % 1024, swz = sb ^ (((sb >> 9) & 1) << 5); R = (st >> 1) * 16 + swz / 64; C = (st & 1) * 32 + (swz % 64) / 2; }
__host__ __device__ __forceinline__ int perm32(int rho) { const int n = rho >> 4, i = rho & 15; return 8 * (i >> 2) + 4 * n + (i & 3); }

__host__ __device__ __forceinline__ int perm32x(int rho) { return 16 * ((rho >> 2) & 1) + (rho & 3) + 4 * (rho >> 3); }
typedef float pg8_f32x16 __attribute__((ext_vector_type(16)));
struct Unit { int pm, pn, pb; };
struct Gemm { const bf16_t* A; const bf16_t* Bt; int M, N, K; };

template <bool GATHER_> struct StaticOrderT {
    static constexpr bool GATHER = GATHER_; const PG8_LAS unsigned* offtab;
    int nM, nN, nwg, G, c, tpg, skipg, skipf, wgm;
    __host__ __device__ __forceinline__ void init(int M, int N, int G_, int c_, int tpg_ = 0, int skipg_ = 0, int skipf_ = 0, int wgm_ = WGM) { wgm = wgm_; nM = M / BM; if (skipg_) nM -= nM / skipg_; nN = N / BM; nwg = nM * nN; G = G_; c = c_; tpg = tpg_; skipg = skipg_; skipf = skipf_; }
    __host__ __device__ __forceinline__ bool next(int i, Unit& u) const {
        const long L = (long)i * G + c; if (L >= nwg) return false;
        int wgid = (int)L; { const int q = nwg / NXCD, r = nwg % NXCD, xcd = wgid % NXCD, off = wgid / NXCD; wgid = (xcd < r ? xcd * (q + 1) : r * (q + 1) + (xcd - r) * q) + off; }
        const int nig = wgm * nN, gid = wgid / nig, fm = gid * wgm, gsz = (nM - fm) < wgm ? (nM - fm) : wgm;
        u.pm = fm + ((wgid % nig) % gsz); u.pn = (wgid % nig) / gsz; if (skipg) u.pm = (u.pm / (skipg - 1)) * skipg + u.pm % (skipg - 1) + skipf; u.pb = tpg ? (u.pm / tpg) * nN + u.pn : u.pn; return true;
    }
    __device__ __forceinline__ void a_ready(const Unit&) const {}
    __device__ __forceinline__ void done(const Unit&) const {}
};
typedef StaticOrderT<false> StaticOrder; typedef StaticOrderT<true> GatherOrder;

__device__ __forceinline__ unsigned cvt_pk_bf16(float lo, float hi) { unsigned r; asm volatile("v_cvt_pk_bf16_f32 %0, %1, %2" : "=v"(r) : "v"(lo), "v"(hi)); return r; }
typedef float f32x2 __attribute__((ext_vector_type(2)));
__device__ __forceinline__ f32x2 gelu_pk(f32x2 v) {
    const f32x2 av = __builtin_elementwise_abs(v), d = av * 0.2316418882f + 1.0f;
    f32x2 t; t.x = __builtin_amdgcn_rcpf(d.x); t.y = __builtin_amdgcn_rcpf(d.y);
    f32x2 q = t * 0.5307027145f + (-0.7265760135f); q = q * t + 0.7107068705f; q = q * t + (-0.142248368f); q = q * t + 0.127414796f; q = q * t;
    const f32x2 s = (v * v) * (-0.72134752044f);
    f32x2 e; e.x = __builtin_amdgcn_exp2f(s.x); e.y = __builtin_amdgcn_exp2f(s.y);
    const f32x2 m = v * (q * e), r = v - m;
    f32x2 o; o.x = v.x < 0.f ? m.x : r.x; o.y = v.y < 0.f ? m.y : r.y; return o;
}

template <int ACT  > struct EpiBf16 {
    static constexpr bool PERM = true, AFTER_DRAIN = false, HEADMAP = false; static_assert(ACT == 0 || ACT == 1, "EpiBf16: ACT is 0 (none) or 1 (gelu_pk)");
    bf16_t* O; int ldc; const float* bias; int split_cols; size_t split_stride; float scale0;
    __device__ __forceinline__ void x32(const pg8_f32x16 (&acc)[2][2][2], const Unit& u, int wr, int wc, int lane) const {
        const int row0 = u.pm * BM + wr * 64 + (lane & 31), col0 = u.pn * BM + wc * 32 + 16 * (lane >> 5);
#pragma unroll
        for (int ai = 0; ai < 2; ++ai)
#pragma unroll
            for (int tb = 0; tb < 2; ++tb) { bf16_t* rowp = O + (size_t)(row0 + ai * HALF + tb * 32) * ldc + col0;
#pragma unroll
                for (int bj = 0; bj < 2; ++bj) { const pg8_f32x16 v = acc[ai][bj][tb]; u32x4 w0, w1;
                    w0.x = cvt_pk_bf16(v[0], v[1]); w0.y = cvt_pk_bf16(v[2], v[3]); w0.z = cvt_pk_bf16(v[4], v[5]); w0.w = cvt_pk_bf16(v[6], v[7]);
                    w1.x = cvt_pk_bf16(v[8], v[9]); w1.y = cvt_pk_bf16(v[10], v[11]); w1.z = cvt_pk_bf16(v[12], v[13]); w1.w = cvt_pk_bf16(v[14], v[15]);
                    *(u32x4*)(rowp + bj * HALF) = w0; *(u32x4*)(rowp + bj * HALF + 8) = w1; } }
    }
    __device__ __forceinline__ void operator()(const f32x4 (&acc)[2][2][4][2], const Unit& u, int wr, int wc, int fr, int fq) const {
        const int row0 = u.pm * BM + wr * 64 + fr; int colt = u.pn * BM; bf16_t* base = O;
        float sc = 1.f; if (split_cols) { const int t = colt / split_cols; base += (size_t)t * split_stride; colt -= t * split_cols; if (t == 0) sc = scale0; }
        const int col0 = colt + wc * 32 + 8 * fq, bcol0 = u.pn * BM + wc * 32 + 8 * fq;
        f32x4 bv[2][2];
#pragma unroll
        for (int bj = 0; bj < 2; ++bj)
#pragma unroll
            for (int n = 0; n < 2; ++n) bv[bj][n] = bias ? *(const f32x4*)(bias + bcol0 + bj * HALF + 4 * n) : (f32x4){0.f, 0.f, 0.f, 0.f};
#pragma unroll
        for (int ai = 0; ai < 2; ++ai)
#pragma unroll
            for (int m = 0; m < 4; ++m) { bf16_t* rowp = base + (size_t)(row0 + ai * HALF + m * 16) * ldc + col0;
#pragma unroll
                for (int bj = 0; bj < 2; ++bj) { f32x4 v0 = acc[ai][bj][m][0] + bv[bj][0], v1 = acc[ai][bj][m][1] + bv[bj][1];
                    if (ACT == 1) { f32x2 a = gelu_pk((f32x2){v0[0], v0[1]}), b = gelu_pk((f32x2){v0[2], v0[3]}), c = gelu_pk((f32x2){v1[0], v1[1]}), d = gelu_pk((f32x2){v1[2], v1[3]});
                        v0 = (f32x4){a.x, a.y, b.x, b.y}; v1 = (f32x4){c.x, c.y, d.x, d.y}; }
                    v0 = v0 * sc; v1 = v1 * sc; u32x4 w; w.x = cvt_pk_bf16(v0[0], v0[1]); w.y = cvt_pk_bf16(v0[2], v0[3]); w.z = cvt_pk_bf16(v1[0], v1[1]); w.w = cvt_pk_bf16(v1[2], v1[3]);
                    *(u32x4*)(rowp + bj * HALF) = w; } }
    }
};


struct EpiResGate {
    static constexpr bool PERM = true, AFTER_DRAIN = false, HEADMAP = false;
    bf16_t* X; int ldc; const float* gates; int q;
    __device__ __forceinline__ static float lo(unsigned w) { return __uint_as_float(w << 16); }
    __device__ __forceinline__ static float hi(unsigned w) { return __uint_as_float(w & 0xffff0000u); }
    __device__ __forceinline__ void operator()(const f32x4 (&acc)[2][2][4][2], const Unit& u, int wr, int wc, int fr, int fq) const {
        const int b = u.pm / 33, s = (u.pm % 33 == 0) ? 4 : b;
        const float* gv = gates + (size_t)(s * 6 + q) * 1024;
        const int col0 = u.pn * BM + wc * 32 + 8 * fq;
        f32x4 g[2][2];
#pragma unroll
        for (int bj = 0; bj < 2; ++bj)
#pragma unroll
            for (int n = 0; n < 2; ++n) g[bj][n] = *(const f32x4*)(gv + col0 + bj * HALF + 4 * n);
#pragma unroll
        for (int ai = 0; ai < 2; ++ai)
#pragma unroll
            for (int m = 0; m < 4; ++m) { bf16_t* rowp = X + (size_t)(u.pm * BM + ai * HALF + wr * 64 + m * 16 + fr) * ldc + col0;
#pragma unroll
                for (int bj = 0; bj < 2; ++bj) { u32x4* p = (u32x4*)(rowp + bj * HALF); const u32x4 w = *p;
                    const f32x4 v0 = (f32x4){lo(w.x), hi(w.x), lo(w.y), hi(w.y)} + g[bj][0] * acc[ai][bj][m][0], v1 = (f32x4){lo(w.z), hi(w.z), lo(w.w), hi(w.w)} + g[bj][1] * acc[ai][bj][m][1];
                    u32x4 o; o.x = cvt_pk_bf16(v0[0], v0[1]); o.y = cvt_pk_bf16(v0[2], v0[3]); o.z = cvt_pk_bf16(v1[0], v1[1]); o.w = cvt_pk_bf16(v1[2], v1[3]); *p = o; }
                if (m & 1) asm volatile("" ::: "memory"); }
    }
};

typedef unsigned u32x2 __attribute__((ext_vector_type(2)));
struct EpiInProj {
    static constexpr bool PERM = false, AFTER_DRAIN = false, HEADMAP = true;
    bf16_t* O; int ldc; const float* qg; const float* kg; const float* rope; float c2; unsigned char* Q8; unsigned char* K8;
    __device__ __forceinline__ static unsigned pack8(const f32x4 a, float s) { int w = __builtin_amdgcn_cvt_pk_fp8_f32(a[0] * s, a[1] * s, 0, false); w = __builtin_amdgcn_cvt_pk_fp8_f32(a[2] * s, a[3] * s, w, true); return (unsigned)w; }
    __device__ __forceinline__ static float dot4(const f32x4 a) { return (a[0] * a[0] + a[1] * a[1]) + (a[2] * a[2] + a[3] * a[3]); }
    __device__ __forceinline__ static u32x2 pack4(const f32x4 a) { u32x2 w; w.x = cvt_pk_bf16(a[0], a[1]); w.y = cvt_pk_bf16(a[2], a[3]); return w; }
    __device__ __forceinline__ void operator()(const f32x4 (&acc)[2][2][4][2], const Unit& u, int wr, int wc, int fr, int fq) const {
        const int mode = (u.pn < 2) ? 1 : (u.pn == 2) ? (wc < 2 ? 2 : 0) : (u.pn == 3) ? 3 : 0;
        int fq4 = 4 * fq; asm volatile("" : "+v"(fq4));
        const int tb = u.pm % 33; const bool lat = tb != 0;
        bf16_t* const obase = O + (size_t)(u.pm * BM + wr * 64 + fr) * ldc + u.pn * BM + 64 * wc + fq4;
        if (mode == 1 || mode == 2) {
            const float* gp = (mode == 1 ? qg : kg) + fq4; const float gs = (mode == 1) ? c2 : 1.0f; const float sc8 = sqrtf(c2), rs8 = 1.0f / sc8;
            f32x4 g[2][2];
#pragma unroll
            for (int bj = 0; bj < 2; ++bj)
#pragma unroll
                for (int n = 0; n < 2; ++n) g[bj][n] = *(const f32x4*)(gp + 32 * bj + 16 * n) * gs;
#pragma unroll
            for (int ai = 0; ai < 2; ++ai) {
                f32x4 cr = (f32x4){1.f, 1.f, 1.f, 1.f}, sr = (f32x4){0.f, 0.f, 0.f, 0.f};
                if (lat) { const int pr = 4 * (tb - 1) + 2 * ai + wr; cr = *(const f32x4*)(rope + pr * 16 + fq4); sr = *(const f32x4*)(rope + 2048 + pr * 16 + fq4); }
#pragma unroll
                for (int m = 0; m < 4; ++m) {
                    f32x4 x00 = acc[ai][0][m][0], x01 = acc[ai][0][m][1], x10 = acc[ai][1][m][0], x11 = acc[ai][1][m][1];
                    float ss = (dot4(x00) + dot4(x01)) + (dot4(x10) + dot4(x11));
                    ss += __shfl_xor(ss, 16); ss += __shfl_xor(ss, 32);
                    const float rstd = 1.0f / sqrtf(ss * (1.0f / 64.0f) + 1e-6f);
                    x00 = x00 * rstd * g[0][0]; x01 = x01 * rstd * g[0][1]; x10 = x10 * rstd * g[1][0]; x11 = x11 * rstd * g[1][1];
                    f32x4 y00 = x00, y01 = x01, y10 = x10, y11 = x11;
                    if (lat) { const int pc = 16 * m + fr; const f32x4 cc = *(const f32x4*)(rope + pc * 16 + fq4), sc = *(const f32x4*)(rope + 2048 + pc * 16 + fq4);
                        y00 = x00 * cr - x01 * sr; y01 = x01 * cr + x00 * sr; y10 = x10 * cc - x11 * sc; y11 = x11 * cc + x10 * sc; }
                    bf16_t* rowp = obase + (size_t)(ai * HALF + m * 16) * ldc;
                    *(u32x2*)(rowp) = pack4(y00); *(u32x2*)(rowp + 16) = pack4(y01); *(u32x2*)(rowp + 32) = pack4(y10); *(u32x2*)(rowp + 48) = pack4(y11);
                    { const size_t row = (size_t)(u.pm * BM + wr * 64 + fr + ai * HALF + m * 16); const float s8 = (mode == 1) ? rs8 : sc8;
                      unsigned char* p8 = (mode == 1) ? Q8 + row * 512 + u.pn * BM + 64 * wc + fq4 : K8 + row * 128 + 64 * wc + fq4;
                      *(unsigned*)(p8) = pack8(y00, s8); *(unsigned*)(p8 + 16) = pack8(y01, s8); *(unsigned*)(p8 + 32) = pack8(y10, s8); *(unsigned*)(p8 + 48) = pack8(y11, s8); }
                }
            }
        } else {
            const float sc = (mode == 3) ? c2 : 1.0f;
#pragma unroll
            for (int ai = 0; ai < 2; ++ai)
#pragma unroll
                for (int m = 0; m < 4; ++m) { bf16_t* rowp = obase + (size_t)(ai * HALF + m * 16) * ldc;
#pragma unroll
                    for (int bj = 0; bj < 2; ++bj)
#pragma unroll
                        for (int n = 0; n < 2; ++n) *(u32x2*)(rowp + 32 * bj + 16 * n) = pack4(acc[ai][bj][m][n] * sc); }
        }
    }
};
template <bool OUT8> struct EpiSwiGLUT {
    static constexpr bool PERM = true, AFTER_DRAIN = false, HEADMAP = false;
    bf16_t* O; int ldc;
    __device__ __forceinline__ static float swi(float g, float u) { const float e = __builtin_amdgcn_exp2f(-1.4426950408889634f * g); return g * __builtin_amdgcn_rcpf(1.0f + e) * u; }
    __device__ __forceinline__ void x32(const pg8_f32x16 (&acc)[2][2][2], const Unit& u, int wr, int wc, int lane) const {
        static_assert(OUT8, "EpiSwiGLUT::x32 writes the fp8 H1");
        int h16 = 16 * (lane >> 5); asm volatile("" : "+v"(h16));
        const int row0 = u.pm * BM + wr * 64 + (lane & 31), col0 = u.pn * HALF + wc * 32 + h16;
#pragma unroll
        for (int ai = 0; ai < 2; ++ai)
#pragma unroll
            for (int tb = 0; tb < 2; ++tb) { const pg8_f32x16 g = acc[ai][0][tb], v = acc[ai][1][tb]; int w[4];
#pragma unroll
                for (int q = 0; q < 4; ++q) { w[q] = __builtin_amdgcn_cvt_pk_fp8_f32(swi(g[4 * q], v[4 * q]), swi(g[4 * q + 1], v[4 * q + 1]), 0, false); w[q] = __builtin_amdgcn_cvt_pk_fp8_f32(swi(g[4 * q + 2], v[4 * q + 2]), swi(g[4 * q + 3], v[4 * q + 3]), w[q], true); }
                u32x4 w8; w8.x = (unsigned)w[0]; w8.y = (unsigned)w[1]; w8.z = (unsigned)w[2]; w8.w = (unsigned)w[3];
                *(u32x4*)((unsigned char*)O + (size_t)(row0 + ai * HALF + tb * 32) * ldc + col0) = w8; }
    }
    __device__ __forceinline__ void operator()(const f32x4 (&acc)[2][2][4][2], const Unit& u, int wr, int wc, int fr, int fq) const {
        int fq8 = 8 * fq; asm volatile("" : "+v"(fq8));
        const int row0 = u.pm * BM + wr * 64 + fr, col0 = u.pn * HALF + wc * 32 + fq8;
#pragma unroll
        for (int ai = 0; ai < 2; ++ai)
#pragma unroll
            for (int m = 0; m < 4; ++m) {
                const f32x4 g0 = acc[ai][0][m][0], g1 = acc[ai][0][m][1], u0 = acc[ai][1][m][0], u1 = acc[ai][1][m][1];
                const float h0 = swi(g0[0], u0[0]), h1 = swi(g0[1], u0[1]), h2 = swi(g0[2], u0[2]), h3 = swi(g0[3], u0[3]), h4 = swi(g1[0], u1[0]), h5 = swi(g1[1], u1[1]), h6 = swi(g1[2], u1[2]), h7 = swi(g1[3], u1[3]);
                if constexpr (OUT8) { unsigned char* p8 = (unsigned char*)O + (size_t)(row0 + ai * HALF + m * 16) * ldc + col0;
                    int w0 = __builtin_amdgcn_cvt_pk_fp8_f32(h0, h1, 0, false); w0 = __builtin_amdgcn_cvt_pk_fp8_f32(h2, h3, w0, true);
                    int w1 = __builtin_amdgcn_cvt_pk_fp8_f32(h4, h5, 0, false); w1 = __builtin_amdgcn_cvt_pk_fp8_f32(h6, h7, w1, true);
                    u32x2 w8; w8.x = (unsigned)w0; w8.y = (unsigned)w1; *(u32x2*)p8 = w8; }
                else { bf16_t* rowp = O + (size_t)(row0 + ai * HALF + m * 16) * ldc + col0;
                    u32x4 w; w.x = cvt_pk_bf16(h0, h1); w.y = cvt_pk_bf16(h2, h3); w.z = cvt_pk_bf16(h4, h5); w.w = cvt_pk_bf16(h6, h7); *(u32x4*)rowp = w; } }
    }
};
__device__ __forceinline__ void glds_sv(const void* sbase, unsigned voff, unsigned lds_dst) { unsigned keep;
    asm volatile("s_mov_b32 %0, m0\n\ts_mov_b32 m0, %3\n\ts_nop 0\n\tglobal_load_lds_dwordx4 %1, %2\n\ts_mov_b32 m0, %0" : "=&s"(keep) : "v"(voff), "s"(sbase), "s"(lds_dst) : "memory"); }
typedef int pg8_v8i __attribute__((ext_vector_type(8))); typedef int pg8_v4i __attribute__((ext_vector_type(4)));
__device__ __forceinline__ pg8_v8i cat8(const bf16x8 a, const bf16x8 b) { const pg8_v4i x = __builtin_bit_cast(pg8_v4i, a), y = __builtin_bit_cast(pg8_v4i, b); return (pg8_v8i){x[0], x[1], x[2], x[3], y[0], y[1], y[2], y[3]}; }
template <class Epi, class Sched, bool ALIGN_EPI = false, bool SP2 = false, int FP8 = 0  , int WSCALE = 127>
__device__ __forceinline__ void gemm_phase(PG8_LAS unsigned char* lds, const Gemm g, const Sched& S, const Epi& E) {
    int tid_ = threadIdx.x; asm volatile("" : "+v"(tid_));
    const int tid = tid_, wid = __builtin_amdgcn_readfirstlane(tid >> 6), lane = tid & 63, wr = wid >> 2, wc = wid & 3, fr = lane & 15, fq = lane >> 4;
    const int K = g.K, nt = K / BK;
    unsigned voffA[2], voffB[2]; int ra[2]; unsigned ca2[2];
    constexpr bool GATHER = Sched::GATHER;
    unsigned cvA[2][2];
#pragma unroll
    for (int i = 0; i < 2; ++i) { int R, C; stage_rc(tid * 16 + i * 8192, R, C); const int Rb = Epi::HEADMAP ? (64 * (R >> 5) + (R & 31)) : Epi::PERM ? ((R & ~31) + (FP8 == 2 ? perm32x(R & 31) : perm32(R & 31))) : R;
        voffA[i] = (unsigned)(R * K + C) * 2u; voffB[i] = (unsigned)(Rb * K + C) * 2u; ra[i] = R; ca2[i] = (unsigned)C * 2u; }
    const size_t kstep = (size_t)(BK * 2);
    const size_t hstep = (size_t)HALF * K * 2;
    const size_t hstepB = Epi::HEADMAP ? (size_t)32 * K * 2 : hstep;
    const size_t tstep = 2 * hstep;
    const unsigned ldsw = (unsigned)wid * 1024u;
    const int aoff = lds_byte(wr * 64 + fr, fq * 8), boff = lds_byte(wc * 32 + fr, fq * 8);
    const int r32 = lane & 31, hi5 = lane >> 5;
    const int aox1 = lds_byte(wr * 64 + r32, hi5 ? 24 : 0), aox2 = lds_byte(wr * 64 + r32, hi5 ? 16 : 8), box1 = lds_byte(wc * 32 + r32, hi5 ? 24 : 0), box2 = lds_byte(wc * 32 + r32, hi5 ? 16 : 8);
#define PG8_SA(b, h) (((b) * 2 + (h)) * HTB)
#define PG8_SB(b, h) ((4 + (b) * 2 + (h)) * HTB)
#define PG8_LDSADDR(p) ((unsigned)__builtin_amdgcn_readfirstlane((int)(unsigned)(unsigned long long)(p)))
#define PG8_STAGE(bufoff, gbase, voff) do { _Pragma("unroll") for (int _i = 0; _i < 2; ++_i) \
        glds_sv((const char*)(gbase), (voff)[_i], PG8_LDSADDR(lds + (bufoff) + ldsw + _i * 8192)); } while (0)
#define PG8_STAGE_A(bufoff, gbase, h, nx) do { _Pragma("unroll") for (int _i = 0; _i < 2; ++_i) { const unsigned vo_ = GATHER ? cvA[h][_i] : voffA[_i]; \
        glds_sv((const char*)(gbase) + (GATHER ? (size_t)0 : (size_t)(h) * hstep), vo_, PG8_LDSADDR(lds + (bufoff) + ldsw + _i * 8192)); } } while (0)
#define PG8_GNEXT() do { if constexpr (GATHER) { if (last && has_next) { int t2_ = tid; asm volatile("" : "+v"(t2_)); _Pragma("unroll") for (int i_ = 0; i_ < 2; ++i_) { int R_, C_; stage_rc(t2_ * 16 + i_ * 8192, R_, C_); \
        _Pragma("unroll") for (int h_ = 0; h_ < 2; ++h_) cvA[h_][i_] = S.offtab[(ui + 1) * BM + h_ * HALF + R_] + (unsigned)C_ * 2u; } } } } while (0)
#define PG8_LD8(p) ({ const pg8_v4i l_ = *(const PG8_LAS pg8_v4i*)(p), h_ = *(const PG8_LAS pg8_v4i*)((p) + 1024); (pg8_v8i){l_[0], l_[1], l_[2], l_[3], h_[0], h_[1], h_[2], h_[3]}; })
#define PG8_LD8X(p, q) ({ const pg8_v4i l_ = *(const PG8_LAS pg8_v4i*)(p), h_ = *(const PG8_LAS pg8_v4i*)(q); (pg8_v8i){l_[0], l_[1], l_[2], l_[3], h_[0], h_[1], h_[2], h_[3]}; })
#define PG8_LDA(dst, b, h) do { if constexpr (FP8 == 2) { _Pragma("unroll") for (int tb = 0; tb < 2; ++tb) _Pragma("unroll") for (int s_ = 0; s_ < 2; ++s_) dst##X[tb][s_] = PG8_LD8X(lds + PG8_SA(b, h) + aox1 + tb * 4096 + s_ * 1024, lds + PG8_SA(b, h) + aox2 + tb * 4096 + s_ * 1024); } \
        else if constexpr (FP8 == 1) { _Pragma("unroll") for (int m = 0; m < 4; ++m) dst##8[m] = PG8_LD8(lds + PG8_SA(b, h) + aoff + m * 2048); } \
        else { _Pragma("unroll") for (int m = 0; m < 4; ++m) _Pragma("unroll") for (int k = 0; k < 2; ++k) dst[m][k] = *(const PG8_LAS bf16x8*)(lds + PG8_SA(b, h) + aoff + m * 2048 + k * 1024); } } while (0)
#define PG8_LDB(dst, b, h) do { if constexpr (FP8 == 2) { _Pragma("unroll") for (int s_ = 0; s_ < 2; ++s_) dst##X[s_] = PG8_LD8X(lds + PG8_SB(b, h) + box1 + s_ * 1024, lds + PG8_SB(b, h) + box2 + s_ * 1024); } \
        else if constexpr (FP8 == 1) { _Pragma("unroll") for (int n = 0; n < 2; ++n) dst##8[n] = PG8_LD8(lds + PG8_SB(b, h) + boff + n * 2048); } \
        else { _Pragma("unroll") for (int n = 0; n < 2; ++n) _Pragma("unroll") for (int k = 0; k < 2; ++k) dst[n][k] = *(const PG8_LAS bf16x8*)(lds + PG8_SB(b, h) + boff + n * 2048 + k * 1024); } } while (0)
#define PG8_MMA(ai, bj, At, Bt) do { __builtin_amdgcn_s_setprio(1); if constexpr (FP8 == 2) { _Pragma("unroll") for (int s_ = 0; s_ < 2; ++s_) _Pragma("unroll") for (int tb = 0; tb < 2; ++tb) \
        accx[ai][bj][tb] = __builtin_amdgcn_mfma_scale_f32_32x32x64_f8f6f4(Bt##X[s_], At##X[tb][s_], accx[ai][bj][tb], 0, 0, 0, WSCALE * 0x01010101, 0, 0x7F7F7F7F); } \
        else _Pragma("unroll") for (int m = 0; m < 4; ++m) _Pragma("unroll") for (int n = 0; n < 2; ++n) { \
        if constexpr (FP8 == 1) acc[ai][bj][m][n] = __builtin_amdgcn_mfma_scale_f32_16x16x128_f8f6f4(Bt##8[n], At##8[m], acc[ai][bj][m][n], 0, 0, 0, WSCALE * 0x01010101, 0, 0x7F7F7F7F); \
        else { _Pragma("unroll") for (int k = 0; k < 2; ++k) acc[ai][bj][m][n] = __builtin_amdgcn_mfma_f32_16x16x32_bf16(Bt[n][k], At[m][k], acc[ai][bj][m][n], 0, 0, 0); } } __builtin_amdgcn_s_setprio(0); } while (0)
#define PG8_WAIT_V(n) asm volatile("s_waitcnt vmcnt(" #n ")" ::: "memory")
#define PG8_WAIT_L(n) asm volatile("s_waitcnt lgkmcnt(" #n ")" ::: "memory")
#define PG8_BAR __builtin_amdgcn_s_barrier()
#define PG8_SCHED __builtin_amdgcn_sched_barrier(0)
    Unit cur, nxt; int ui = 0;
    if (!S.next(0, cur)) return;
    f32x4 acc[2][2][4][2]; pg8_f32x16 accx[2][2][2];
    float zr_ = 0.f; asm volatile("" : "+v"(zr_));
#pragma unroll
    for (int a = 0; a < 2; ++a)
#pragma unroll
        for (int b = 0; b < 2; ++b)
{
#pragma unroll
            for (int m = 0; m < 4; ++m)
#pragma unroll
                for (int n = 0; n < 2; ++n) acc[a][b][m][n] = (f32x4){zr_, zr_, zr_, zr_};
            if constexpr (FP8 == 2) {
#pragma unroll
                for (int tb = 0; tb < 2; ++tb)
#pragma unroll
                    for (int r = 0; r < 16; ++r) accx[a][b][tb][r] = zr_; } }
    bf16x8 At[4][2], B0[2][2], B1[2][2]; pg8_v8i At8[4], B08[2], B18[2], AtX[2][2], B0X[2], B1X[2];
    const char* cA = GATHER ? (const char*)g.A : (const char*)g.A + (size_t)cur.pm * tstep; const char* cB = (const char*)g.Bt + (size_t)cur.pb * tstep;
    if constexpr (GATHER) {
#pragma unroll
        for (int h = 0; h < 2; ++h)
#pragma unroll
            for (int i = 0; i < 2; ++i) cvA[h][i] = S.offtab[h * HALF + ra[i]] + ca2[i]; }
    S.a_ready(cur);
    if constexpr (SP2) {
        PG8_STAGE(PG8_SB(0, 0), cB, voffB); PG8_STAGE(PG8_SB(0, 1), cB + hstepB, voffB); PG8_STAGE_A(PG8_SA(0, 0), cA, 0, false); PG8_STAGE_A(PG8_SA(0, 1), cA, 1, false);
        if (wr == 1) PG8_BAR;
        PG8_WAIT_V(2); PG8_BAR;
        PG8_STAGE(PG8_SB(1, 0), cB + kstep, voffB); PG8_STAGE_A(PG8_SA(1, 0), cA + kstep, 0, false); PG8_STAGE(PG8_SB(1, 1), cB + hstepB + kstep, voffB);
        PG8_WAIT_V(6); PG8_BAR;
    } else {
        PG8_STAGE(PG8_SB(0, 0), cB, voffB); PG8_STAGE_A(PG8_SA(0, 0), cA, 0, false); PG8_STAGE(PG8_SB(0, 1), cB + hstepB, voffB); PG8_STAGE_A(PG8_SA(0, 1), cA, 1, false);
        if (wr == 1) PG8_BAR;
        PG8_WAIT_V(4); PG8_BAR;
        PG8_STAGE(PG8_SB(1, 0), cB + kstep, voffB); PG8_STAGE_A(PG8_SA(1, 0), cA + kstep, 0, false); PG8_STAGE(PG8_SB(1, 1), cB + hstepB + kstep, voffB);
        PG8_WAIT_V(6); PG8_BAR;
    }
    for (;;) {
        const bool has_next = S.next(ui + 1, nxt);
        const char* nA = GATHER ? (const char*)g.A : has_next ? (const char*)g.A + (size_t)nxt.pm * tstep : cA; const char* nB = has_next ? (const char*)g.Bt + (size_t)nxt.pb * tstep : cB;
#pragma unroll 1
        for (int t = 0; t < nt; t += 2) {
            const bool last = (t == nt - 2);
            const char* a1 = cA + (size_t)(t + 1) * kstep;
            const char* a2 = last ? nA : cA + (size_t)(t + 2) * kstep; const char* b2 = last ? nB : cB + (size_t)(t + 2) * kstep;
            const char* a3 = a2 + kstep; const char* b3 = b2 + kstep;
            if (last && has_next) S.a_ready(nxt);
            if constexpr (SP2) {
            PG8_LDB(B0, 0, 0); PG8_LDB(B1, 0, 1); PG8_SCHED; PG8_LDA(At, 0, 0); PG8_STAGE_A(PG8_SA(1, 1), a1, 1, false); PG8_GNEXT();
            PG8_WAIT_V(8); PG8_WAIT_L(0); PG8_BAR; PG8_MMA(0, 0, At, B0); PG8_MMA(0, 1, At, B1); PG8_BAR; PG8_SCHED;
            PG8_LDA(At, 0, 1); PG8_STAGE(PG8_SB(0, 0), b2, voffB); PG8_STAGE(PG8_SB(0, 1), b2 + hstepB, voffB); PG8_STAGE_A(PG8_SA(0, 0), a2, 0, last);
            PG8_WAIT_V(8); PG8_WAIT_L(0); PG8_BAR; PG8_MMA(1, 0, At, B0); PG8_MMA(1, 1, At, B1); PG8_BAR; PG8_SCHED;
            PG8_LDB(B0, 1, 0); PG8_LDB(B1, 1, 1); PG8_SCHED; PG8_LDA(At, 1, 0); PG8_STAGE_A(PG8_SA(0, 1), a2, 1, last);
            PG8_WAIT_V(8); PG8_WAIT_L(0); PG8_BAR; PG8_MMA(0, 0, At, B0); PG8_MMA(0, 1, At, B1); PG8_BAR; PG8_SCHED;
            PG8_LDA(At, 1, 1); PG8_STAGE(PG8_SB(1, 0), b3, voffB); PG8_STAGE(PG8_SB(1, 1), b3 + hstepB, voffB); PG8_STAGE_A(PG8_SA(1, 0), a3, 0, last);
            PG8_WAIT_V(8); PG8_WAIT_L(0); PG8_BAR; PG8_MMA(1, 0, At, B0); PG8_MMA(1, 1, At, B1); PG8_BAR; PG8_SCHED;
            } else {
            PG8_LDB(B0, 0, 0); PG8_SCHED; PG8_LDA(At, 0, 0); PG8_STAGE_A(PG8_SA(1, 1), a1, 1, false); PG8_GNEXT();
            PG8_WAIT_L(8); PG8_BAR; PG8_WAIT_L(0); PG8_MMA(0, 0, At, B0); PG8_BAR; PG8_SCHED;
            PG8_LDB(B1, 0, 1); PG8_STAGE(PG8_SB(0, 0), b2, voffB);
            PG8_BAR; PG8_WAIT_L(0); PG8_MMA(0, 1, At, B1); PG8_BAR;
            PG8_LDA(At, 0, 1); PG8_STAGE_A(PG8_SA(0, 0), a2, 0, last);
            PG8_BAR; PG8_WAIT_L(0); PG8_MMA(1, 0, At, B0); PG8_BAR; PG8_SCHED;
            PG8_STAGE(PG8_SB(0, 1), b2 + hstepB, voffB);
            PG8_WAIT_V(6); PG8_BAR; PG8_MMA(1, 1, At, B1); PG8_BAR;
            PG8_LDB(B0, 1, 0); PG8_SCHED; PG8_LDA(At, 1, 0); PG8_STAGE_A(PG8_SA(0, 1), a2, 1, last);
            PG8_WAIT_L(8); PG8_BAR; PG8_WAIT_L(0); PG8_MMA(0, 0, At, B0); PG8_BAR; PG8_SCHED;
            PG8_LDB(B1, 1, 1); PG8_STAGE(PG8_SB(1, 0), b3, voffB);
            PG8_BAR; PG8_WAIT_L(0); PG8_MMA(0, 1, At, B1); PG8_BAR;
            PG8_LDA(At, 1, 1); PG8_STAGE_A(PG8_SA(1, 0), a3, 0, last);
            PG8_BAR; PG8_WAIT_L(0); PG8_MMA(1, 0, At, B0); PG8_BAR; PG8_SCHED;
            PG8_STAGE(PG8_SB(1, 1), b3 + hstepB, voffB);
            PG8_WAIT_V(6); PG8_BAR; PG8_MMA(1, 1, At, B1); PG8_BAR;
            }
        }
        if constexpr (ALIGN_EPI) { if (wr == 0) PG8_BAR; }
        if constexpr (!Epi::AFTER_DRAIN) { if constexpr (FP8 == 2) E.x32(accx, cur, wr, wc, lane); else E(acc, cur, wr, wc, fr, fq); S.done(cur); }
        if (!has_next) break;
#pragma unroll
        for (int a = 0; a < 2; ++a)
#pragma unroll
            for (int b = 0; b < 2; ++b)
{
#pragma unroll
                for (int m = 0; m < 4; ++m)
#pragma unroll
                    for (int n = 0; n < 2; ++n) acc[a][b][m][n] = (f32x4){zr_, zr_, zr_, zr_};
                if constexpr (FP8 == 2) {
#pragma unroll
                    for (int tb = 0; tb < 2; ++tb)
#pragma unroll
                        for (int r = 0; r < 16; ++r) accx[a][b][tb][r] = zr_; } }
        cur = nxt; cA = nA; cB = nB; ++ui;
        if constexpr (ALIGN_EPI) { if (wr == 1) PG8_BAR; }
    }
    PG8_WAIT_V(0);
    if constexpr (!ALIGN_EPI) { if (wr == 0) PG8_BAR; }
    PG8_BAR;
    if constexpr (Epi::AFTER_DRAIN) { E.fused(acc, cur, wr, wc, fr, fq, lds, wid, lane); S.done(cur); }
#undef PG8_SA
#undef PG8_SB
#undef PG8_STAGE
#undef PG8_STAGE_A
#undef PG8_LDA
#undef PG8_LD8
#undef PG8_LD8X
#undef PG8_LDB
#undef PG8_MMA
#undef PG8_WAIT_V
#undef PG8_WAIT_L
#undef PG8_BAR
#undef PG8_SCHED
}
}


#include <hip/hip_bf16.h>
#include <cmath>
namespace attn_body {
using bf16=__hip_bfloat16;
using bf16x8=__attribute__((ext_vector_type(8)))short;
using s16x4=__attribute__((ext_vector_type(4)))short;
using f32x16=__attribute__((ext_vector_type(16)))float;
using u32x4=__attribute__((ext_vector_type(4)))unsigned;
constexpr int D=64,KP=2048,OP=1024;
constexpr int NW=8,QBLK=32,QB=QBLK*NW,KVBLK=64;
__device__ __forceinline__ int crow(int r,int hi){return (r&3)+8*(r>>2)+4*hi;}
#define SBAR() __builtin_amdgcn_sched_barrier(0)
typedef __attribute__((address_space(3))) const float* lds_cfptr;
__device__ __forceinline__ void na_mask(f32x16&p0,f32x16&p1,bool rowok,int bidx,int d0,lds_cfptr tab){
  const float NEG=-INFINITY;
  if(!rowok){
    #pragma unroll
    for(int r=0;r<16;++r){p0[r]=NEG;p1[r]=NEG;}
  } else {
    #pragma unroll
    for(int r=0;r<16;++r){ const int c=(r&3)+8*(r>>2);
      const bool v0=(unsigned)(d0+c)<16u, v1=(unsigned)(d0+c+32)<16u;
      const float b0=tab[v0?bidx+c:0], b1=tab[v1?bidx+c+32:0];
      p0[r]=v0?p0[r]+b0:NEG; p1[r]=v1?p1[r]+b1:NEG; }
  }
}

constexpr int NSLOT=3, SLOTB=8192;
constexpr int LDS_K=0, LDS_V=NSLOT*SLOTB, LDS_WS=2*NSLOT*SLOTB, LDS_OST=LDS_WS+NW*64*4, LDS_BYTES=LDS_OST+NW*4096;
constexpr float C2=0.125f*1.4426950408889634f;
__device__ __forceinline__ void glds16(const void*gsrc,unsigned lds_dst){unsigned keep;
  asm volatile("s_mov_b32 %0, m0\n\ts_mov_b32 m0, %2\n\ts_nop 0\n\tglobal_load_lds_dwordx4 %1, off\n\ts_mov_b32 m0, %0":"=&s"(keep):"v"(gsrc),"s"(lds_dst):"memory");}
__device__ __forceinline__ float max3f(float a,float b,float c){float r;asm("v_max3_f32 %0, %1, %2, %3":"=v"(r):"v"(a),"v"(b),"v"(c));return r;}
__device__ __forceinline__ float max2f(float a,float b){float r;asm("v_max_f32_e32 %0, %1, %2":"=v"(r):"v"(a),"v"(b));return r;}
__device__ __forceinline__ float fadd_s(float a,float b){float r;asm("v_add_f32_e32 %0, %1, %2":"=v"(r):"v"(a),"v"(b));return r;}
__device__ __forceinline__ float fsub_s(float a,float b){float r;asm("v_sub_f32_e32 %0, %1, %2":"=v"(r):"v"(a),"v"(b));return r;}
typedef float f32x2_t __attribute__((ext_vector_type(2))); typedef __bf16 bf16x2_t __attribute__((ext_vector_type(2)));
__device__ __forceinline__ unsigned cvtpk_s(float lo,float hi){f32x2_t v={lo,hi};bf16x2_t b=__builtin_convertvector(v,bf16x2_t);return __builtin_bit_cast(unsigned,b);}
#define WAIT_BAR(N) asm volatile("s_waitcnt vmcnt(" #N ") lgkmcnt(0)\n\ts_barrier":::"memory")

__device__ __forceinline__ void qkt(f32x16&p0,f32x16&p1,const char*Kslot,const bf16x8*qr,const f32x16&negm,int r32,int hi){
  const char*kb=Kslot+hi*1024+r32*16;
  #pragma unroll
  for(int d0=0;d0<4;++d0){
    const bf16x8 b0=*reinterpret_cast<const bf16x8*>(kb+d0*2048);
    const bf16x8 b1=*reinterpret_cast<const bf16x8*>(kb+d0*2048+512);
    if(d0==0){p0=__builtin_amdgcn_mfma_f32_32x32x16_bf16(b0,qr[0],negm,0,0,0);p1=__builtin_amdgcn_mfma_f32_32x32x16_bf16(b1,qr[0],negm,0,0,0);}
    else{p0=__builtin_amdgcn_mfma_f32_32x32x16_bf16(b0,qr[d0],p0,0,0,0);p1=__builtin_amdgcn_mfma_f32_32x32x16_bf16(b1,qr[d0],p1,0,0,0);}}
}
typedef __attribute__((address_space(3))) const char* lds_cptr;
typedef short v4i16_t __attribute__((ext_vector_type(4)));
__device__ __forceinline__ void kload8(bf16x8*kf,lds_cptr kp){
  kf[0]=*(const __attribute__((address_space(3))) bf16x8*)(kp);      kf[1]=*(const __attribute__((address_space(3))) bf16x8*)(kp+512);
  kf[2]=*(const __attribute__((address_space(3))) bf16x8*)(kp+2048); kf[3]=*(const __attribute__((address_space(3))) bf16x8*)(kp+2560);
  kf[4]=*(const __attribute__((address_space(3))) bf16x8*)(kp+4096); kf[5]=*(const __attribute__((address_space(3))) bf16x8*)(kp+4608);
  kf[6]=*(const __attribute__((address_space(3))) bf16x8*)(kp+6144); kf[7]=*(const __attribute__((address_space(3))) bf16x8*)(kp+6656);
}
__device__ __forceinline__ void kload2(bf16x8*kf,lds_cptr kp,int j){ kf[2*j]=*(const __attribute__((address_space(3))) bf16x8*)(kp+j*2048); kf[2*j+1]=*(const __attribute__((address_space(3))) bf16x8*)(kp+j*2048+512); }
__device__ __forceinline__ s16x4 vtr(lds_cptr p){ return __builtin_bit_cast(s16x4,__builtin_amdgcn_ds_read_tr16_b64_v4i16((__attribute__((address_space(3))) v4i16_t*)p)); }
__device__ __forceinline__ float rowmax(const f32x16&p0,const f32x16&p1){
  float a=max3f(p0[0],p0[1],p1[0]),b=max3f(p0[2],p0[3],p1[1]);a=max3f(a,p1[2],p1[3]);
  #pragma unroll
  for(int r=4;r<16;r+=4){a=max3f(a,p0[r],p0[r+1]);b=max3f(b,p0[r+2],p0[r+3]);a=max3f(a,p1[r],p1[r+1]);b=max3f(b,p1[r+2],p1[r+3]);}
  const float m=max2f(a,b);
  auto rr=__builtin_amdgcn_permlane32_swap(__float_as_uint(m),__float_as_uint(m),false,false);
  return max2f(__uint_as_float(rr[0]),__uint_as_float(rr[1]));
}
__device__ __forceinline__ void pv(f32x16*o,int vb,bf16x8 pa0,bf16x8 pa1,bf16x8 pa2,bf16x8 pa3){
  #pragma unroll
  for(int d0=0;d0<2;++d0){s16x4 lo[4],hi[4];
    #pragma unroll
    for(int ks=0;ks<4;++ks){
      asm volatile("ds_read_b64_tr_b16 %0,%1 offset:%c2":"=&v"(lo[ks]):"v"(vb),"i"(d0*4096+ks*1024):"memory");
      asm volatile("ds_read_b64_tr_b16 %0,%1 offset:%c2":"=&v"(hi[ks]):"v"(vb),"i"(d0*4096+ks*1024+512):"memory");}
    asm volatile("s_waitcnt lgkmcnt(0)":::"memory");SBAR();
    #define PK(k) (bf16x8){lo[k][0],lo[k][1],lo[k][2],lo[k][3],hi[k][0],hi[k][1],hi[k][2],hi[k][3]}
    o[d0]=__builtin_amdgcn_mfma_f32_32x32x16_bf16(pa0,PK(0),o[d0],0,0,0);
    o[d0]=__builtin_amdgcn_mfma_f32_32x32x16_bf16(pa1,PK(1),o[d0],0,0,0);
    o[d0]=__builtin_amdgcn_mfma_f32_32x32x16_bf16(pa2,PK(2),o[d0],0,0,0);
    o[d0]=__builtin_amdgcn_mfma_f32_32x32x16_bf16(pa3,PK(3),o[d0],0,0,0);
    #undef PK
  }
}

#ifndef ATTN_STORE16
#define ATTN_STORE16(p,v) (*(u32x4*)(p)=(v))
#endif
constexpr bool LSUM_MFMA=false;
template<int THRL,bool NA,bool FIXM,int DBG=0> __device__ __forceinline__ void attn_unit(const bf16*Qu,const bf16*__restrict__ Kh,const bf16*__restrict__ Vh,bf16*Ou,const int NT,const int tskip,const int gr0,const int kr0,const float*rpbh,const float m0,char*shm){
  int tid_=threadIdx.x; asm volatile("":"+v"(tid_));
  const int tid=tid_,lane=tid&63,r32=lane&31,hi=lane>>5; const int wid=__builtin_amdgcn_readfirstlane(tid>>6);
  const bf16*Qw=Qu+(long)(wid*QBLK)*KP;
  const unsigned lds0=(unsigned)(uintptr_t)shm;
  float*wsf=(float*)(shm+LDS_WS)+wid*64;
  const bf16*ksrc=Kh+(long)lane*KP+wid*8;
  const bf16*vsrc=Vh+(long)(16*(wid&3)+(lane>>2))*KP+(wid>>2)*32+(lane&3)*8;
  const unsigned kdst=lds0+LDS_K+wid*1024, vdst=lds0+LDS_V+wid*1024;
  #define TROW(t) ((long)(((t)<4)?(t):(t)+tskip)*(KVBLK*KP))
  #define DMA_K(t,slot) glds16(ksrc+TROW(t),(unsigned)__builtin_amdgcn_readfirstlane(kdst+(slot)))
  #define DMA_V(t,slot) glds16(vsrc+TROW(t),(unsigned)__builtin_amdgcn_readfirstlane(vdst+(slot)))
  const int vb0=(int)(lds0+LDS_V)+((lane>>4)&1)*32+(lane&3)*8+(4*hi+((lane&15)>>2))*64;
  const char*Kbase=shm+LDS_K; bf16x8 kf[8];
  const lds_cptr shm3=(lds_cptr)shm; const lds_cptr kp0=shm3+LDS_K+hi*1024+r32*16; const lds_cptr vp0=shm3+LDS_V+((lane>>4)&1)*32+(lane&3)*8+(4*hi+((lane&15)>>2))*64;
  DMA_K(0,0);DMA_V(0,0);DMA_K(1,SLOTB);
  bf16x8 qr[4];
  #pragma unroll
  for(int d0=0;d0<4;++d0)qr[d0]=*reinterpret_cast<const bf16x8*>(&Qw[(long)r32*KP+d0*16+hi*8]);
  float mhat=0.f,l_reg=0.f;f32x16 o[2];o[0]=f32x16{};o[1]=f32x16{};f32x16 negm=f32x16{}; if constexpr(!FIXM){ asm volatile("":"+v"(negm)); }
  constexpr bool LM=FIXM&&LSUM_MFMA;
  f32x16 lacc=f32x16{}; const f32x16 zero16=f32x16{}; const bf16x8 onesv={(short)0x3F80,(short)0x3F80,(short)0x3F80,(short)0x3F80,(short)0x3F80,(short)0x3F80,(short)0x3F80,(short)0x3F80}; (void)m0;
  #define CIN (FIXM?zero16:negm)
  const int gr_=gr0+(wid>>1), gc_=32*(wid&1)+r32, rs_=min(max(gr_-4,0),120), cs_=min(max(gc_-8,0),48), bb_=15-gc_+4*hi, d0_=4*hi-cs_;
  const lds_cfptr tab=(lds_cfptr)(shm3+LDS_BYTES);
  if constexpr(NA){ __attribute__((address_space(3))) float*tw=(__attribute__((address_space(3))) float*)(shm3+LDS_BYTES); for(int i=tid;i<465;i+=NW*64)tw[i]=rpbh[i]*1.4426950408889634f; }
  #define CMASK(P0,P1,t) do{ if constexpr(NA){ if((t)>=4){ const int kr_=kr0+(t)-4; na_mask(P0,P1,(kr_>=rs_&&kr_<rs_+8),(kr_-gr_+7)*31+bb_,d0_,tab); } } }while(0)
  bool resc=false;
  #define START(P0,P1) do{ resc=false; if constexpr(!FIXM) \
    { const float rm=rowmax(P0,P1); const float dl=rm; mhat=fadd_s(mhat,dl); \
      _Pragma("unroll") for(int r=0;r<16;++r){P0[r]=fsub_s(P0[r],dl);P1[r]=fsub_s(P1[r],dl);} \
      _Pragma("unroll") for(int r=0;r<16;++r)negm[r]=-mhat; asm volatile("":"+v"(negm)); } \
    _Pragma("unroll") for(int r=0;r<16;++r)P0[r]=__builtin_amdgcn_exp2f(P0[r]); }while(0)
  #define RESC() do{ if(resc){ asm volatile("s_waitcnt lgkmcnt(0)":::"memory"); \
      _Pragma("unroll") for(int d_=0;d_<2;++d_) _Pragma("unroll") for(int r=0;r<16;++r)o[d_][r]*=wsf[crow(r,hi)]; } }while(0)
  f32x16 pA0,pA1,pB0,pB1;
  int sl_prev=0,sl_cur=0,sl_next=SLOTB;
  #define ROT() do{sl_prev=sl_cur;sl_cur=sl_next;sl_next=(sl_next==(NSLOT-1)*SLOTB)?0:sl_next+SLOTB;}while(0)
  DMA_K(2,2*SLOTB);
  WAIT_BAR(3);
  qkt(pA0,pA1,Kbase,qr,CIN,r32,hi);asm volatile("s_nop 15\n\ts_nop 7":"+v"(pA0),"+v"(pA1));CMASK(pA0,pA1,0);
  START(pA0,pA1);
  _Pragma("unroll") for(int r=0;r<16;++r)pA1[r]=__builtin_amdgcn_exp2f(pA1[r]);
  WAIT_BAR(0);
  DMA_K(3,0);DMA_V(1,SLOTB);
  ROT();
  kload8(kf,kp0+sl_cur);
  WAIT_BAR(2);
  s16x4 vlo[8],vhi[8]; u32x4 pw0,pw1,pw2,pw3;
  #define PKW(P,B) cvtpk_s(P[B],P[B+1])
  #define PAF(k) __builtin_bit_cast(bf16x8,pw##k)
  #define VFR(i) (bf16x8){vlo[i][0],vlo[i][1],vlo[i][2],vlo[i][3],vhi[i][0],vhi[i][1],vhi[i][2],vhi[i][3]}
  #define PIN(x) asm volatile("":"+v"(x))
  #define MX3(a,b,c) __builtin_fmaxf(__builtin_fmaxf((a),(b)),(c))
  #define GAPA(MF,A0,A1,A2,A3,W0,W1,PW) do{ MF; if constexpr(!LM&&DBG!=2&&DBG!=3){ sacc+=A0; sacc+=A1; sacc+=A2; sacc+=A3; PIN(sacc); } W0; W1; PIN(PW); SBAR(); }while(0)
  #define EX(v) ((DBG==1||DBG==3)?(v):__builtin_amdgcn_exp2f(v))
  #define GAPB(MF,X,B) do{ MF; X[B]=EX(X[B]); X[B+1]=EX(X[B+1]); X[B+2]=EX(X[B+2]); X[B+3]=EX(X[B+3]); PIN(X); SBAR(); }while(0)
  #define GAPB3(MF,X,B) do{ MF; X[B]=EX(X[B]); X[B+1]=EX(X[B+1]); X[B+2]=EX(X[B+2]); PIN(X); SBAR(); }while(0)
  #define GAPB2(MF,X,B) do{ MF; X[B]=EX(X[B]); X[B+1]=EX(X[B+1]); PIN(X); SBAR(); }while(0)
  #define LMF(k) lacc=__builtin_amdgcn_mfma_f32_32x32x16_bf16(PAF(k),onesv,lacc,0,0,0)
  #define VRD(i) do{ vlo[i]=vtr(vp_+(((i)>>2)*4096+((i)&3)*1024)); vhi[i]=vtr(vp_+(((i)>>2)*4096+((i)&3)*1024+512)); }while(0)
  #define KRD(G,j) do{ if(G){ kload2(kf,kp0+sl_next,j); SBAR(); } }while(0)
  #define STEP(C0,C1,P0,P1,t,GK,GV,GL) do{ SBAR(); \
    const lds_cptr vp_=vp0+sl_prev; \
    VRD(0); SBAR(); float sacc=0.f; if constexpr(!LM) sacc=(P0[0]+P0[1]); \
    GAPA(C0=__builtin_amdgcn_mfma_f32_32x32x16_bf16(kf[0],qr[0],CIN,0,0,0), P0[2],P0[3],P0[4],P0[5],     pw0[0]=PKW(P0,0), pw0[1]=PKW(P0,2), pw0); \
    VRD(4); SBAR(); GAPA(C1=__builtin_amdgcn_mfma_f32_32x32x16_bf16(kf[1],qr[0],CIN,0,0,0), P0[6],P0[7],P0[8],P0[9],     pw0[2]=PKW(P0,4), pw0[3]=PKW(P0,6), pw0); \
    VRD(1); SBAR(); GAPA(C0=__builtin_amdgcn_mfma_f32_32x32x16_bf16(kf[2],qr[1],C0,0,0,0),   P0[10],P0[11],P0[12],P0[13], pw1[0]=PKW(P0,8), pw1[1]=PKW(P0,10), pw1); \
    VRD(5); SBAR(); GAPA(C1=__builtin_amdgcn_mfma_f32_32x32x16_bf16(kf[3],qr[1],C1,0,0,0),   P0[14],P0[15],P1[0],P1[1],   pw1[2]=PKW(P0,12),pw1[3]=PKW(P0,14), pw1); \
    VRD(2); SBAR(); GAPA(C0=__builtin_amdgcn_mfma_f32_32x32x16_bf16(kf[4],qr[2],C0,0,0,0),   P1[2],P1[3],P1[4],P1[5],     pw2[0]=PKW(P1,0), pw2[1]=PKW(P1,2), pw2); \
    VRD(6); SBAR(); GAPA(C1=__builtin_amdgcn_mfma_f32_32x32x16_bf16(kf[5],qr[2],C1,0,0,0),   P1[6],P1[7],P1[8],P1[9],     pw2[2]=PKW(P1,4), pw2[3]=PKW(P1,6), pw2); \
    VRD(3); SBAR(); GAPA(C0=__builtin_amdgcn_mfma_f32_32x32x16_bf16(kf[6],qr[3],C0,0,0,0),   P1[10],P1[11],P1[12],P1[13], pw3[0]=PKW(P1,8), pw3[1]=PKW(P1,10), pw3); \
    VRD(7); SBAR(); GAPA(C1=__builtin_amdgcn_mfma_f32_32x32x16_bf16(kf[7],qr[3],C1,0,0,0),   P1[14],P1[15],0.f,0.f,       pw3[2]=PKW(P1,12),pw3[3]=PKW(P1,14), pw3); \
    if constexpr(!LM) l_reg+=sacc; \
    if(GK){DMA_K((t)+3,sl_cur);} if(GV){DMA_V((t)+1,sl_next);} \
    CMASK(C0,C1,t); \
    if constexpr(!FIXM) { float a=MX3(C0[0],C0[1],C1[0]),b=MX3(C0[2],C0[3],C1[1]); a=MX3(a,C1[2],C1[3]); \
      _Pragma("unroll") for(int r=4;r<16;r+=4){a=MX3(a,C0[r],C0[r+1]);b=MX3(b,C0[r+2],C0[r+3]);a=MX3(a,C1[r],C1[r+1]);b=MX3(b,C1[r+2],C1[r+3]);} \
      float rm=__builtin_fmaxf(a,b); { auto rr=__builtin_amdgcn_permlane32_swap(__float_as_uint(rm),__float_as_uint(rm),false,false); rm=__builtin_fmaxf(__uint_as_float(rr[0]),__uint_as_float(rr[1])); } \
      resc=false; \
      if(__builtin_expect(__any(rm>(float)THRL),0)){ const float dl=__builtin_fmaxf(rm,0.f); mhat+=dl; \
        _Pragma("unroll") for(int r=0;r<16;++r){C0[r]-=dl;C1[r]-=dl;} \
        _Pragma("unroll") for(int r=0;r<16;++r)negm[r]=-mhat; asm volatile("":"+v"(negm)); \
        const float f=__builtin_amdgcn_exp2f(-dl); l_reg*=f; if(hi==0)wsf[r32]=f; resc=true; } } \
    SBAR(); \
    if constexpr(LM){ \
    GAPB3(o[0]=__builtin_amdgcn_mfma_f32_32x32x16_bf16(PAF(0),VFR(0),o[0],0,0,0), C0,0); \
    GAPB3(o[1]=__builtin_amdgcn_mfma_f32_32x32x16_bf16(PAF(0),VFR(4),o[1],0,0,0), C0,3); \
    GAPB2(LMF(0), C0,6); \
    KRD(GL,0); GAPB3(o[0]=__builtin_amdgcn_mfma_f32_32x32x16_bf16(PAF(1),VFR(1),o[0],0,0,0), C0,8); \
    KRD(GL,1); GAPB3(o[1]=__builtin_amdgcn_mfma_f32_32x32x16_bf16(PAF(1),VFR(5),o[1],0,0,0), C0,11); \
    GAPB2(LMF(1), C0,14); \
    KRD(GL,2); GAPB3(o[0]=__builtin_amdgcn_mfma_f32_32x32x16_bf16(PAF(2),VFR(2),o[0],0,0,0), C1,0); \
    KRD(GL,3); GAPB3(o[1]=__builtin_amdgcn_mfma_f32_32x32x16_bf16(PAF(2),VFR(6),o[1],0,0,0), C1,3); \
    GAPB2(LMF(2), C1,6); \
    GAPB3(o[0]=__builtin_amdgcn_mfma_f32_32x32x16_bf16(PAF(3),VFR(3),o[0],0,0,0), C1,8); \
    GAPB3(o[1]=__builtin_amdgcn_mfma_f32_32x32x16_bf16(PAF(3),VFR(7),o[1],0,0,0), C1,11); \
    GAPB2(LMF(3), C1,14); \
    } else { \
    GAPB(o[0]=__builtin_amdgcn_mfma_f32_32x32x16_bf16(PAF(0),VFR(0),o[0],0,0,0), C0,0); \
    GAPB(o[1]=__builtin_amdgcn_mfma_f32_32x32x16_bf16(PAF(0),VFR(4),o[1],0,0,0), C0,4); \
    KRD(GL,0); GAPB(o[0]=__builtin_amdgcn_mfma_f32_32x32x16_bf16(PAF(1),VFR(1),o[0],0,0,0), C0,8); \
    KRD(GL,1); GAPB(o[1]=__builtin_amdgcn_mfma_f32_32x32x16_bf16(PAF(1),VFR(5),o[1],0,0,0), C0,12); \
    KRD(GL,2); GAPB(o[0]=__builtin_amdgcn_mfma_f32_32x32x16_bf16(PAF(2),VFR(2),o[0],0,0,0), C1,0); \
    KRD(GL,3); GAPB(o[1]=__builtin_amdgcn_mfma_f32_32x32x16_bf16(PAF(2),VFR(6),o[1],0,0,0), C1,4); \
    GAPB(o[0]=__builtin_amdgcn_mfma_f32_32x32x16_bf16(PAF(3),VFR(3),o[0],0,0,0), C1,8); \
    GAPB(o[1]=__builtin_amdgcn_mfma_f32_32x32x16_bf16(PAF(3),VFR(7),o[1],0,0,0), C1,12); \
    } \
    }while(0)
  int t=1;
  for(;t+5<NT;t+=2){
    STEP(pB0,pB1,pA0,pA1,t,true,true,true);     WAIT_BAR(2); RESC(); ROT();
    STEP(pA0,pA1,pB0,pB1,t+1,true,true,true);   WAIT_BAR(2); RESC(); ROT();
  }
  #define ENDW(tt) do{ if((tt)+3<NT){WAIT_BAR(2);} else if((tt)+2<NT){WAIT_BAR(1);} else {WAIT_BAR(0);} }while(0)
  for(;t+1<NT;t+=2){
    STEP(pB0,pB1,pA0,pA1,t,(t+3<NT),(t+1<NT),(t+1<NT));       ENDW(t);   RESC(); ROT();
    STEP(pA0,pA1,pB0,pB1,t+1,(t+4<NT),(t+2<NT),(t+2<NT));     ENDW(t+1); RESC(); ROT();
  }
  STEP(pB0,pB1,pA0,pA1,NT-1,false,false,false); RESC();
  { if constexpr(!LM){ float sacc=pB0[0]+pB0[1]; _Pragma("unroll") for(int r=2;r<16;++r)sacc+=pB0[r]; _Pragma("unroll") for(int r=0;r<16;++r)sacc+=pB1[r]; l_reg+=sacc; }
    pw0=(u32x4){PKW(pB0,0),PKW(pB0,2),PKW(pB0,4),PKW(pB0,6)};pw1=(u32x4){PKW(pB0,8),PKW(pB0,10),PKW(pB0,12),PKW(pB0,14)};pw2=(u32x4){PKW(pB1,0),PKW(pB1,2),PKW(pB1,4),PKW(pB1,6)};pw3=(u32x4){PKW(pB1,8),PKW(pB1,10),PKW(pB1,12),PKW(pB1,14)};
    SBAR(); if constexpr(LM){ LMF(0); LMF(1); LMF(2); LMF(3); } pv(o,vb0+sl_cur,PAF(0),PAF(1),PAF(2),PAF(3)); }
  #undef PKW
  #undef PAF
  #undef VFR
  #undef PIN
  #undef MX3
  #undef GAPA
  #undef GAPB
  #undef GAPB3
  #undef GAPB2
  #undef LMF
  #undef EX
  #undef VRD
  #undef KRD
  #undef STEP
  #undef ENDW
  float rli[16];
  if constexpr(LM){
    #pragma unroll
    for(int r=0;r<16;++r)rli[r]=__builtin_amdgcn_rcpf(lacc[r]);
  } else {
    {auto rr=__builtin_amdgcn_permlane32_swap(__float_as_uint(l_reg),__float_as_uint(l_reg),false,false);l_reg=__uint_as_float(rr[0])+__uint_as_float(rr[1]);}
    if(hi==0)wsf[32+r32]=l_reg;asm volatile("s_waitcnt lgkmcnt(0)":::"memory");
    #pragma unroll
    for(int r=0;r<16;++r)rli[r]=__builtin_amdgcn_rcpf(wsf[32+crow(r,hi)]);
  }
  bf16*Ow=Ou+(long)(wid*QBLK)*OP;
  { bf16*stg=(bf16*)(shm+LDS_OST)+wid*2048;
    #pragma unroll
    for(int r=0;r<16;++r){const int orow=crow(r,hi);
      #pragma unroll
      for(int d0=0;d0<2;++d0)stg[orow*64+d0*32+r32]=__float2bfloat16(o[d0][r]*rli[r]);}
    asm volatile("s_waitcnt lgkmcnt(0)":::"memory");
    #pragma unroll
    for(int i=0;i<4;++i){const int row=i*8+(lane>>3),ch=lane&7; const u32x4 v=*(const u32x4*)(stg+row*64+ch*8); ATTN_STORE16(Ow+(long)row*OP+ch*8,v);} }
  asm volatile("s_waitcnt lgkmcnt(0)\n\ts_barrier":::"memory");
  #undef DMA_K
  #undef DMA_V
  #undef TROW
  #undef CMASK
  #undef CIN
  #undef START
  #undef RESC
  #undef ROT
}
template<int B> __device__ __forceinline__ void ex4(f32x16&X){ X[B]=__builtin_amdgcn_exp2f(X[B]); X[B+1]=__builtin_amdgcn_exp2f(X[B+1]); X[B+2]=__builtin_amdgcn_exp2f(X[B+2]); X[B+3]=__builtin_amdgcn_exp2f(X[B+3]); }
template<int B> __device__ __forceinline__ void ad4(float&l,const f32x16&X){ l+=X[B]; l+=X[B+1]; l+=X[B+2]; l+=X[B+3]; }
template<int B,int W> __device__ __forceinline__ void pk2v(u32x4&w,const f32x16&X){ w[W]=cvtpk_s(X[B],X[B+1]); w[W+1]=cvtpk_s(X[B+2],X[B+3]); }
__device__ __forceinline__ bf16x8 vfrag(lds_cptr vp,int off){ const s16x4 lo=vtr(vp+off),hi=vtr(vp+off+512); return (bf16x8){lo[0],lo[1],lo[2],lo[3],hi[0],hi[1],hi[2],hi[3]}; }
template<int DBG=0> __device__ __forceinline__ void attn_unit64(const bf16*Qu,const bf16*__restrict__ Kh,const bf16*__restrict__ Vh,bf16*Ou,const int NT,char*shm){
  int tid_=threadIdx.x; asm volatile("":"+v"(tid_));
  const int tid=tid_,lane=tid&63,r32=lane&31,hi=lane>>5; const int wid=__builtin_amdgcn_readfirstlane(tid>>6);
  const bf16*Qw=Qu+(long)(wid*64)*KP;
  const unsigned lds0=(unsigned)(uintptr_t)shm;
  float*wsf=(float*)(shm+LDS_WS)+wid*64;
  const bf16*ksrc=Kh+(long)lane*KP+wid*8;
  const bf16*vsrc=Vh+(long)(16*(wid&3)+(lane>>2))*KP+(wid>>2)*32+(lane&3)*8;
  const unsigned kdst=lds0+LDS_K+wid*1024, vdst=lds0+LDS_V+wid*1024;
  #define DMA_K(t,slot) glds16(ksrc+(long)(t)*(KVBLK*KP),(unsigned)__builtin_amdgcn_readfirstlane(kdst+(slot)))
  #define DMA_V(t,slot) glds16(vsrc+(long)(t)*(KVBLK*KP),(unsigned)__builtin_amdgcn_readfirstlane(vdst+(slot)))
  #define MF(a,b,c) __builtin_amdgcn_mfma_f32_32x32x16_bf16(a,b,c,0,0,0)
  const lds_cptr shm3=(lds_cptr)shm; const lds_cptr kp0=shm3+LDS_K+hi*1024+r32*16; const lds_cptr vp0=shm3+LDS_V+((lane>>4)&1)*32+(lane&3)*8+(4*hi+((lane&15)>>2))*64;
  DMA_K(0,0);DMA_V(0,0);DMA_K(1,SLOTB);
  bf16x8 qa[4],qb[4];
  #pragma unroll
  for(int d0=0;d0<4;++d0){ qa[d0]=*reinterpret_cast<const bf16x8*>(&Qw[(long)r32*KP+d0*16+hi*8]); qb[d0]=*reinterpret_cast<const bf16x8*>(&Qw[(long)(32+r32)*KP+d0*16+hi*8]); }
  DMA_K(2,2*SLOTB);DMA_V(1,SLOTB);
  f32x16 oa[2],ob[2]; oa[0]=f32x16{};oa[1]=f32x16{};ob[0]=f32x16{};ob[1]=f32x16{}; float la=0.f,lb=0.f; const f32x16 zero16=f32x16{};
  f32x16 Ca0,Ca1,Cb0,Cb1; u32x4 pa0,pa1,pa2,pa3,pb0,pb1,pb2,pb3;
  bf16x8 kf[8]; bf16x8 vfp={0,0,0,0,0,0,0,0}; bool first_=true; (void)first_; (void)vfp;
  #define QKT(ks) do{ if(DBG!=14||first_){ kload8(kf,kp0+(ks)); first_=false; } \
    Ca0=MF(kf[0],qa[0],zero16); Cb0=MF(kf[0],qb[0],zero16); Ca1=MF(kf[1],qa[0],zero16); Cb1=MF(kf[1],qb[0],zero16); \
    Ca0=MF(kf[2],qa[1],Ca0); Cb0=MF(kf[2],qb[1],Cb0); Ca1=MF(kf[3],qa[1],Ca1); Cb1=MF(kf[3],qb[1],Cb1); \
    Ca0=MF(kf[4],qa[2],Ca0); Cb0=MF(kf[4],qb[2],Cb0); Ca1=MF(kf[5],qa[2],Ca1); Cb1=MF(kf[5],qb[2],Cb1); \
    Ca0=MF(kf[6],qa[3],Ca0); Cb0=MF(kf[6],qb[3],Cb0); Ca1=MF(kf[7],qa[3],Ca1); Cb1=MF(kf[7],qb[3],Cb1); }while(0)
  #define PAF(w) __builtin_bit_cast(bf16x8,w)
  WAIT_BAR(4);
  QKT(0);
  { ex4<0>(Ca0);ex4<4>(Ca0);ex4<8>(Ca0);ex4<12>(Ca0);ex4<0>(Ca1);ex4<4>(Ca1);ex4<8>(Ca1);ex4<12>(Ca1);
    ex4<0>(Cb0);ex4<4>(Cb0);ex4<8>(Cb0);ex4<12>(Cb0);ex4<0>(Cb1);ex4<4>(Cb1);ex4<8>(Cb1);ex4<12>(Cb1);
    ad4<0>(la,Ca0);ad4<4>(la,Ca0);ad4<8>(la,Ca0);ad4<12>(la,Ca0);ad4<0>(la,Ca1);ad4<4>(la,Ca1);ad4<8>(la,Ca1);ad4<12>(la,Ca1);
    ad4<0>(lb,Cb0);ad4<4>(lb,Cb0);ad4<8>(lb,Cb0);ad4<12>(lb,Cb0);ad4<0>(lb,Cb1);ad4<4>(lb,Cb1);ad4<8>(lb,Cb1);ad4<12>(lb,Cb1);
    pk2v<0,0>(pa0,Ca0);pk2v<4,2>(pa0,Ca0);pk2v<8,0>(pa1,Ca0);pk2v<12,2>(pa1,Ca0);pk2v<0,0>(pa2,Ca1);pk2v<4,2>(pa2,Ca1);pk2v<8,0>(pa3,Ca1);pk2v<12,2>(pa3,Ca1);
    pk2v<0,0>(pb0,Cb0);pk2v<4,2>(pb0,Cb0);pk2v<8,0>(pb1,Cb0);pk2v<12,2>(pb1,Cb0);pk2v<0,0>(pb2,Cb1);pk2v<4,2>(pb2,Cb1);pk2v<8,0>(pb3,Cb1);pk2v<12,2>(pb3,Cb1); }
  WAIT_BAR(2);
  int sk=SLOTB, sv=0;
  #define PIN(x) asm volatile("":"+v"(x))
  #define GAPV(L,k,d0,vf,E,A,P) do{ o##L[d0]=MF(PAF(p##L##k),vf,o##L[d0]); if(DBG!=13){ E; A; P; } SBAR(); }while(0)
  for(int t=1;t<NT;++t){
    if(DBG!=12){ if(t+2<NT){DMA_K(t+2,sv);} if(t+1<NT){DMA_V(t+1,(sk==2*SLOTB)?0:sk+SLOTB);} }
    SBAR();
    QKT(sk);
    SBAR();
    { const lds_cptr vp_=vp0+sv; bf16x8 vf=vfp;
      if(DBG!=14||t==1){vf=vfrag(vp_,0); vfp=vf;}            GAPV(a,0,0,vf, ex4<0>(Ca0),  (void)0,          (void)0); GAPV(b,0,0,vf, ex4<0>(Cb0),  (void)0,          (void)0);
      if(DBG!=14||t==1){vf=vfrag(vp_,4096); vfp=vf;}         GAPV(a,0,1,vf, ex4<4>(Ca0),  ad4<0>(la,Ca0),   (void)0); GAPV(b,0,1,vf, ex4<4>(Cb0),  ad4<0>(lb,Cb0),   (void)0);
      if(DBG!=14||t==1){vf=vfrag(vp_,1024); vfp=vf;}         GAPV(a,1,0,vf, ex4<8>(Ca0),  ad4<4>(la,Ca0),   (pk2v<0,0>(pa0,Ca0))); GAPV(b,1,0,vf, ex4<8>(Cb0),  ad4<4>(lb,Cb0),   (pk2v<0,0>(pb0,Cb0)));
      if(DBG!=14||t==1){vf=vfrag(vp_,4096+1024); vfp=vf;}    GAPV(a,1,1,vf, ex4<12>(Ca0), ad4<8>(la,Ca0),   (pk2v<4,2>(pa0,Ca0))); GAPV(b,1,1,vf, ex4<12>(Cb0), ad4<8>(lb,Cb0),   (pk2v<4,2>(pb0,Cb0)));
      if(DBG!=14||t==1){vf=vfrag(vp_,2048); vfp=vf;}         GAPV(a,2,0,vf, ex4<0>(Ca1),  ad4<12>(la,Ca0),  (pk2v<8,0>(pa1,Ca0))); GAPV(b,2,0,vf, ex4<0>(Cb1),  ad4<12>(lb,Cb0),  (pk2v<8,0>(pb1,Cb0)));
      if(DBG!=14||t==1){vf=vfrag(vp_,4096+2048); vfp=vf;}    GAPV(a,2,1,vf, ex4<4>(Ca1),  ad4<0>(la,Ca1),   (pk2v<12,2>(pa1,Ca0))); GAPV(b,2,1,vf, ex4<4>(Cb1),  ad4<0>(lb,Cb1),   (pk2v<12,2>(pb1,Cb0)));
      if(DBG!=14||t==1){vf=vfrag(vp_,3072); vfp=vf;}         GAPV(a,3,0,vf, ex4<8>(Ca1),  ad4<4>(la,Ca1),   (pk2v<0,0>(pa2,Ca1))); GAPV(b,3,0,vf, ex4<8>(Cb1),  ad4<4>(lb,Cb1),   (pk2v<0,0>(pb2,Cb1)));
      if(DBG!=14||t==1){vf=vfrag(vp_,4096+3072); vfp=vf;}    GAPV(a,3,1,vf, ex4<12>(Ca1), ad4<8>(la,Ca1),   (pk2v<4,2>(pa2,Ca1))); GAPV(b,3,1,vf, ex4<12>(Cb1), ad4<8>(lb,Cb1),   (pk2v<4,2>(pb2,Cb1)));
      if(DBG!=13){ ad4<12>(la,Ca1); ad4<12>(lb,Cb1);
      (pk2v<8,0>(pa3,Ca1)); (pk2v<12,2>(pa3,Ca1)); (pk2v<8,0>(pb3,Cb1)); (pk2v<12,2>(pb3,Cb1)); } }
    if(DBG==11){ asm volatile("s_waitcnt lgkmcnt(0)":::"memory"); } else if(DBG==12){ WAIT_BAR(0); } else { if(t+2<NT){WAIT_BAR(2);} else if(t+1<NT){WAIT_BAR(1);} else {WAIT_BAR(0);} }
    sv=sk; sk=(sk==2*SLOTB)?0:sk+SLOTB;
  }
  { const lds_cptr vp_=vp0+sv; bf16x8 vf;
    vf=vfrag(vp_,0);         oa[0]=MF(PAF(pa0),vf,oa[0]); ob[0]=MF(PAF(pb0),vf,ob[0]);
    vf=vfrag(vp_,4096);      oa[1]=MF(PAF(pa0),vf,oa[1]); ob[1]=MF(PAF(pb0),vf,ob[1]);
    vf=vfrag(vp_,1024);      oa[0]=MF(PAF(pa1),vf,oa[0]); ob[0]=MF(PAF(pb1),vf,ob[0]);
    vf=vfrag(vp_,4096+1024); oa[1]=MF(PAF(pa1),vf,oa[1]); ob[1]=MF(PAF(pb1),vf,ob[1]);
    vf=vfrag(vp_,2048);      oa[0]=MF(PAF(pa2),vf,oa[0]); ob[0]=MF(PAF(pb2),vf,ob[0]);
    vf=vfrag(vp_,4096+2048); oa[1]=MF(PAF(pa2),vf,oa[1]); ob[1]=MF(PAF(pb2),vf,ob[1]);
    vf=vfrag(vp_,3072);      oa[0]=MF(PAF(pa3),vf,oa[0]); ob[0]=MF(PAF(pb3),vf,ob[0]);
    vf=vfrag(vp_,4096+3072); oa[1]=MF(PAF(pa3),vf,oa[1]); ob[1]=MF(PAF(pb3),vf,ob[1]); }
  #define EPI64(L,rowoff) do{ \
    { auto rr=__builtin_amdgcn_permlane32_swap(__float_as_uint(l##L),__float_as_uint(l##L),false,false); l##L=__uint_as_float(rr[0])+__uint_as_float(rr[1]); } \
    if(hi==0)wsf[32+r32]=l##L; asm volatile("s_waitcnt lgkmcnt(0)":::"memory"); \
    float rli[16]; _Pragma("unroll") for(int r=0;r<16;++r)rli[r]=__builtin_amdgcn_rcpf(wsf[32+crow(r,hi)]); \
    bf16*Ow=Ou+(long)(wid*64+(rowoff))*OP; bf16*stg=(bf16*)(shm+LDS_OST)+wid*2048; \
    _Pragma("unroll") for(int r=0;r<16;++r){ const int orow=crow(r,hi); _Pragma("unroll") for(int d0=0;d0<2;++d0)stg[orow*64+d0*32+r32]=__float2bfloat16(o##L[d0][r]*rli[r]); } \
    asm volatile("s_waitcnt lgkmcnt(0)":::"memory"); \
    _Pragma("unroll") for(int i=0;i<4;++i){ const int row=i*8+(lane>>3),ch=lane&7; const u32x4 v=*(const u32x4*)(stg+row*64+ch*8); ATTN_STORE16(Ow+(long)row*OP+ch*8,v); } \
    asm volatile("s_waitcnt lgkmcnt(0)":::"memory"); }while(0)
  EPI64(a,0); EPI64(b,32);
  asm volatile("s_waitcnt lgkmcnt(0)\n\ts_barrier":::"memory");
  #undef EPI64
  #undef GAPV
  #undef PIN
  #undef PAF
  #undef QKT
  #undef MF
  #undef DMA_K
  #undef DMA_V
}
typedef int v8i_t __attribute__((ext_vector_type(8))); typedef int v4i_t __attribute__((ext_vector_type(4)));
template<int DBG=0> __device__ __forceinline__ void attn_unit64f8(const unsigned char*Q8u,const unsigned char*__restrict__ K8h,const bf16*__restrict__ Vh,bf16*Ou,const int NT,char*shm){
  int tid_=threadIdx.x; asm volatile("":"+v"(tid_));
  const int tid=tid_,lane=tid&63,r32=lane&31,hi=lane>>5; const int wid=__builtin_amdgcn_readfirstlane(tid>>6);
  const unsigned char*Q8w=Q8u+(long)(wid*64)*512;
  const unsigned lds0=(unsigned)(uintptr_t)shm;
  float*wsf=(float*)(shm+LDS_WS)+wid*64;
  const unsigned char*k8src=K8h+(long)lane*128+(wid&3)*16;
  const bf16*vsrc=Vh+(long)(16*(wid&3)+(lane>>2))*KP+(wid>>2)*32+(lane&3)*8;
  const unsigned kdst=lds0+LDS_K+wid*1024, vdst=lds0+LDS_V+wid*1024;
  #define DMA_K(t,slot) do{ if(wid<4){ glds16(k8src+(long)(t)*(KVBLK*128),(unsigned)__builtin_amdgcn_readfirstlane(kdst+(slot))); } }while(0)
  #define DMA_V(t,slot) glds16(vsrc+(long)(t)*(KVBLK*KP),(unsigned)__builtin_amdgcn_readfirstlane(vdst+(slot)))
  #define MF(a,b,c) __builtin_amdgcn_mfma_f32_32x32x16_bf16(a,b,c,0,0,0)
  const lds_cptr shm3=(lds_cptr)shm; const lds_cptr kp8=shm3+LDS_K+(2*hi)*1024+r32*16; const lds_cptr vp0=shm3+LDS_V+((lane>>4)&1)*32+(lane&3)*8+(4*hi+((lane&15)>>2))*64;
  DMA_K(0,0);DMA_V(0,0);DMA_K(1,SLOTB);
  v8i_t qa8,qb8;
  { const v4i_t a0=*reinterpret_cast<const v4i_t*>(Q8w+(long)r32*512+32*hi), a1=*reinterpret_cast<const v4i_t*>(Q8w+(long)r32*512+32*hi+16), b0=*reinterpret_cast<const v4i_t*>(Q8w+(long)(32+r32)*512+32*hi), b1=*reinterpret_cast<const v4i_t*>(Q8w+(long)(32+r32)*512+32*hi+16);
    qa8=(v8i_t){a0[0],a0[1],a0[2],a0[3],a1[0],a1[1],a1[2],a1[3]}; qb8=(v8i_t){b0[0],b0[1],b0[2],b0[3],b1[0],b1[1],b1[2],b1[3]}; }
  DMA_K(2,2*SLOTB);DMA_V(1,SLOTB);
  f32x16 oa[2],ob[2]; oa[0]=f32x16{};oa[1]=f32x16{};ob[0]=f32x16{};ob[1]=f32x16{}; float la=0.f,lb=0.f; const f32x16 zero16=f32x16{};
  f32x16 Ca0,Ca1,Cb0,Cb1; u32x4 pa0,pa1,pa2,pa3,pb0,pb1,pb2,pb3;
  bf16x8 vfp={0,0,0,0,0,0,0,0}; (void)vfp;
  #define MF8(a,b,c) __builtin_amdgcn_mfma_scale_f32_32x32x64_f8f6f4(a,b,c,0,0,0,0x7F7F7F7F,0,0x7F7F7F7F)
  #define KF8(ks,n) ({ const v4i_t lo_=*(const __attribute__((address_space(3))) v4i_t*)(kp8+(ks)+(n)*512), hi_=*(const __attribute__((address_space(3))) v4i_t*)(kp8+(ks)+(n)*512+1024); (v8i_t){lo_[0],lo_[1],lo_[2],lo_[3],hi_[0],hi_[1],hi_[2],hi_[3]}; })
  #define QKT(ks) do{ const v8i_t k0_=KF8(ks,0), k1_=KF8(ks,1); Ca0=MF8(k0_,qa8,zero16); Cb0=MF8(k0_,qb8,zero16); Ca1=MF8(k1_,qa8,zero16); Cb1=MF8(k1_,qb8,zero16); }while(0)
  #define WAIT_KV(N03,N47) do{ if(wid<4){WAIT_BAR(N03);} else {WAIT_BAR(N47);} }while(0)
  #define PAF(w) __builtin_bit_cast(bf16x8,w)
  WAIT_KV(4,2);
  QKT(0);
  { ex4<0>(Ca0);ex4<4>(Ca0);ex4<8>(Ca0);ex4<12>(Ca0);ex4<0>(Ca1);ex4<4>(Ca1);ex4<8>(Ca1);ex4<12>(Ca1);
    ex4<0>(Cb0);ex4<4>(Cb0);ex4<8>(Cb0);ex4<12>(Cb0);ex4<0>(Cb1);ex4<4>(Cb1);ex4<8>(Cb1);ex4<12>(Cb1);
    ad4<0>(la,Ca0);ad4<4>(la,Ca0);ad4<8>(la,Ca0);ad4<12>(la,Ca0);ad4<0>(la,Ca1);ad4<4>(la,Ca1);ad4<8>(la,Ca1);ad4<12>(la,Ca1);
    ad4<0>(lb,Cb0);ad4<4>(lb,Cb0);ad4<8>(lb,Cb0);ad4<12>(lb,Cb0);ad4<0>(lb,Cb1);ad4<4>(lb,Cb1);ad4<8>(lb,Cb1);ad4<12>(lb,Cb1);
    pk2v<0,0>(pa0,Ca0);pk2v<4,2>(pa0,Ca0);pk2v<8,0>(pa1,Ca0);pk2v<12,2>(pa1,Ca0);pk2v<0,0>(pa2,Ca1);pk2v<4,2>(pa2,Ca1);pk2v<8,0>(pa3,Ca1);pk2v<12,2>(pa3,Ca1);
    pk2v<0,0>(pb0,Cb0);pk2v<4,2>(pb0,Cb0);pk2v<8,0>(pb1,Cb0);pk2v<12,2>(pb1,Cb0);pk2v<0,0>(pb2,Cb1);pk2v<4,2>(pb2,Cb1);pk2v<8,0>(pb3,Cb1);pk2v<12,2>(pb3,Cb1); }
  WAIT_KV(2,1);
  int sk=SLOTB, sv=0;
  #define PIN(x) asm volatile("":"+v"(x))
  #define GAPV(L,k,d0,vf,E,A,P) do{ o##L[d0]=MF(PAF(p##L##k),vf,o##L[d0]); if(DBG!=13){ E; A; P; } SBAR(); }while(0)
  for(int t=1;t<NT;++t){
    if(DBG!=12){ if(t+2<NT){DMA_K(t+2,sv);} if(t+1<NT){DMA_V(t+1,(sk==2*SLOTB)?0:sk+SLOTB);} }
    SBAR();
    QKT(sk);
    SBAR();
    { const lds_cptr vp_=vp0+sv; bf16x8 vf=vfp;
      if(DBG!=14||t==1){vf=vfrag(vp_,0); vfp=vf;}            GAPV(a,0,0,vf, ex4<0>(Ca0),  (void)0,          (void)0); GAPV(b,0,0,vf, ex4<0>(Cb0),  (void)0,          (void)0);
      if(DBG!=14||t==1){vf=vfrag(vp_,4096); vfp=vf;}         GAPV(a,0,1,vf, ex4<4>(Ca0),  ad4<0>(la,Ca0),   (void)0); GAPV(b,0,1,vf, ex4<4>(Cb0),  ad4<0>(lb,Cb0),   (void)0);
      if(DBG!=14||t==1){vf=vfrag(vp_,1024); vfp=vf;}         GAPV(a,1,0,vf, ex4<8>(Ca0),  ad4<4>(la,Ca0),   (pk2v<0,0>(pa0,Ca0))); GAPV(b,1,0,vf, ex4<8>(Cb0),  ad4<4>(lb,Cb0),   (pk2v<0,0>(pb0,Cb0)));
      if(DBG!=14||t==1){vf=vfrag(vp_,4096+1024); vfp=vf;}    GAPV(a,1,1,vf, ex4<12>(Ca0), ad4<8>(la,Ca0),   (pk2v<4,2>(pa0,Ca0))); GAPV(b,1,1,vf, ex4<12>(Cb0), ad4<8>(lb,Cb0),   (pk2v<4,2>(pb0,Cb0)));
      if(DBG!=14||t==1){vf=vfrag(vp_,2048); vfp=vf;}         GAPV(a,2,0,vf, ex4<0>(Ca1),  ad4<12>(la,Ca0),  (pk2v<8,0>(pa1,Ca0))); GAPV(b,2,0,vf, ex4<0>(Cb1),  ad4<12>(lb,Cb0),  (pk2v<8,0>(pb1,Cb0)));
      if(DBG!=14||t==1){vf=vfrag(vp_,4096+2048); vfp=vf;}    GAPV(a,2,1,vf, ex4<4>(Ca1),  ad4<0>(la,Ca1),   (pk2v<12,2>(pa1,Ca0))); GAPV(b,2,1,vf, ex4<4>(Cb1),  ad4<0>(lb,Cb1),   (pk2v<12,2>(pb1,Cb0)));
      if(DBG!=14||t==1){vf=vfrag(vp_,3072); vfp=vf;}         GAPV(a,3,0,vf, ex4<8>(Ca1),  ad4<4>(la,Ca1),   (pk2v<0,0>(pa2,Ca1))); GAPV(b,3,0,vf, ex4<8>(Cb1),  ad4<4>(lb,Cb1),   (pk2v<0,0>(pb2,Cb1)));
      if(DBG!=14||t==1){vf=vfrag(vp_,4096+3072); vfp=vf;}    GAPV(a,3,1,vf, ex4<12>(Ca1), ad4<8>(la,Ca1),   (pk2v<4,2>(pa2,Ca1))); GAPV(b,3,1,vf, ex4<12>(Cb1), ad4<8>(lb,Cb1),   (pk2v<4,2>(pb2,Cb1)));
      if(DBG!=13){ ad4<12>(la,Ca1); ad4<12>(lb,Cb1);
      (pk2v<8,0>(pa3,Ca1)); (pk2v<12,2>(pa3,Ca1)); (pk2v<8,0>(pb3,Cb1)); (pk2v<12,2>(pb3,Cb1)); } }
    if(DBG==11){ asm volatile("s_waitcnt lgkmcnt(0)":::"memory"); } else if(DBG==12){ WAIT_BAR(0); } else { if(t+2<NT){WAIT_KV(2,1);} else if(t+1<NT){WAIT_BAR(1);} else {WAIT_BAR(0);} }
    sv=sk; sk=(sk==2*SLOTB)?0:sk+SLOTB;
  }
  { const lds_cptr vp_=vp0+sv; bf16x8 vf;
    vf=vfrag(vp_,0);         oa[0]=MF(PAF(pa0),vf,oa[0]); ob[0]=MF(PAF(pb0),vf,ob[0]);
    vf=vfrag(vp_,4096);      oa[1]=MF(PAF(pa0),vf,oa[1]); ob[1]=MF(PAF(pb0),vf,ob[1]);
    vf=vfrag(vp_,1024);      oa[0]=MF(PAF(pa1),vf,oa[0]); ob[0]=MF(PAF(pb1),vf,ob[0]);
    vf=vfrag(vp_,4096+1024); oa[1]=MF(PAF(pa1),vf,oa[1]); ob[1]=MF(PAF(pb1),vf,ob[1]);
    vf=vfrag(vp_,2048);      oa[0]=MF(PAF(pa2),vf,oa[0]); ob[0]=MF(PAF(pb2),vf,ob[0]);
    vf=vfrag(vp_,4096+2048); oa[1]=MF(PAF(pa2),vf,oa[1]); ob[1]=MF(PAF(pb2),vf,ob[1]);
    vf=vfrag(vp_,3072);      oa[0]=MF(PAF(pa3),vf,oa[0]); ob[0]=MF(PAF(pb3),vf,ob[0]);
    vf=vfrag(vp_,4096+3072); oa[1]=MF(PAF(pa3),vf,oa[1]); ob[1]=MF(PAF(pb3),vf,ob[1]); }
  #define EPI64(L,rowoff) do{ \
    { auto rr=__builtin_amdgcn_permlane32_swap(__float_as_uint(l##L),__float_as_uint(l##L),false,false); l##L=__uint_as_float(rr[0])+__uint_as_float(rr[1]); } \
    if(hi==0)wsf[32+r32]=l##L; asm volatile("s_waitcnt lgkmcnt(0)":::"memory"); \
    float rli[16]; _Pragma("unroll") for(int r=0;r<16;++r)rli[r]=__builtin_amdgcn_rcpf(wsf[32+crow(r,hi)]); \
    bf16*Ow=Ou+(long)(wid*64+(rowoff))*OP; bf16*stg=(bf16*)(shm+LDS_OST)+wid*2048; \
    _Pragma("unroll") for(int r=0;r<16;++r){ const int orow=crow(r,hi); _Pragma("unroll") for(int d0=0;d0<2;++d0)stg[orow*64+d0*32+r32]=__float2bfloat16(o##L[d0][r]*rli[r]); } \
    asm volatile("s_waitcnt lgkmcnt(0)":::"memory"); \
    _Pragma("unroll") for(int i=0;i<4;++i){ const int row=i*8+(lane>>3),ch=lane&7; const u32x4 v=*(const u32x4*)(stg+row*64+ch*8); ATTN_STORE16(Ow+(long)row*OP+ch*8,v); } \
    asm volatile("s_waitcnt lgkmcnt(0)":::"memory"); }while(0)
  EPI64(a,0); EPI64(b,32);
  asm volatile("s_waitcnt lgkmcnt(0)\n\ts_barrier":::"memory");
  #undef EPI64
  #undef GAPV
  #undef PIN
  #undef PAF
  #undef QKT
  #undef KF8
  #undef MF8
  #undef WAIT_KV
  #undef MF
  #undef DMA_K
  #undef DMA_V
}
template<int DBG=0> __device__ __forceinline__ void attn_unit64f8pv(const unsigned char*Q8u,const unsigned char*__restrict__ K8h,const unsigned char*__restrict__ VT8h,bf16*Ou,const int NT,char*shm){
  int tid_=threadIdx.x; asm volatile("":"+v"(tid_));
  const int tid=tid_,lane=tid&63,r32=lane&31,hi=lane>>5; const int wid=__builtin_amdgcn_readfirstlane(tid>>6);
  const unsigned char*Q8w=Q8u+(long)(wid*64)*512;
  const unsigned lds0=(unsigned)(uintptr_t)shm;
  float*wsf=(float*)(shm+LDS_WS)+wid*64;
  const unsigned char*dsrc=(wid<4)?K8h+(long)lane*128+(wid&3)*16:VT8h+(long)lane*64+(wid&3)*16;
  const long dstep=(wid<4)?(long)KVBLK*128:4096;
  const unsigned ddst=lds0+((wid<4)?LDS_K:LDS_V)+(wid&3)*1024;
  #define DMA1(t,slot) glds16(dsrc+(long)(t)*dstep,(unsigned)__builtin_amdgcn_readfirstlane(ddst+(slot)))
  const lds_cptr shm3=(lds_cptr)shm; const lds_cptr kp8=shm3+LDS_K+(2*hi)*1024+r32*16; const lds_cptr vp8=shm3+LDS_V+(2*hi)*1024+r32*16;
  DMA1(0,0);
  v8i_t qa8,qb8;
  { const v4i_t a0=*reinterpret_cast<const v4i_t*>(Q8w+(long)r32*512+32*hi), a1=*reinterpret_cast<const v4i_t*>(Q8w+(long)r32*512+32*hi+16), b0=*reinterpret_cast<const v4i_t*>(Q8w+(long)(32+r32)*512+32*hi), b1=*reinterpret_cast<const v4i_t*>(Q8w+(long)(32+r32)*512+32*hi+16);
    qa8=(v8i_t){a0[0],a0[1],a0[2],a0[3],a1[0],a1[1],a1[2],a1[3]}; qb8=(v8i_t){b0[0],b0[1],b0[2],b0[3],b1[0],b1[1],b1[2],b1[3]}; }
  DMA1(1,SLOTB);
  if(wid<4){ DMA1(2,2*SLOTB); }
  f32x16 oa[2],ob[2]; oa[0]=f32x16{};oa[1]=f32x16{};ob[0]=f32x16{};ob[1]=f32x16{}; float la=0.f,lb=0.f; const f32x16 zero16=f32x16{};
  f32x16 Ca0,Ca1,Cb0,Cb1; v8i_t pa8,pb8;
  f32x16 lsa=f32x16{},lsb=f32x16{}; const v8i_t ones8={0x38383838,0x38383838,0x38383838,0x38383838,0x38383838,0x38383838,0x38383838,0x38383838}; (void)la; (void)lb;
  #define MF8(a,b,c) __builtin_amdgcn_mfma_scale_f32_32x32x64_f8f6f4(a,b,c,0,0,0,0x7F7F7F7F,0,0x7F7F7F7F)
  #define MF8P(a,b,c) __builtin_amdgcn_mfma_scale_f32_32x32x64_f8f6f4(a,b,c,1,0,0,0x7F7F7F7F,0,0x7F7F7F7F)
  #define FR8(base,slot,n) ({ const v4i_t lo_=*(const __attribute__((address_space(3))) v4i_t*)((base)+(slot)+(n)*512), hi_=*(const __attribute__((address_space(3))) v4i_t*)((base)+(slot)+(n)*512+1024); (v8i_t){lo_[0],lo_[1],lo_[2],lo_[3],hi_[0],hi_[1],hi_[2],hi_[3]}; })
  #define QKT(ks) do{ const v8i_t k0_=FR8(kp8,ks,0), k1_=FR8(kp8,ks,1); Ca0=MF8(k0_,qa8,zero16); Cb0=MF8(k0_,qb8,zero16); Ca1=MF8(k1_,qa8,zero16); Cb1=MF8(k1_,qb8,zero16); }while(0)
  #define PVT(vs) do{ const v8i_t v0_=FR8(vp8,vs,0), v1_=FR8(vp8,vs,1); oa[0]=MF8P(pa8,v0_,oa[0]); ob[0]=MF8P(pb8,v0_,ob[0]); oa[1]=MF8P(pa8,v1_,oa[1]); ob[1]=MF8P(pb8,v1_,ob[1]); lsa=MF8P(pa8,ones8,lsa); lsb=MF8P(pb8,ones8,lsb); }while(0)
  #define PK8(x0,x1,x2,x3) ({ int w_=__builtin_amdgcn_cvt_pk_bf8_f32(x0,x1,0,false); w_=__builtin_amdgcn_cvt_pk_bf8_f32(x2,x3,w_,true); w_; })
  #define SOFTMAX(C0,C1,l,P8) do{ \
    ex4<0>(C0);ex4<4>(C0);ex4<8>(C0);ex4<12>(C0);ex4<0>(C1);ex4<4>(C1);ex4<8>(C1);ex4<12>(C1); \
    P8=(v8i_t){PK8(C0[0],C0[1],C0[2],C0[3]),PK8(C0[4],C0[5],C0[6],C0[7]),PK8(C0[8],C0[9],C0[10],C0[11]),PK8(C0[12],C0[13],C0[14],C0[15]), \
               PK8(C1[0],C1[1],C1[2],C1[3]),PK8(C1[4],C1[5],C1[6],C1[7]),PK8(C1[8],C1[9],C1[10],C1[11]),PK8(C1[12],C1[13],C1[14],C1[15])}; }while(0)
  if(wid<4){WAIT_BAR(2);} else {WAIT_BAR(1);}
  QKT(0);
  SOFTMAX(Ca0,Ca1,la,pa8); SOFTMAX(Cb0,Cb1,lb,pb8);
  if(wid<4){WAIT_BAR(1);} else {WAIT_BAR(1);}
  int sk=SLOTB, sv=0;
  for(int t=1;t<NT;++t){
    const bool iss=(wid<4)?(t+2<NT):(t+1<NT);
    if(iss){ if(wid<4){DMA1(t+2,sv);} else {DMA1(t+1,(sk==2*SLOTB)?0:sk+SLOTB);} }
    SBAR();
    QKT(sk);
    PVT(sv);
    SBAR();
    SOFTMAX(Ca0,Ca1,la,pa8); SOFTMAX(Cb0,Cb1,lb,pb8);
    if(iss){WAIT_BAR(1);} else {WAIT_BAR(0);}
    sv=sk; sk=(sk==2*SLOTB)?0:sk+SLOTB;
  }
  PVT(sv);
  #define EPI64(L,rowoff) do{ \
    float rli[16]; _Pragma("unroll") for(int r=0;r<16;++r)rli[r]=__builtin_amdgcn_rcpf(ls##L[r]); \
    bf16*Ow=Ou+(long)(wid*64+(rowoff))*OP; bf16*stg=(bf16*)(shm+LDS_OST)+wid*2048; \
    _Pragma("unroll") for(int r=0;r<16;++r){ const int orow=crow(r,hi); _Pragma("unroll") for(int d0=0;d0<2;++d0)stg[orow*64+d0*32+r32]=__float2bfloat16(o##L[d0][r]*rli[r]); } \
    asm volatile("s_waitcnt lgkmcnt(0)":::"memory"); \
    _Pragma("unroll") for(int i=0;i<4;++i){ const int row=i*8+(lane>>3),ch=lane&7; const u32x4 v=*(const u32x4*)(stg+row*64+ch*8); ATTN_STORE16(Ow+(long)row*OP+ch*8,v); } \
    asm volatile("s_waitcnt lgkmcnt(0)":::"memory"); }while(0)
  EPI64(a,0); EPI64(b,32);
  asm volatile("s_waitcnt lgkmcnt(0)\n\ts_barrier":::"memory");
  #undef EPI64
  #undef SOFTMAX
  #undef PK8
  #undef PVT
  #undef QKT
  #undef FR8
  #undef MF8P
  #undef MF8
  #undef DMA1
}
constexpr int ATTN_LDS_BYTES=LDS_BYTES;
#undef SBAR
#undef WAIT_BAR
}

constexpr int NWAVES = 8;
constexpr int DM = 1024, NBATCH = 4, SEQL = 8192, CTXL = 256, TPB = SEQL + CTXL, NROW = NBATCH * TPB, DEPTH = 4;
constexpr int INW = 2048, NEXP = 16, EDIM = 2048, CAPL = 1024, CAPC = 32, ETILES = 17, ESLOTS = ETILES * 256, EUSED = NBATCH * (CAPL + CAPC);
constexpr int COL_QA = 0, COL_KA = 512, COL_VA = 640, COL_QB = 768, COL_KB = 1024, COL_VB = 1280, COL_CV = 1536, COL_CG = 1792;
constexpr int MIX_A = 0, MIX_B = 512, MIX_C = 768;
constexpr float LOG2E = 1.4426950408889634f, C2 = 0.125f * LOG2E, EPS = 1e-6f;
constexpr int NPL = 9;
constexpr bool MOE_DOWN_FP8 = true;
constexpr bool MOE_UP_FP8 = true;
constexpr bool ATTN_FP8_PV = true;
constexpr bool ATTN_FP8_QK = true;
constexpr int ATTN_DBG = 0;
constexpr int WGM_IN = 4, WGM_OUT = 8, WGM_G1 = 8, WGM_G2 = 8;
constexpr int PROBE_KIND = -1, PROBE_MULT = 4;
constexpr int REP_P0 = 1, REP_INPROJ = 1, REP_ATTN = 1, REP_CONV = 1, REP_NORM2 = 1, REP_TOPK = 1, REP_DISPATCH = 1, REP_G1 = 1, REP_G2 = 1;
constexpr int PH_FINAL = 1 + DEPTH * NPL, NPH = PH_FINAL + 1;
enum { LP_NORM1 = 0, LP_INPROJ = 1, LP_VT = 2, LP_MIX = 3, LP_OUTPROJ = 4, LP_NORM2 = 5, LP_TOPK = 6, LP_G1 = 7, LP_G2 = 8 };

constexpr size_t MiB = 1u << 20;
constexpr size_t WS_CTL = 0, CTL_ZERO_BYTES = 65536;
constexpr size_t WS_MODV = 1 * MiB;
constexpr size_t WS_ROPE = 2 * MiB;
constexpr size_t WS_WIN = 4 * MiB;
constexpr size_t WS_WOUT = 20 * MiB;
constexpr size_t WS_WGU = 32 * MiB;
constexpr size_t WS_WD = 544 * MiB;
constexpr size_t WS_X = 800 * MiB;
constexpr size_t WS_HN = 932 * MiB;
constexpr size_t WS_P = 998 * MiB;
constexpr size_t WS_MIX = 1130 * MiB;
constexpr size_t WS_AFF = 1196 * MiB;
constexpr size_t WS_SLOT = 1199 * MiB;
constexpr size_t WS_IDX = 1202 * MiB;
constexpr size_t WS_XE = 1204 * MiB;
constexpr size_t WS_H1 = 1340 * MiB;
constexpr size_t WS_Y = 1612 * MiB;
constexpr size_t WS_RW = 1748 * MiB;
constexpr size_t WS_RC = 1750 * MiB;
constexpr size_t WS_Q8 = 1752 * MiB;
constexpr size_t WS_K8 = 1770 * MiB;
constexpr size_t WS_VT8 = 1776 * MiB;
constexpr size_t WS_END = 1782 * MiB;
constexpr int CW_TMO = 0, CW_CODE = 1, CW_BAR = 4096;

constexpr int RING_OFF = 0, RING_BYTES = 155648;
constexpr int GTAB_OFF = 131072, GTAB_UNITS = 17;
constexpr int LDSCTL_OFF = RING_BYTES, MISC_OFF = LDSCTL_OFF + 320;
constexpr int LDS_BYTES = 159744;
static_assert(MISC_OFF + 128 <= LDS_BYTES, "LDS map");

#define GAS __attribute__((address_space(1)))
#define LAS __attribute__((address_space(3)))
typedef unsigned short bf16;
typedef unsigned v4u __attribute__((ext_vector_type(4)));
typedef float f32x4 __attribute__((ext_vector_type(4)));
typedef short bf16x8 __attribute__((ext_vector_type(8)));
typedef GAS unsigned gu32;
typedef GAS unsigned long long gu64;
#define RLX_AGENT __ATOMIC_RELAXED, __HIP_MEMORY_SCOPE_AGENT
#define LDS_WAIT() asm volatile("s_waitcnt lgkmcnt(0)" ::: "memory")
#define VM_WAIT() asm volatile("s_waitcnt vmcnt(0)" ::: "memory")
__device__ __forceinline__ unsigned long long rt() { return __builtin_amdgcn_s_memrealtime(); }
__device__ __forceinline__ unsigned f2bf(float f) { unsigned u = __builtin_bit_cast(unsigned, f); return (u + 0x7fffu + ((u >> 16) & 1u)) >> 16; }
__device__ __forceinline__ unsigned pk2(float lo, float hi) { return f2bf(lo) | (f2bf(hi) << 16); }

#define XB_TMO      128
#define XB_XCNT(j)  (256  + 64 * (j))
#define XB_XSUB(j)  (1280 + 64 * (j))
#define XB_XGEN(j)  (2304 + 64 * (j))
#define XB_TOP      3328
#define XB_TOPGEN   3392
#define XCD_BAR_WORDS 3456
#define XB_SPIN_CAP (1u << 18)

__device__ __forceinline__ unsigned xb_ld(unsigned* p)              { return __hip_atomic_load(p, __ATOMIC_RELAXED, __HIP_MEMORY_SCOPE_AGENT); }
__device__ __forceinline__ unsigned xb_add(unsigned* p, unsigned v) { return __hip_atomic_fetch_add(p, v, __ATOMIC_RELAXED, __HIP_MEMORY_SCOPE_AGENT); }
__device__ __forceinline__ unsigned xb_xcc_id() { return (unsigned)__builtin_amdgcn_s_getreg((3 << 11) | 20) & 0xFu; }
#define XB_SPIN(cond, bar) do { unsigned _sp = 0; while (cond) { __builtin_amdgcn_s_sleep(1); \
    if ((++_sp & 255u) == 0u) { if (xb_ld(&(bar)[XB_TMO])) break; if (_sp > XB_SPIN_CAP) { atomicAdd(&(bar)[XB_TMO], 1u); break; } } } } while (0)

struct XcdBarrier {
    unsigned* bar; unsigned x;
    volatile LAS unsigned* st;
};

__device__ __forceinline__ XcdBarrier xcd_barrier_post(unsigned* bar, volatile LAS unsigned* st) {
    XcdBarrier b; b.bar = bar; b.x = xb_xcc_id(); b.st = st;
    if (threadIdx.x == 0) (void)xb_add(&bar[XB_XCNT(b.x)], 1u);
    return b;
}
__device__ __forceinline__ void xcd_barrier_complete(unsigned* bar, unsigned x, unsigned& nloc, unsigned& nx) {
    const unsigned G = gridDim.x * gridDim.y * gridDim.z;
    unsigned sum, cnt, mine, sp = 0u;
    for (;;) {
        sum = 0u; cnt = 0u; mine = 0u;
#pragma unroll
        for (unsigned j = 0; j < 16; ++j) { const unsigned c = xb_ld(&bar[XB_XCNT(j)]); sum += c; cnt += (c > 0u) ? 1u : 0u; mine = (j == x) ? c : mine; }
        if (sum == G) break;
        __builtin_amdgcn_s_sleep(1);
        if ((++sp & 255u) == 0u) { if (xb_ld(&bar[XB_TMO])) break; if (sp > XB_SPIN_CAP) { atomicAdd(&bar[XB_TMO], 1u); break; } }
    }
    nloc = mine > 0u ? mine : 1u; nx = cnt > 0u ? cnt : 1u;
}

__device__ __forceinline__ void xcd_barrier(const XcdBarrier& b) {
    asm volatile("s_waitcnt vmcnt(0)" ::: "memory");
    __syncthreads();
    if (threadIdx.x == 0) {
        unsigned* bar = b.bar;
        __builtin_amdgcn_s_waitcnt(0);
        unsigned nloc = b.st[0], nx = b.st[1];
        if (nloc == 0u) { xcd_barrier_complete(bar, b.x, nloc, nx); b.st[0] = nloc; b.st[1] = nx; }
        const unsigned old = xb_add(&bar[XB_XSUB(b.x)], 1u);
        const unsigned gen = old / nloc;
        if (old + 1u == (gen + 1u) * nloc) {
            __builtin_amdgcn_fence(__ATOMIC_RELEASE, "agent");
            asm volatile("s_waitcnt vmcnt(0)" ::: "memory");
            const unsigned og = xb_add(&bar[XB_TOP], 1u);
            const unsigned tg = og / nx;
            if (og + 1u == (tg + 1u) * nx) xb_add(&bar[XB_TOPGEN], 1u);
            else XB_SPIN(xb_ld(&bar[XB_TOPGEN]) == tg, bar);
            __builtin_amdgcn_fence(__ATOMIC_ACQUIRE, "agent");
            xb_add(&bar[XB_XGEN(b.x)], 1u);
            asm volatile("s_waitcnt vmcnt(0)" ::: "memory");
        } else {
            XB_SPIN(xb_ld(&bar[XB_XGEN(b.x)]) == gen, bar);
            __builtin_amdgcn_fence(__ATOMIC_ACQUIRE, "agent");
            asm volatile("s_waitcnt vmcnt(0)" ::: "memory");
        }
    }
    __syncthreads();
}


typedef unsigned u2v __attribute__((ext_vector_type(2)));
__device__ __forceinline__ float bf2f(unsigned short b) { return __uint_as_float((unsigned)b << 16); }
__device__ __forceinline__ float bflo(unsigned w) { return __uint_as_float(w << 16); }
__device__ __forceinline__ float bfhi(unsigned w) { return __uint_as_float(w & 0xffff0000u); }
__device__ __forceinline__ float fexp2(float x) { return __builtin_amdgcn_exp2f(x); }
__device__ __forceinline__ float fsigmoid(float x) { return __builtin_amdgcn_rcpf(1.0f + fexp2(-LOG2E * x)); }

struct Frame {
    LAS unsigned char* lds;
    volatile LAS unsigned* MISC;
    gu32* ctl;
    int tid, lane, wave;
    int vcu, G, bx;
    const float* in[22];
    float* out;
    unsigned char* ws;
};
#define WSP(T, off) ((T*)(F.ws + (off)))

__device__ __forceinline__ float wave_sum(float v) {
#pragma unroll
    for (int o = 1; o < 64; o <<= 1) v += __shfl_xor(v, o);
    return v;
}

__device__ __forceinline__ void tr_item(const float* W0, int N, bf16* Wt0, int K, LAS float* scr, int lane) {
    f32x4 v[16];
    const int n4 = (lane & 15) * 4, k4 = lane >> 4;
#pragma unroll
    for (int i = 0; i < 16; ++i) v[i] = __builtin_nontemporal_load((const GAS f32x4*)(W0 + (size_t)(4 * i + k4) * N + n4));
#pragma unroll
    for (int i = 0; i < 16; ++i) { LAS float* d = scr + (4 * i + k4) * 65 + n4; d[0] = v[i].x; d[1] = v[i].y; d[2] = v[i].z; d[3] = v[i].w; }
    LDS_WAIT(); asm volatile("" ::: "memory");
    const int c = lane & 7;
#pragma unroll
    for (int j = 0; j < 8; ++j) { const int n = (lane >> 3) + 8 * j; const LAS float* s = scr + (8 * c) * 65 + n;
        v4u o; o.x = pk2(s[0 * 65], s[1 * 65]); o.y = pk2(s[2 * 65], s[3 * 65]); o.z = pk2(s[4 * 65], s[5 * 65]); o.w = pk2(s[6 * 65], s[7 * 65]);
        *(GAS v4u*)(Wt0 + (size_t)n * K + 8 * c) = o; }
    LDS_WAIT(); asm volatile("" ::: "memory");
}
__device__ __forceinline__ void tr_item8(const float* W0, int N, unsigned char* Wt0, int K, float mul, LAS float* scr, int lane) {
    f32x4 v[16];
    const int n4 = (lane & 15) * 4, k4 = lane >> 4;
#pragma unroll
    for (int i = 0; i < 16; ++i) v[i] = __builtin_nontemporal_load((const GAS f32x4*)(W0 + (size_t)(4 * i + k4) * N + n4));
#pragma unroll
    for (int i = 0; i < 16; ++i) { LAS float* d = scr + (4 * i + k4) * 65 + n4; d[0] = v[i].x; d[1] = v[i].y; d[2] = v[i].z; d[3] = v[i].w; }
    LDS_WAIT(); asm volatile("" ::: "memory");
    const int c = lane & 7;
#pragma unroll
    for (int j = 0; j < 8; ++j) { const int n = (lane >> 3) + 8 * j; const LAS float* s = scr + (8 * c) * 65 + n;
        int w0 = __builtin_amdgcn_cvt_pk_fp8_f32(s[0 * 65] * mul, s[1 * 65] * mul, 0, false); w0 = __builtin_amdgcn_cvt_pk_fp8_f32(s[2 * 65] * mul, s[3 * 65] * mul, w0, true);
        int w1 = __builtin_amdgcn_cvt_pk_fp8_f32(s[4 * 65] * mul, s[5 * 65] * mul, 0, false); w1 = __builtin_amdgcn_cvt_pk_fp8_f32(s[6 * 65] * mul, s[7 * 65] * mul, w1, true);
        u2v o; o.x = (unsigned)w0; o.y = (unsigned)w1; *(GAS u2v*)(Wt0 + (size_t)n * K + 8 * c) = o; }
    LDS_WAIT(); asm volatile("" ::: "memory");
}
__device__ __forceinline__ void sincos_d(double a, double& s, double& c) {
    const double n = __builtin_rint(a * 0.63661977236758134308);
    double r = __builtin_fma(-n, 1.57079632679489655800e+00, a); r = __builtin_fma(-n, 6.12323399573676603587e-17, r);
    const double r2 = r * r;
    double sp = -7.6471637318198164759e-13; sp = sp * r2 + 1.6059043836821614599e-10; sp = sp * r2 - 2.5052108385441718775e-08; sp = sp * r2 + 2.7557319223985890653e-06;
    sp = sp * r2 - 1.9841269841269841270e-04; sp = sp * r2 + 8.3333333333333333333e-03; sp = sp * r2 - 1.6666666666666666667e-01; const double sr = r + r * r2 * sp;
    double cp = 4.7794773323873852974e-14; cp = cp * r2 - 1.1470745597729724714e-11; cp = cp * r2 + 2.0876756987868098979e-09; cp = cp * r2 - 2.7557319223985890653e-07;
    cp = cp * r2 + 2.4801587301587301587e-05; cp = cp * r2 - 1.3888888888888888889e-03; cp = cp * r2 + 4.1666666666666666667e-02; cp = cp * r2 - 0.5; const double cr = 1.0 + r2 * cp;
    const int q = ((int)n) & 3;
    s = (q == 0) ? sr : (q == 1) ? cr : (q == 2) ? -sr : -cr;
    c = (q == 0) ? cr : (q == 1) ? -sr : (q == 2) ? -cr : sr;
}
constexpr int LI_IN = 16 * 32, LI_OUT = 16 * 16, LI_G = NEXP * 16 * 32, LI_D = NEXP * 32 * 16, LITEMS = LI_IN + LI_OUT + 2 * LI_G + LI_D;
__device__ __forceinline__ void conv_item(Frame& F, int L, int it) {
    LAS float* scr = (LAS float*)(F.lds + F.wave * 16640);
    int r = it;
    if (r < LI_IN) { const int kb = r >> 5, nb = r & 31;
        tr_item(F.in[8] + (size_t)L * 1024 * 2048 + (size_t)(64 * kb) * 2048 + 64 * nb, 2048, WSP(bf16, WS_WIN) + (size_t)L * 2048 * 1024 + (size_t)(64 * nb) * 1024 + 64 * kb, 1024, scr, F.lane); return; }
    r -= LI_IN;
    if (r < LI_OUT) { const int kb = r >> 4, nb = r & 15;
        tr_item(F.in[16] + (size_t)L * 1024 * 1024 + (size_t)(64 * kb) * 1024 + 64 * nb, 1024, WSP(bf16, WS_WOUT) + (size_t)L * 1024 * 1024 + (size_t)(64 * nb) * 1024 + 64 * kb, 1024, scr, F.lane); return; }
    r -= LI_OUT;
    if (r < 2 * LI_G) { const int up = r >= LI_G ? 1 : 0; if (up) r -= LI_G; const int mat = L * NEXP + (r >> 9), t = r & 511, kb = t >> 5, nb = t & 31;
        const int n0 = 64 * nb, drow = (n0 >> 7) * 256 + up * 128 + (n0 & 127);
        if (MOE_UP_FP8) tr_item8((up ? F.in[19] : F.in[18]) + (size_t)mat * 1024 * 2048 + (size_t)(64 * kb) * 2048 + n0, 2048, WSP(unsigned char, WS_WGU) + (size_t)mat * 4096 * 1024 + (size_t)drow * 1024 + 64 * kb, 1024, 64.0f, scr, F.lane);
        else tr_item((up ? F.in[19] : F.in[18]) + (size_t)mat * 1024 * 2048 + (size_t)(64 * kb) * 2048 + n0, 2048, WSP(bf16, WS_WGU) + (size_t)mat * 4096 * 1024 + (size_t)drow * 1024 + 64 * kb, 1024, scr, F.lane);
        return; }
    r -= 2 * LI_G;
    { const int mat = L * NEXP + (r >> 9), t = r & 511, kb = t >> 4, nb = t & 15;
        if (MOE_DOWN_FP8) tr_item8(F.in[20] + (size_t)mat * 2048 * 1024 + (size_t)(64 * kb) * 1024 + 64 * nb, 1024, WSP(unsigned char, WS_WD) + (size_t)mat * 1024 * 2048 + (size_t)(64 * nb) * 2048 + 64 * kb, 2048, 64.0f, scr, F.lane);
        else tr_item(F.in[20] + (size_t)mat * 2048 * 1024 + (size_t)(64 * kb) * 1024 + 64 * nb, 1024, WSP(bf16, WS_WD) + (size_t)mat * 1024 * 2048 + (size_t)(64 * nb) * 2048 + 64 * kb, 2048, scr, F.lane); }
}
constexpr int FQ_A = 3, FQ_B = 3, FQ_C = 2, FQ_D = 6;
constexpr int FILL_A0 = 0, FILL_B0 = FILL_A0 + 224 * NWAVES * FQ_A, FILL_C0 = FILL_B0 + 240 * NWAVES * FQ_B, FILL_D0 = FILL_C0 + 128 * NWAVES * FQ_C, FILL_R0 = FILL_D0 + 192 * NWAVES * FQ_D;
static_assert(FILL_R0 <= LITEMS, "filler quotas exceed a layer's items");
__device__ __forceinline__ void fill_convert(Frame& F, int L, int c0, int base, int q) {
    if (L >= DEPTH || F.bx < c0) return;
    const int nfw = (F.G - c0) * NWAVES, fw = (F.bx - c0) * NWAVES + F.wave;
    for (int k = 0; k < q; ++k) conv_item(F, L, base + fw + k * nfw);
}
__device__ __forceinline__ void fill_rest(Frame& F, int L) {
    if (L >= DEPTH) return;
    for (int it = FILL_R0 + F.bx * NWAVES + F.wave; it < LITEMS; it += F.G * NWAVES) conv_item(F, L, it);
}
__device__ __forceinline__ void p0_prologue(Frame& F) {
    {
        LAS float* sil = (LAS float*)F.lds;
        LAS float* part = sil + 8192;
        for (int i = F.tid; i < 5 * 1024; i += NWAVES * 64) { const int s = i >> 10, k = i & 1023; const float c = (s < 4) ? F.in[1][s * 1024 + k] : F.in[3][k]; sil[k * 8 + s] = c * fsigmoid(c); }
        __syncthreads();
        for (int it = F.bx; it < DEPTH * 96; it += F.G) {
            const int l = it / 96, j0 = (it % 96) * 64;
            const float* wa = F.in[4] + (size_t)l * 1024 * 6144 + j0 + F.lane;
            float a0 = 0.f, a1 = 0.f, a2 = 0.f, a3 = 0.f, a4 = 0.f;
            const int kb = F.wave * 128;
#pragma unroll 8
            for (int k = 0; k < 128; ++k) { const float w = wa[(size_t)(kb + k) * 6144]; const f32x4 sv = *(const LAS f32x4*)(sil + (kb + k) * 8); const float s4 = sil[(kb + k) * 8 + 4];
                a0 += w * sv.x; a1 += w * sv.y; a2 += w * sv.z; a3 += w * sv.w; a4 += w * s4; }
            LAS float* pw = part + F.wave * 320 + F.lane; pw[0] = a0; pw[64] = a1; pw[128] = a2; pw[192] = a3; pw[256] = a4;
            __syncthreads();
            if (F.wave < 5) { const int s = F.wave; float t = 0.f;
#pragma unroll
                for (int w = 0; w < 8; ++w) t += part[w * 320 + s * 64 + F.lane];
                const int j = j0 + F.lane, q = j >> 10, kk = j & 1023; t += F.in[5][l * 6144 + j];
                if (q == 1) t = F.in[6][l * 1024 + kk] * (1.0f + t); else if (q == 4) t = F.in[7][l * 1024 + kk] * (1.0f + t);
                WSP(float, WS_MODV)[(size_t)((l * 5 + s) * 6 + q) * 1024 + kk] = t; }
            __syncthreads();
        }
    }
    if (F.bx == F.G - 1) {
        for (int i = F.tid; i < 2048; i += NWAVES * 64) { const int pos = i >> 4, j = i & 15;
            double inv = 1.0; for (int q = 0; q < j; ++q) inv *= 0.56234132519034908039;
            double s, c; sincos_d((double)pos * (double)(float)inv, s, c);
            WSP(float, WS_ROPE)[i] = (float)c; WSP(float, WS_ROPE)[2048 + i] = (float)s; }
    }
    { const int gw = F.vcu * NWAVES + F.wave, NGW = F.G * NWAVES;
      for (int it = gw; it < LITEMS; it += NGW) conv_item(F, 0, it); }
}

__device__ __forceinline__ int row_set(int r) { const int b = r / TPB, t = r - b * TPB; return t < CTXL ? 4 : b; }
__device__ __forceinline__ void ld_x(Frame& F, int r, f32x4 (&v)[4]) {
    const GAS u2v* xr = (const GAS u2v*)(WSP(const bf16, WS_X) + (size_t)r * DM) + F.lane;
#pragma unroll
    for (int j = 0; j < 4; ++j) { const u2v w = xr[64 * j]; v[j] = (f32x4){bflo(w.x), bfhi(w.x), bflo(w.y), bfhi(w.y)}; }
}
__device__ __forceinline__ void st_x(Frame& F, int r, const f32x4 (&v)[4]) {
    GAS u2v* xr = (GAS u2v*)(WSP(bf16, WS_X) + (size_t)r * DM) + F.lane;
#pragma unroll
    for (int j = 0; j < 4; ++j) { u2v w; w.x = pk2(v[j].x, v[j].y); w.y = pk2(v[j].z, v[j].w); xr[64 * j] = w; }
}
__device__ __forceinline__ void ld_in(Frame& F, int r, f32x4 (&v)[4]) {
    const int b = r / TPB, t = r - b * TPB;
    const GAS f32x4* src = (const GAS f32x4*)(t < CTXL ? F.in[2] + ((size_t)b * CTXL + t) * DM : F.in[0] + ((size_t)b * SEQL + (t - CTXL)) * DM) + F.lane;
#pragma unroll
    for (int j = 0; j < 4; ++j) v[j] = src[64 * j];
}
__device__ __forceinline__ void ld_slot(Frame& F, int r, int& sl, float& af) {
    sl = (F.lane < 16) ? WSP(const int, WS_SLOT)[(size_t)r * 16 + F.lane] : -1;
    af = (F.lane < 16) ? WSP(const float, WS_AFF)[(size_t)r * 16 + F.lane] : 0.f;
}
__device__ __forceinline__ void combine_moe(Frame& F, int lprev, int s, int sl, float af, f32x4 (&v)[4]) {
    f32x4 acc[4];
#pragma unroll
    for (int j = 0; j < 4; ++j) acc[j] = (f32x4){0.f, 0.f, 0.f, 0.f};
#pragma unroll
    for (int e = 0; e < NEXP; ++e) {
        const int se = __builtin_amdgcn_readlane(sl, e);
        if (se >= 0) { const float ge = __uint_as_float(__builtin_amdgcn_readlane(__float_as_uint(af), e));
            const GAS u2v* yr = (const GAS u2v*)(WSP(const bf16, WS_Y) + ((size_t)e * ESLOTS + se) * DM) + F.lane;
#pragma unroll
            for (int j = 0; j < 4; ++j) { const u2v w = yr[64 * j]; acc[j] = acc[j] + ge * (f32x4){bflo(w.x), bfhi(w.x), bflo(w.y), bfhi(w.y)}; } }
    }
    const GAS f32x4* g2 = (const GAS f32x4*)(WSP(const float, WS_MODV) + (size_t)((lprev * 5 + s) * 6 + 5) * 1024) + F.lane;
#pragma unroll
    for (int j = 0; j < 4; ++j) v[j] = v[j] + g2[64 * j] * acc[j];
}
__device__ __forceinline__ float row_rstd(const f32x4 (&v)[4]) {
    float s = 0.f;
#pragma unroll
    for (int j = 0; j < 4; ++j) s += (v[j].x * v[j].x + v[j].y * v[j].y) + (v[j].z * v[j].z + v[j].w * v[j].w);
    return 1.0f / sqrtf(wave_sum(s) * (1.0f / DM) + EPS);
}
__device__ __forceinline__ void norm1_finish(Frame& F, int l, int r, int s, const f32x4 (&v)[4]) {
    st_x(F, r, v);
    const float rstd = row_rstd(v);
    const GAS f32x4* A = (const GAS f32x4*)(WSP(const float, WS_MODV) + (size_t)((l * 5 + s) * 6 + 1) * 1024) + F.lane;
    const GAS f32x4* B = (const GAS f32x4*)(WSP(const float, WS_MODV) + (size_t)((l * 5 + s) * 6 + 0) * 1024) + F.lane;
    GAS u2v* o = (GAS u2v*)(WSP(bf16, WS_HN) + (size_t)r * DM) + F.lane;
#pragma unroll
    for (int j = 0; j < 4; ++j) { const f32x4 h = v[j] * rstd * A[64 * j] + B[64 * j]; u2v w; w.x = pk2(h.x, h.y); w.y = pk2(h.z, h.w); o[64 * j] = w; }
}
__device__ __forceinline__ void build_router_tab(Frame& F, int l, int c0);
__device__ __forceinline__ void ph_norm1(Frame& F, int l) {
    if (l == 0) build_router_tab(F, 0, 0);
    for (int ch = F.bx; ch < 256; ch += F.G) {
        for (int i = F.wave; i < 132; i += 2 * NWAVES) {
            const bool vB = i + NWAVES < 132;
            const int rA = ch * 132 + i, rB = vB ? rA + NWAVES : rA, sA = row_set(rA), sB = row_set(rB);
            f32x4 a[4], b[4];
            if (l == 0) { ld_in(F, rA, a); ld_in(F, rB, b); }
            else { int slA, slB; float afA, afB;
                ld_slot(F, rA, slA, afA); ld_slot(F, rB, slB, afB); ld_x(F, rA, a); ld_x(F, rB, b);
                combine_moe(F, l - 1, sA, slA, afA, a); combine_moe(F, l - 1, sB, slB, afB, b); }
            norm1_finish(F, l, rA, sA, a);
            if (vB) norm1_finish(F, l, rB, sB, b);
        }
    }
}
__device__ __forceinline__ void build_router_tab(Frame& F, int l, int c0) {
    if (l >= DEPTH || F.bx < c0 || F.bx >= c0 + 20) return;
    const int s = (F.bx - c0) >> 2, qd = (F.bx - c0) & 3;
    const float* A2 = WSP(const float, WS_MODV) + (size_t)((l * 5 + s) * 6 + 4) * 1024; const float* B2 = WSP(const float, WS_MODV) + (size_t)((l * 5 + s) * 6 + 3) * 1024;
    const float* wr = F.in[17] + (size_t)l * 1024 * 16;
    bf16* th = WSP(bf16, WS_RW) + (size_t)(l * 5 + s) * 32768; bf16* tl = th + 16384;
    for (int idx = F.tid; idx < 256 * 16; idx += NWAVES * 64) { const int k = 256 * qd + (idx >> 4), e = idx & 15;
        const float v = A2[k] * wr[k * 16 + e]; const unsigned h = f2bf(v); const float lo = v - __uint_as_float(h << 16);
        const int off = (((k >> 5) * 64 + ((k >> 3) & 3) * 16 + e) << 3) + (k & 7);
        th[off] = (bf16)h; tl[off] = (bf16)f2bf(lo); }
    if (qd == 0) {
        LAS float* part = (LAS float*)F.lds;
        { const int e = F.tid & 15, kg = F.tid >> 4; float a = 0.f;
#pragma unroll 16
          for (int k = 32 * kg; k < 32 * kg + 32; ++k) a += B2[k] * wr[k * 16 + e];
          part[kg * 16 + e] = a; }
        __syncthreads();
        if (F.tid < 16) { float a = 0.f; for (int kg = 0; kg < 32; ++kg) a += part[kg * 16 + F.tid]; WSP(float, WS_RC)[(l * 5 + s) * 16 + F.tid] = a; }
        __syncthreads();
    }
}
__device__ __forceinline__ void norm2_load(Frame& F, int g, v4u (&xa)[32]) {
    const int fr = F.lane & 15, kq = F.lane >> 4; const size_t r = (size_t)16 * g + fr;
    const GAS v4u* xp = (const GAS v4u*)(WSP(const bf16, WS_X) + r * DM + 8 * kq);
#pragma unroll
    for (int st = 0; st < 32; ++st) xa[st] = xp[4 * st];
}
__device__ __forceinline__ void norm2_group(Frame& F, int l, int g, int s, const LAS unsigned char* tab, v4u (&xa)[32]) {
    int ln = F.lane; asm volatile("" : "+v"(ln));
    const int fr = ln & 15, kq = ln >> 4; const size_t r = (size_t)16 * g + fr;
    float ss = 0.f;
#pragma unroll
    for (int st = 0; st < 32; ++st) { const v4u w = xa[st];
        ss += (bflo(w.x) * bflo(w.x) + bfhi(w.x) * bfhi(w.x)) + (bflo(w.y) * bflo(w.y) + bfhi(w.y) * bfhi(w.y)) + (bflo(w.z) * bflo(w.z) + bfhi(w.z) * bfhi(w.z)) + (bflo(w.w) * bflo(w.w) + bfhi(w.w) * bfhi(w.w)); }
    ss += __shfl_xor(ss, 16); ss += __shfl_xor(ss, 32);
    const float rstd = 1.0f / sqrtf(ss * (1.0f / DM) + EPS);
    f32x4 acc = (f32x4){0.f, 0.f, 0.f, 0.f};
#pragma unroll
    for (int st = 0; st < 32; ++st) { const bf16x8 bh = *(const LAS bf16x8*)(tab + (st * 64 + ln) * 16), bl = *(const LAS bf16x8*)(tab + 32768 + (st * 64 + ln) * 16);
        const bf16x8 a = __builtin_bit_cast(bf16x8, xa[st]);
        acc = __builtin_amdgcn_mfma_f32_16x16x32_bf16(a, bh, acc, 0, 0, 0); acc = __builtin_amdgcn_mfma_f32_16x16x32_bf16(a, bl, acc, 0, 0, 0);
        if ((st & 3) == 3) asm volatile("" ::: "memory"); }
    const float cj = WSP(const float, WS_RC)[(l * 5 + s) * 16 + fr];
#pragma unroll
    for (int e = 0; e < 4; ++e) { const float rs = __shfl(rstd, 4 * kq + e); const float lg = acc[e] * rs + cj;
        float mx = lg; mx = fmaxf(mx, __shfl_xor(mx, 1)); mx = fmaxf(mx, __shfl_xor(mx, 2)); mx = fmaxf(mx, __shfl_xor(mx, 4)); mx = fmaxf(mx, __shfl_xor(mx, 8));
        const float ex = fexp2((lg - mx) * LOG2E); float sm = ex; sm += __shfl_xor(sm, 1); sm += __shfl_xor(sm, 2); sm += __shfl_xor(sm, 4); sm += __shfl_xor(sm, 8);
        WSP(float, WS_AFF)[((size_t)16 * g + 4 * kq + e) * 16 + fr] = ex / sm; }
    const GAS f32x4* A = (const GAS f32x4*)(WSP(const float, WS_MODV) + (size_t)((l * 5 + s) * 6 + 4) * 1024 + 8 * kq);
    const GAS f32x4* B = (const GAS f32x4*)(WSP(const float, WS_MODV) + (size_t)((l * 5 + s) * 6 + 3) * 1024 + 8 * kq);
    GAS v4u* op = (GAS v4u*)(WSP(bf16, WS_HN) + r * DM + 8 * kq);
    GAS u2v* op8 = (GAS u2v*)(WSP(unsigned char, WS_HN) + r * DM + 8 * kq);
#pragma unroll
    for (int st = 0; st < 32; ++st) { v4u w = xa[st]; asm volatile("" : "+v"(w));     const f32x4 a0 = A[8 * st], a1 = A[8 * st + 1], b0 = B[8 * st], b1 = B[8 * st + 1];
        if (MOE_UP_FP8) { int o0 = __builtin_amdgcn_cvt_pk_fp8_f32(bflo(w.x) * rstd * a0.x + b0.x, bfhi(w.x) * rstd * a0.y + b0.y, 0, false); o0 = __builtin_amdgcn_cvt_pk_fp8_f32(bflo(w.y) * rstd * a0.z + b0.z, bfhi(w.y) * rstd * a0.w + b0.w, o0, true);
            int o1 = __builtin_amdgcn_cvt_pk_fp8_f32(bflo(w.z) * rstd * a1.x + b1.x, bfhi(w.z) * rstd * a1.y + b1.y, 0, false); o1 = __builtin_amdgcn_cvt_pk_fp8_f32(bflo(w.w) * rstd * a1.z + b1.z, bfhi(w.w) * rstd * a1.w + b1.w, o1, true);
            u2v o8; o8.x = (unsigned)o0; o8.y = (unsigned)o1; op8[4 * st] = o8; }
        else { v4u o; o.x = pk2(bflo(w.x) * rstd * a0.x + b0.x, bfhi(w.x) * rstd * a0.y + b0.y); o.y = pk2(bflo(w.y) * rstd * a0.z + b0.z, bfhi(w.y) * rstd * a0.w + b0.w);
            o.z = pk2(bflo(w.z) * rstd * a1.x + b1.x, bfhi(w.z) * rstd * a1.y + b1.y); o.w = pk2(bflo(w.w) * rstd * a1.z + b1.z, bfhi(w.w) * rstd * a1.w + b1.w);
            op[4 * st] = o; }
        if (st & 1) asm volatile("" ::: "memory"); }
}
__device__ __forceinline__ int group_set(int g) { const int r = 16 * g, b = r / TPB, t = r - b * TPB; return t < CTXL ? 4 : b; }
__device__ __forceinline__ void ph_norm2(Frame& F, int l) {
    for (int c = F.bx; c < 256; c += F.G) {
        const int g_lo = (33 * c) >> 2, g_hi = (33 * (c + 1)) >> 2, sA = group_set(g_lo), sB = group_set(g_hi - 1);
        v4u xa[32]; norm2_load(F, g_lo + F.wave, xa);
        { const GAS v4u* src = (const GAS v4u*)(WSP(const bf16, WS_RW) + (size_t)(l * 5 + sA) * 32768); LAS v4u* dst = (LAS v4u*)F.lds;
          for (int i = F.tid; i < 4096; i += NWAVES * 64) dst[i] = src[i];
          if (sB != sA) { const GAS v4u* src2 = (const GAS v4u*)(WSP(const bf16, WS_RW) + (size_t)(l * 5 + sB) * 32768); for (int i = F.tid; i < 4096; i += NWAVES * 64) dst[4096 + i] = src2[i]; } }
        __syncthreads();
        for (int g = g_lo + F.wave; g < g_hi; g += NWAVES) { const int s = group_set(g); if (g != g_lo + F.wave) norm2_load(F, g, xa); norm2_group(F, l, g, s, (const LAS unsigned char*)F.lds + (s == sA ? 0 : 65536), xa); }
        __syncthreads();
    }
}
__device__ __forceinline__ void final_finish(Frame& F, int r, const f32x4 (&v)[4]) {
    const int b = r / TPB, t = r - b * TPB;
    const float rstd = row_rstd(v);
    const GAS f32x4* g = (const GAS f32x4*)F.in[21] + F.lane;
    GAS f32x4* o = (GAS f32x4*)(F.out + ((size_t)b * SEQL + (t - CTXL)) * DM) + F.lane;
#pragma unroll
    for (int j = 0; j < 4; ++j) o[64 * j] = v[j] * rstd * g[64 * j];
}
__device__ __forceinline__ void ph_final(Frame& F) {
    for (int ch = F.bx; ch < 256; ch += F.G) {
        for (int i = F.wave; i < 132; i += 2 * NWAVES) {
            const bool vB = i + NWAVES < 132;
            const int rA = ch * 132 + i, rB = vB ? rA + NWAVES : rA;
            const int bA = rA / TPB, tA = rA - bA * TPB, bB = rB / TPB, tB = rB - bB * TPB;
            f32x4 a[4], b[4]; int slA, slB; float afA, afB;
            ld_slot(F, rA, slA, afA); ld_slot(F, rB, slB, afB); ld_x(F, rA, a); ld_x(F, rB, b);
            if (tA >= CTXL) combine_moe(F, DEPTH - 1, bA, slA, afA, a);
            if (tB >= CTXL) combine_moe(F, DEPTH - 1, bB, slB, afB, b);
            if (tA >= CTXL) final_finish(F, rA, a);
            if (vB && tB >= CTXL) final_finish(F, rB, b);
        }
    }
}

__device__ __forceinline__ void ph_conv(Frame& F, int l) {
    LAS float* U = (LAS float*)F.lds;
    const float* cw = F.in[12] + (size_t)l * 31 * 256 + 4 * F.lane;
    f32x4 w[31];
#pragma unroll
    for (int j = 0; j < 31; ++j) w[j] = *(const GAS f32x4*)(cw + j * 256);
    const f32x4 cbv = *(const GAS f32x4*)(F.in[13] + l * 256 + 4 * F.lane), lgv = *(const GAS f32x4*)(F.in[14] + l * 256 + 4 * F.lane), lbv = *(const GAS f32x4*)(F.in[15] + l * 256 + 4 * F.lane);
    const bf16* P = WSP(const bf16, WS_P);
    for (int tile = F.bx; tile < NROW / 66; tile += F.G) {
        const int r0 = tile * 66, b = r0 / TPB, t0 = r0 - b * TPB, seam = b * TPB + CTXL;
        const bool straddle = (t0 < CTXL) && (t0 + 66 > CTXL);
        for (int part = 0; part < (straddle ? 2 : 1); ++part) {
            const bool ctxpart = straddle ? (part == 0) : (t0 < CTXL);
            const int seg_lo = ctxpart ? b * TPB : seam, seg_hi = ctxpart ? seam : (b + 1) * TPB;
            const int p_lo = r0 > seg_lo ? r0 : seg_lo, p_hi = (r0 + 66) < seg_hi ? (r0 + 66) : seg_hi;
            for (int it = F.tid; it < 96 * 32; it += NWAVES * 64) { const int lr = it >> 5, chn = (it & 31) * 8, r = r0 - 15 + lr;
                f32x4 u0 = (f32x4){0.f, 0.f, 0.f, 0.f}, u1 = u0;
                if (r >= seg_lo && r < seg_hi) { const v4u cv = *(const GAS v4u*)(P + (size_t)r * INW + COL_CV + chn), cg = *(const GAS v4u*)(P + (size_t)r * INW + COL_CG + chn);
                    u0.x = bflo(cv.x) * fsigmoid(bflo(cg.x)); u0.y = bfhi(cv.x) * fsigmoid(bfhi(cg.x)); u0.z = bflo(cv.y) * fsigmoid(bflo(cg.y)); u0.w = bfhi(cv.y) * fsigmoid(bfhi(cg.y));
                    u1.x = bflo(cv.z) * fsigmoid(bflo(cg.z)); u1.y = bfhi(cv.z) * fsigmoid(bfhi(cg.z)); u1.z = bflo(cv.w) * fsigmoid(bflo(cg.w)); u1.w = bfhi(cv.w) * fsigmoid(bfhi(cg.w)); }
                *(LAS f32x4*)(U + lr * 256 + chn) = u0; *(LAS f32x4*)(U + lr * 256 + chn + 4) = u1; }
            __syncthreads();
            for (int i = (p_lo - r0) + F.wave; i < p_hi - r0; i += NWAVES) {
                f32x4 y = cbv;
#pragma unroll
                for (int j = 0; j < 31; ++j) y = y + w[j] * *(const LAS f32x4*)(U + (i + j) * 256 + 4 * F.lane);
                const float mean = wave_sum((y.x + y.y) + (y.z + y.w)) * (1.0f / 256.0f);
                const f32x4 d = y - mean;
                const float var = wave_sum((d.x * d.x + d.y * d.y) + (d.z * d.z + d.w * d.w)) * (1.0f / 256.0f);
                const float rstd = 1.0f / sqrtf(var + EPS);
                f32x4 z = d * rstd * lgv + lbv;
                z.x *= fsigmoid(z.x); z.y *= fsigmoid(z.y); z.z *= fsigmoid(z.z); z.w *= fsigmoid(z.w);
                u2v o; o.x = pk2(z.x, z.y); o.y = pk2(z.z, z.w);
                *(GAS u2v*)(WSP(bf16, WS_MIX) + (size_t)(r0 + i) * DM + MIX_C + 4 * F.lane) = o;
            }
            __syncthreads();
        }
    }
}

__device__ __forceinline__ int block_excl_scan(Frame& F, int v, LAS int* sc) {
    int inc = v;
#pragma unroll
    for (int o = 1; o < 64; o <<= 1) { const int t = __shfl_up(inc, o); if (F.lane >= o) inc += t; }
    if (F.lane == 63) sc[F.wave] = inc;
    __syncthreads();
    int base = 0;
#pragma unroll
    for (int w = 0; w < NWAVES; ++w) base += (w < F.wave) ? sc[w] : 0;
    __syncthreads();
    return base + inc - v;
}
__device__ __forceinline__ void topk_unit(Frame& F, int kind, int b, int e) {
    LAS unsigned* vals = (LAS unsigned*)F.lds;
    LAS unsigned* hist = vals + 8192;
    LAS int* sc = (LAS int*)(hist + 256);
    const int n = kind ? CTXL : SEQL, cap = kind ? CAPC : CAPL;
    const int row0 = b * TPB + (kind ? 0 : CTXL), slot0 = kind ? NBATCH * CAPL + b * CAPC : b * CAPL;
    const float* aff = WSP(const float, WS_AFF);
    for (int i = F.tid; i < n; i += NWAVES * 64) vals[i] = __float_as_uint(aff[(size_t)(row0 + i) * 16 + e]);
    __syncthreads();
    unsigned prefix = 0u; int need = cap;
    for (int round = 0; round < 4; ++round) {
        const int shift = 24 - 8 * round;
        if (F.tid < 256) hist[F.tid] = 0u;
        __syncthreads();
        for (int i = F.tid; i < n; i += NWAVES * 64) { const unsigned v = vals[i]; const bool match = (round == 0) || ((v >> (shift + 8)) == prefix); if (match) atomicAdd((unsigned*)&hist[(v >> shift) & 255u], 1u); }
        __syncthreads();
        if (F.wave == 0) {
            const unsigned h0 = hist[4 * F.lane], h1 = hist[4 * F.lane + 1], h2 = hist[4 * F.lane + 2], h3 = hist[4 * F.lane + 3];
            const unsigned s = h0 + h1 + h2 + h3; unsigned suf = s;
#pragma unroll
            for (int o = 1; o < 64; o <<= 1) { const unsigned t = __shfl_down(suf, o); if (F.lane + o < 64) suf += t; }
            const unsigned above = suf - s;
            if (above < (unsigned)need && (unsigned)need <= above + s) {
                unsigned a = above; int bin, nn;
                if ((unsigned)need <= a + h3) { bin = 3; nn = need - (int)a; } else { a += h3;
                if ((unsigned)need <= a + h2) { bin = 2; nn = need - (int)a; } else { a += h2;
                if ((unsigned)need <= a + h1) { bin = 1; nn = need - (int)a; } else { a += h1; bin = 0; nn = need - (int)a; } } }
                sc[0] = 4 * F.lane + bin; sc[1] = nn; }
        }
        __syncthreads();
        prefix = (prefix << 8) | (unsigned)sc[0]; need = sc[1];
        __syncthreads();
    }
    const unsigned T = prefix;
    const int cnt = kind ? (F.tid < CTXL ? 1 : 0) : 16, start = kind ? F.tid : 16 * F.tid;
    int ngt = 0, neq = 0;
    for (int i = 0; i < cnt; ++i) { const unsigned v = vals[start + i]; ngt += v > T ? 1 : 0; neq += v == T ? 1 : 0; }
    const int eqpre = block_excl_scan(F, neq, sc);
    int take = need - eqpre; take = take < 0 ? 0 : (take > neq ? neq : take);
    int pos = block_excl_scan(F, ngt + take, sc);
    int* idx = WSP(int, WS_IDX) + (size_t)e * ESLOTS + slot0;
    int* slot = WSP(int, WS_SLOT);
    for (int i = 0; i < cnt; ++i) { const unsigned v = vals[start + i]; int sl = -1;
        if (v > T) sl = pos++; else if (v == T && take > 0) { sl = pos++; --take; }
        const int r = row0 + start + i;
        slot[(size_t)r * 16 + e] = sl >= 0 ? slot0 + sl : -1;
        if (sl >= 0) idx[sl] = r; }
    if (kind == 1 && b == 0 && F.tid < ESLOTS - EUSED) WSP(int, WS_IDX)[(size_t)e * ESLOTS + EUSED + F.tid] = 0;
    __syncthreads();
}
__device__ __forceinline__ void ph_topk(Frame& F) {
    for (int u = F.bx; u < 2 * NBATCH * NEXP; u += F.G) topk_unit(F, u / (NBATCH * NEXP), (u % (NBATCH * NEXP)) / NEXP, u % NEXP);
}

__device__ __forceinline__ void ph_vt8(Frame& F) {
    LAS unsigned char* scr = (LAS unsigned char*)(F.lds + F.wave * 4352);
    const bf16* P = WSP(const bf16, WS_P);
    const int gw = F.vcu * NWAVES + F.wave, NGW = F.G * NWAVES;
    for (int it = gw; it < NBATCH * 2 * (TPB / 64); it += NGW) {
        const int tile = it % (TPB / 64), bk = it / (TPB / 64), b = bk >> 1, kvh = bk & 1;
        const int kk = F.lane, c = kk >> 5, k5 = kk & 31, h = (k5 >> 2) & 1, pos = 32 * h + 16 * c + 4 * (k5 >> 3) + (k5 & 3);
        const GAS v4u* vr = (const GAS v4u*)(P + ((size_t)b * TPB + 64 * tile + kk) * INW + COL_VA + kvh * 64);
        v4u w[8];
#pragma unroll
        for (int i = 0; i < 8; ++i) w[i] = vr[i];
#pragma unroll
        for (int i = 0; i < 8; ++i) {
#pragma unroll
            for (int e = 0; e < 4; ++e) { const unsigned x = w[i][e]; const int p2 = __builtin_amdgcn_cvt_pk_fp8_f32(bflo(x), bfhi(x), 0, false);
                scr[(8 * i + 2 * e) * 68 + pos] = (unsigned char)(p2 & 0xff); scr[(8 * i + 2 * e + 1) * 68 + pos] = (unsigned char)((p2 >> 8) & 0xff); } }
        LDS_WAIT(); asm volatile("" ::: "memory");
        { const LAS unsigned* rr = (const LAS unsigned*)(scr + F.lane * 68);
          GAS v4u* o = (GAS v4u*)(WSP(unsigned char, WS_VT8) + (size_t)it * 4096 + F.lane * 64);
#pragma unroll
          for (int q = 0; q < 4; ++q) { v4u v; v.x = rr[4 * q]; v.y = rr[4 * q + 1]; v.z = rr[4 * q + 2]; v.w = rr[4 * q + 3]; o[q] = v; } }
        LDS_WAIT(); asm volatile("" ::: "memory");
    }
}

__device__ __forceinline__ void ph_attn(Frame& F, int l, bool last, char* shm) {
    typedef attn_body::bf16 abf;
    const abf* P = (const abf*)WSP(const bf16, WS_P); abf* MIX = (abf*)WSP(bf16, WS_MIX);
    float m0; bool fixm;
    { float gq = fabsf(F.in[9][l * 64 + F.lane]), gk = fabsf(F.in[10][l * 64 + F.lane]);
#pragma unroll
      for (int o = 1; o < 64; o <<= 1) { gq = fmaxf(gq, __shfl_xor(gq, o)); gk = fmaxf(gk, __shfl_xor(gk, o)); }
      m0 = __uint_as_float(__builtin_amdgcn_readfirstlane(__float_as_uint(64.0f * C2 * 1.014f * gq * gk))); fixm = m0 <= 60.0f; }
    for (int L = F.vcu; L < 7 * 256; L += F.G) {
        const int i = L >> 8, v = L & 255, x = v >> 5, j = v & 31;
        if (i == 4 || i == 5) {
            const int b = x >> 1, h = (x & 1) * 2 + (i - 4), gr0 = 4 * j, kr0 = gr0 - 4 < 0 ? 0 : (gr0 - 4 > 116 ? 116 : gr0 - 4);
            const size_t row0 = (size_t)b * TPB + CTXL + 256 * j, k0 = (size_t)b * TPB;
            attn_body::attn_unit<8, true, false>(P + row0 * INW + COL_QB + h * 64, P + k0 * INW + COL_KB + h * 64, P + k0 * INW + COL_VB + h * 64, MIX + row0 * DM + MIX_B + h * 64, 16, kr0, gr0, kr0,
                                          F.in[11] + (size_t)(l * 4 + h) * 465, 0.f, shm);
        } else {
            size_t row0, k0; int qc, kc, vc, oc, NT; bool isA = true;
            if (i < 4 && fixm) {
                if (i >= 2) continue;
                const int b = x >> 1, kvh = x & 1, idx = i * 32 + j, h = kvh * 4 + (idx >> 4), qb = idx & 15; const size_t r0 = (size_t)b * TPB + CTXL + 512 * qb, kk0 = (size_t)b * TPB;
                if (ATTN_FP8_QK && ATTN_FP8_PV && m0 <= 17.0f)     attn_body::attn_unit64f8pv<0>(WSP(const unsigned char, WS_Q8) + r0 * 512 + h * 64, WSP(const unsigned char, WS_K8) + kk0 * 128 + kvh * 64, WSP(const unsigned char, WS_VT8) + (size_t)((b * 2 + kvh) * (TPB / 64)) * 4096, MIX + r0 * DM + MIX_A + h * 64, TPB / 64, shm);
                else if (ATTN_FP8_QK) attn_body::attn_unit64f8<0>(WSP(const unsigned char, WS_Q8) + r0 * 512 + h * 64, WSP(const unsigned char, WS_K8) + kk0 * 128 + kvh * 64, P + kk0 * INW + COL_VA + kvh * 64, MIX + r0 * DM + MIX_A + h * 64, TPB / 64, shm);
                else attn_body::attn_unit64<0>(P + r0 * INW + COL_QA + h * 64, P + kk0 * INW + COL_KA + kvh * 64, P + kk0 * INW + COL_VA + kvh * 64, MIX + r0 * DM + MIX_A + h * 64, TPB / 64, shm);
                continue; }
            if (i < 4) { const int b = x >> 1, kvh = x & 1, h = kvh * 4 + i; row0 = (size_t)b * TPB + CTXL + 256 * j; k0 = (size_t)b * TPB; qc = COL_QA + h * 64; kc = COL_KA + kvh * 64; vc = COL_VA + kvh * 64; oc = MIX_A + h * 64; NT = TPB / 64; }
            else { int u = j * 8 + x; if (last || u >= 48) continue;
                if (u < 32) { const int b = u >> 3, h = u & 7; row0 = k0 = (size_t)b * TPB; qc = COL_QA + h * 64; kc = COL_KA + (h >> 2) * 64; vc = COL_VA + (h >> 2) * 64; oc = MIX_A + h * 64; }
                else { isA = false; u -= 32; const int b = u >> 2, h = u & 3; row0 = k0 = (size_t)b * TPB; qc = COL_QB + h * 64; kc = COL_KB + h * 64; vc = COL_VB + h * 64; oc = MIX_B + h * 64; }
                NT = CTXL / 64; }
            if (isA && fixm) attn_body::attn_unit<8, false, true>(P + row0 * INW + qc, P + k0 * INW + kc, P + k0 * INW + vc, MIX + row0 * DM + oc, NT, 0, 0, 0, nullptr, m0, shm);
            else attn_body::attn_unit<8, false, false>(P + row0 * INW + qc, P + k0 * INW + kc, P + k0 * INW + vc, MIX + row0 * DM + oc, NT, 0, 0, 0, nullptr, 0.f, shm);
        }
    }
}

template <int DBG> __device__ __forceinline__ void ph_attn_dbg(Frame& F, float m0, char* shm) {
    typedef attn_body::bf16 abf;
    const abf* P = (const abf*)WSP(const bf16, WS_P); abf* DUM = (abf*)WSP(bf16, WS_H1);
    for (int L = F.vcu; L < 2 * 256; L += F.G) {
        const int i = L >> 8, v = L & 255, x = v >> 5, j = v & 31, b = x >> 1, kvh = x & 1, idx = i * 32 + j, h = kvh * 4 + (idx >> 4), qb = idx & 15;
        const size_t r0 = (size_t)b * TPB + CTXL + 512 * qb, kk0 = (size_t)b * TPB;
        attn_body::attn_unit64<DBG>(P + r0 * INW + COL_QA + h * 64, P + kk0 * INW + COL_KA + kvh * 64, P + kk0 * INW + COL_VA + kvh * 64, DUM + r0 * DM + h * 64, TPB / 64, shm);
    }
}

struct Args { const float* in[22]; float* out; unsigned char* ws; int ph_lo, ph_hi; };
__global__ void __launch_bounds__(NWAVES * 64, 2) mk_fwd(Args args) {
    extern __shared__ __attribute__((aligned(16))) unsigned char lds[];
    asm volatile("s_setreg_imm32_b32 hwreg(HW_REG_MODE, 23, 1), 1");
    Frame F;
    F.lds = (LAS unsigned char*)lds;
    F.MISC = (volatile LAS unsigned*)(F.lds + MISC_OFF);
    F.tid = threadIdx.x; F.lane = F.tid & 63; F.wave = __builtin_amdgcn_readfirstlane(F.tid >> 6);
    F.G = gridDim.x; F.bx = blockIdx.x; { const int bx = blockIdx.x; F.vcu = (F.G % 8 == 0) ? (bx % 8) * (F.G / 8) + bx / 8 : bx; }
    F.ws = args.ws; F.ctl = (gu32*)(args.ws + WS_CTL); F.out = args.out;
#pragma unroll
    for (int i = 0; i < 22; ++i) F.in[i] = args.in[i];
    for (int u = F.tid; u < (LDS_BYTES - LDSCTL_OFF) / 4; u += NWAVES * 64) ((LAS unsigned*)(F.lds + LDSCTL_OFF))[u] = 0u;
    __syncthreads();
    const int lo = args.ph_lo, hi = args.ph_hi;
    const bool multi = (hi - lo) > 1;
    XcdBarrier bar; bar.bar = (unsigned*)(F.ctl + CW_BAR); bar.x = 0; bar.st = nullptr;
    if (multi) bar = xcd_barrier_post((unsigned*)(F.ctl + CW_BAR), F.MISC + 8);
#define IN(k) (lo <= (k) && (k) < hi)
#define PHB() do { int t_ = threadIdx.x; asm volatile("" : "+v"(t_)); F.tid = t_; F.lane = t_ & 63; F.wave = __builtin_amdgcn_readfirstlane(t_ >> 6); int b_ = blockIdx.x, g_ = gridDim.x; asm volatile("" : "+s"(b_), "+s"(g_)); F.bx = b_; F.G = g_; F.vcu = (g_ % 8 == 0) ? (b_ % 8) * (g_ / 8) + b_ / 8 : b_; } while (0)
    unsigned long long tprev_ = 0ull, pacc_ = 0ull; if (PROBE_KIND >= 0) tprev_ = rt();
#define SEAM(k) do { if (IN((k) + 1)) xcd_barrier(bar); if (PROBE_KIND >= 0) { const unsigned long long now_ = rt(); const int kind_ = ((k) == 0) ? 8 : ((k) - 1) % NPL; if (kind_ == PROBE_KIND) pacc_ += now_ - tprev_; tprev_ = now_; } } while (0)

    if (IN(0)) { PHB(); p0_prologue(F); if (REP_P0 > 1) { PHB(); p0_prologue(F); } SEAM(0); }
    for (int l = 0; l < DEPTH; ++l) {
        const int pb = 1 + l * NPL;
        if (IN(pb + LP_NORM1)) { PHB(); ph_norm1(F, l); SEAM(pb + LP_NORM1); }
        if (IN(pb + LP_INPROJ)) {
            PHB(); pg8::Gemm g{WSP(const bf16, WS_HN), WSP(const bf16, WS_WIN) + (size_t)l * INW * DM, NROW, INW, DM}; pg8::StaticOrder S; S.init(NROW, INW, F.G, F.bx, 0, 0, 0, WGM_IN);
            pg8::EpiInProj E{WSP(bf16, WS_P), INW, F.in[9] + l * 64, F.in[10] + l * 64, WSP(const float, WS_ROPE), C2, WSP(unsigned char, WS_Q8), WSP(unsigned char, WS_K8)};
            pg8::gemm_phase<pg8::EpiInProj, pg8::StaticOrder, true, true>(F.lds + RING_OFF, g, S, E); if (REP_INPROJ > 1) { pg8::gemm_phase<pg8::EpiInProj, pg8::StaticOrder, true, true>(F.lds + RING_OFF, g, S, E); }
            PHB(); fill_convert(F, l + 1, 32, FILL_A0, FQ_A);
            SEAM(pb + LP_INPROJ);
        }
        if (IN(pb + LP_VT)) { if (ATTN_FP8_PV) { PHB(); ph_vt8(F); } SEAM(pb + LP_VT); }
        if (IN(pb + LP_MIX)) { PHB(); ph_attn(F, l, l == DEPTH - 1, (char*)lds + RING_OFF); if (REP_ATTN > 1) { PHB(); ph_attn(F, l, l == DEPTH - 1, (char*)lds + RING_OFF); } PHB(); ph_conv(F, l); if (REP_CONV > 1) { PHB(); ph_conv(F, l); }
            if (ATTN_DBG != 0) { __syncthreads(); const unsigned long long t0_ = rt(); PHB(); ph_attn_dbg<ATTN_DBG>(F, 16.0f, (char*)lds + RING_OFF); pacc_ += rt() - t0_; }
            SEAM(pb + LP_MIX); }
        if (IN(pb + LP_OUTPROJ)) {
            PHB(); pg8::Gemm g{WSP(const bf16, WS_MIX), WSP(const bf16, WS_WOUT) + (size_t)l * DM * DM, NROW, DM, DM}; pg8::StaticOrder S; S.init(NROW, DM, F.G, F.bx, 0, l == DEPTH - 1 ? 33 : 0, 1, WGM_OUT);
            pg8::EpiResGate E{WSP(bf16, WS_X), DM, WSP(const float, WS_MODV) + (size_t)l * 5 * 6 * 1024, 2};
            pg8::gemm_phase<pg8::EpiResGate, pg8::StaticOrder, true, true>(F.lds + RING_OFF, g, S, E);
            PHB(); fill_convert(F, l + 1, 16, FILL_B0, FQ_B);
            SEAM(pb + LP_OUTPROJ);
        }
        if (IN(pb + LP_NORM2)) { PHB(); ph_norm2(F, l); if (REP_NORM2 > 1) { PHB(); ph_norm2(F, l); } SEAM(pb + LP_NORM2); }
        if (IN(pb + LP_TOPK)) { PHB(); ph_topk(F); if (REP_TOPK > 1) { PHB(); ph_topk(F); } PHB(); build_router_tab(F, l + 1, 236); __syncthreads(); fill_convert(F, l + 1, 128, FILL_C0, FQ_C); fill_rest(F, l + 1); SEAM(pb + LP_TOPK); }
        if (IN(pb + LP_G1)) {
            PHB(); pg8::Gemm g{WSP(const bf16, WS_HN), WSP(const bf16, WS_WGU) + (size_t)l * NEXP * 4096 * (MOE_UP_FP8 ? DM / 2 : DM), NEXP * ESLOTS, 4096, MOE_UP_FP8 ? DM / 2 : DM}; pg8::GatherOrder S;
            S.init(NEXP * ESLOTS, 4096, F.G, F.bx, ETILES, l == DEPTH - 1 ? ETILES : 0, 0, WGM_G1);
            S.offtab = (const LAS unsigned*)(F.lds + GTAB_OFF);
            { LAS unsigned* tab = (LAS unsigned*)(F.lds + GTAB_OFF); pg8::Unit u; const int* idx = WSP(const int, WS_IDX);
              for (int i = 0; i < GTAB_UNITS && S.next(i, u); ++i) if (F.tid < 256) tab[i * 256 + F.tid] = (unsigned)idx[(size_t)u.pm * 256 + F.tid] * (unsigned)(MOE_UP_FP8 ? DM : DM * 2);
              __syncthreads(); }
            pg8::EpiSwiGLUT<MOE_DOWN_FP8> E{WSP(bf16, WS_H1), EDIM};
            if constexpr (MOE_UP_FP8) pg8::gemm_phase<pg8::EpiSwiGLUT<MOE_DOWN_FP8>, pg8::GatherOrder, true, false, 2, 121>(F.lds + RING_OFF, g, S, E);
            else pg8::gemm_phase<pg8::EpiSwiGLUT<MOE_DOWN_FP8>, pg8::GatherOrder, true, true>(F.lds + RING_OFF, g, S, E);
            SEAM(pb + LP_G1);
        }
        if (IN(pb + LP_G2)) {
            PHB(); pg8::StaticOrder S; S.init(NEXP * ESLOTS, DM, F.G, F.bx, ETILES, l == DEPTH - 1 ? ETILES : 0, 0, WGM_G2);
            pg8::EpiBf16<0> E{WSP(bf16, WS_Y), DM, nullptr, 0, 0, 1.f};
            if (MOE_DOWN_FP8) { pg8::Gemm g{WSP(const bf16, WS_H1), WSP(const bf16, WS_WD) + (size_t)l * NEXP * DM * (EDIM / 2), NEXP * ESLOTS, DM, EDIM / 2};
                pg8::gemm_phase<pg8::EpiBf16<0>, pg8::StaticOrder, true, false, 2, 121>(F.lds + RING_OFF, g, S, E); }
            else { pg8::Gemm g{WSP(const bf16, WS_H1), WSP(const bf16, WS_WD) + (size_t)l * NEXP * DM * EDIM, NEXP * ESLOTS, DM, EDIM};
                pg8::gemm_phase<pg8::EpiBf16<0>, pg8::StaticOrder, true, true>(F.lds + RING_OFF, g, S, E); }
            PHB(); fill_convert(F, l + 1, 64, FILL_D0, FQ_D);
            SEAM(pb + LP_G2);
        }
    }
    if (IN(PH_FINAL)) { PHB(); ph_final(F); }
    if (PROBE_KIND >= 0 || ATTN_DBG != 0) { if (PROBE_KIND == 9) pacc_ += rt() - tprev_; if (blockIdx.x == 0) { const unsigned long long tend_ = rt() + (unsigned long long)PROBE_MULT * pacc_; while (rt() < tend_) __builtin_amdgcn_s_sleep(20); } }
#undef IN
#undef SEAM
}

extern "C" void kernel_launch(void* const* d_in, const int* in_sizes, int n_in, void* d_out, int out_size, void* d_ws, size_t ws_size, hipStream_t stream) {
    static int grid = 0;
    if (grid == 0) {
        if (n_in != 22 || in_sizes[0] != NBATCH * SEQL * DM || out_size != NBATCH * SEQL * DM || ws_size < WS_END) {
            fprintf(stderr, "kernel_launch: unexpected shapes (n_in %d, in0 %d, out %d, ws %zu; need ws >= %zu); nothing launched\n", n_in, n_in > 0 ? in_sizes[0] : -1, out_size, ws_size, (size_t)WS_END); grid = -1; return; }
        int dev = 0, cus = 0, per_cu = 0;
        if (hipGetDevice(&dev) != hipSuccess || hipDeviceGetAttribute(&cus, hipDeviceAttributeMultiprocessorCount, dev) != hipSuccess) { grid = -1; return; }
        if (hipFuncSetAttribute((const void*)mk_fwd, hipFuncAttributeMaxDynamicSharedMemorySize, LDS_BYTES) != hipSuccess) { fprintf(stderr, "kernel_launch: hipFuncSetAttribute failed\n"); grid = -1; return; }
        if (hipOccupancyMaxActiveBlocksPerMultiprocessor(&per_cu, (const void*)mk_fwd, NWAVES * 64, LDS_BYTES) != hipSuccess || per_cu < 1)
            fprintf(stderr, "kernel_launch: note: occupancy query reports %d workgroups per CU\n", per_cu);
        (void)hipGetLastError();
        if (cus != 256) { fprintf(stderr, "kernel_launch: built for a 256-CU device (one workgroup per CU, static unit deals); found %d CUs; nothing launched\n", cus); grid = -1; return; }
        grid = cus;
    }
    if (grid < 0) return;
    (void)hipMemsetAsync((char*)d_ws + WS_CTL, 0, CTL_ZERO_BYTES, stream);
    Args a{};
    for (int i = 0; i < 22; ++i) a.in[i] = (const float*)d_in[i];
    a.out = (float*)d_out; a.ws = (unsigned char*)d_ws;
    unsigned char* ws = (unsigned char*)d_ws;
#ifndef MK_PER_PHASE
    a.ph_lo = 0; a.ph_hi = NPH;
    hipLaunchKernelGGL(mk_fwd, dim3(grid), dim3(NWAVES * 64), LDS_BYTES, stream, a);
#else
    for (int ph = 0; ph < NPH; ++ph) { a.ph_lo = ph; a.ph_hi = ph + 1; hipLaunchKernelGGL(mk_fwd, dim3(grid), dim3(NWAVES * 64), LDS_BYTES, stream, a); }
#endif
}
```

```cpp
#include <hip/hip_runtime.h>
#include <cstdio>
#include <cstdint>
namespace pg8 {
#define PG8_LAS __attribute__((address_space(3)))
typedef unsigned short bf16_t;
typedef short bf16x8 __attribute__((ext_vector_type(8)));
typedef float f32x4 __attribute__((ext_vector_type(4)));
typedef unsigned u32x4 __attribute__((ext_vector_type(4)));
constexpr int BM = 256, BK = 64, HALF = 128, HTB = HALF * BK * 2  , STAGE_BYTES = 8 * HTB, NXCD = 8, WGM = 8;

__host__ __device__ __forceinline__ int lds_byte(int r, int c) { const int st = (r >> 4) * 2 + (c >> 5), rr = r & 15, cc = c & 31, ob = rr * 64 + cc * 2; return st * 1024 + (ob ^ (((ob >> 9) & 1) << 5)); }
__host__ __device__ __forceinline__ void stage_rc(int b, int& R, int& C) { const int st = b / 1024, sb = b % 1024, swz = sb ^ (((sb >> 9) & 1) << 5); R = (st >> 1) * 16 + swz / 64; C = (st & 1) * 32 + (swz % 64) / 2; }
__host__ __device__ __forceinline__ int perm32(int rho) { const int n = rho >> 4, i = rho & 15; return 8 * (i >> 2) + 4 * n + (i & 3); }

__host__ __device__ __forceinline__ int perm32x(int rho) { return 16 * ((rho >> 2) & 1) + (rho & 3) + 4 * (rho >> 3); }
typedef float pg8_f32x16 __attribute__((ext_vector_type(16)));
struct Unit { int pm, pn, pb; };
struct Gemm { const bf16_t* A; const bf16_t* Bt; int M, N, K; };

template <bool GATHER_> struct StaticOrderT {
    static constexpr bool GATHER = GATHER_; const PG8_LAS unsigned* offtab;
    int nM, nN, nwg, G, c, tpg, skipg, skipf, wgm;
    __host__ __device__ __forceinline__ void init(int M, int N, int G_, int c_, int tpg_ = 0, int skipg_ = 0, int skipf_ = 0, int wgm_ = WGM) { wgm = wgm_; nM = M / BM; if (skipg_) nM -= nM / skipg_; nN = N / BM; nwg = nM * nN; G = G_; c = c_; tpg = tpg_; skipg = skipg_; skipf = skipf_; }
    __host__ __device__ __forceinline__ bool next(int i, Unit& u) const {
        const long L = (long)i * G + c; if (L >= nwg) return false;
        int wgid = (int)L; { const int q = nwg / NXCD, r = nwg % NXCD, xcd = wgid % NXCD, off = wgid / NXCD; wgid = (xcd < r ? xcd * (q + 1) : r * (q + 1) + (xcd - r) * q) + off; }
        const int nig = wgm * nN, gid = wgid / nig, fm = gid * wgm, gsz = (nM - fm) < wgm ? (nM - fm) : wgm;
        u.pm = fm + ((wgid % nig) % gsz); u.pn = (wgid % nig) / gsz; if (skipg) u.pm = (u.pm / (skipg - 1)) * skipg + u.pm % (skipg - 1) + skipf; u.pb = tpg ? (u.pm / tpg) * nN + u.pn : u.pn; return true;
    }
    __device__ __forceinline__ void a_ready(const Unit&) const {}
    __device__ __forceinline__ void done(const Unit&) const {}
};
typedef StaticOrderT<false> StaticOrder; typedef StaticOrderT<true> GatherOrder;

__device__ __forceinline__ unsigned cvt_pk_bf16(float lo, float hi) { unsigned r; asm volatile("v_cvt_pk_bf16_f32 %0, %1, %2" : "=v"(r) : "v"(lo), "v"(hi)); return r; }
typedef float f32x2 __attribute__((ext_vector_type(2)));
__device__ __forceinline__ f32x2 gelu_pk(f32x2 v) {
    const f32x2 av = __builtin_elementwise_abs(v), d = av * 0.2316418882f + 1.0f;
    f32x2 t; t.x = __builtin_amdgcn_rcpf(d.x); t.y = __builtin_amdgcn_rcpf(d.y);
    f32x2 q = t * 0.5307027145f + (-0.7265760135f); q = q * t + 0.7107068705f; q = q * t + (-0.142248368f); q = q * t + 0.127414796f; q = q * t;
    const f32x2 s = (v * v) * (-0.72134752044f);
    f32x2 e; e.x = __builtin_amdgcn_exp2f(s.x); e.y = __builtin_amdgcn_exp2f(s.y);
    const f32x2 m = v * (q * e), r = v - m;
    f32x2 o; o.x = v.x < 0.f ? m.x : r.x; o.y = v.y < 0.f ? m.y : r.y; return o;
}

template <int ACT  > struct EpiBf16 {
    static constexpr bool PERM = true, AFTER_DRAIN = false, HEADMAP = false; static_assert(ACT == 0 || ACT == 1, "EpiBf16: ACT is 0 (none) or 1 (gelu_pk)");
    bf16_t* O; int ldc; const float* bias; int split_cols; size_t split_stride; float scale0;
    __device__ __forceinline__ void x32(const pg8_f32x16 (&acc)[2][2][2], const Unit& u, int wr, int wc, int lane) const {
        const int row0 = u.pm * BM + wr * 64 + (lane & 31), col0 = u.pn * BM + wc * 32 + 16 * (lane >> 5);
#pragma unroll
        for (int ai = 0; ai < 2; ++ai)
#pragma unroll
            for (int tb = 0; tb < 2; ++tb) { bf16_t* rowp = O + (size_t)(row0 + ai * HALF + tb * 32) * ldc + col0;
#pragma unroll
                for (int bj = 0; bj < 2; ++bj) { const pg8_f32x16 v = acc[ai][bj][tb]; u32x4 w0, w1;
                    w0.x = cvt_pk_bf16(v[0], v[1]); w0.y = cvt_pk_bf16(v[2], v[3]); w0.z = cvt_pk_bf16(v[4], v[5]); w0.w = cvt_pk_bf16(v[6], v[7]);
                    w1.x = cvt_pk_bf16(v[8], v[9]); w1.y = cvt_pk_bf16(v[10], v[11]); w1.z = cvt_pk_bf16(v[12], v[13]); w1.w = cvt_pk_bf16(v[14], v[15]);
                    *(u32x4*)(rowp + bj * HALF) = w0; *(u32x4*)(rowp + bj * HALF + 8) = w1; } }
    }
    __device__ __forceinline__ void operator()(const f32x4 (&acc)[2][2][4][2], const Unit& u, int wr, int wc, int fr, int fq) const {
        const int row0 = u.pm * BM + wr * 64 + fr; int colt = u.pn * BM; bf16_t* base = O;
        float sc = 1.f; if (split_cols) { const int t = colt / split_cols; base += (size_t)t * split_stride; colt -= t * split_cols; if (t == 0) sc = scale0; }
        const int col0 = colt + wc * 32 + 8 * fq, bcol0 = u.pn * BM + wc * 32 + 8 * fq;
        f32x4 bv[2][2];
#pragma unroll
        for (int bj = 0; bj < 2; ++bj)
#pragma unroll
            for (int n = 0; n < 2; ++n) bv[bj][n] = bias ? *(const f32x4*)(bias + bcol0 + bj * HALF + 4 * n) : (f32x4){0.f, 0.f, 0.f, 0.f};
#pragma unroll
        for (int ai = 0; ai < 2; ++ai)
#pragma unroll
            for (int m = 0; m < 4; ++m) { bf16_t* rowp = base + (size_t)(row0 + ai * HALF + m * 16) * ldc + col0;
#pragma unroll
                for (int bj = 0; bj < 2; ++bj) { f32x4 v0 = acc[ai][bj][m][0] + bv[bj][0], v1 = acc[ai][bj][m][1] + bv[bj][1];
                    if (ACT == 1) { f32x2 a = gelu_pk((f32x2){v0[0], v0[1]}), b = gelu_pk((f32x2){v0[2], v0[3]}), c = gelu_pk((f32x2){v1[0], v1[1]}), d = gelu_pk((f32x2){v1[2], v1[3]});
                        v0 = (f32x4){a.x, a.y, b.x, b.y}; v1 = (f32x4){c.x, c.y, d.x, d.y}; }
                    v0 = v0 * sc; v1 = v1 * sc; u32x4 w; w.x = cvt_pk_bf16(v0[0], v0[1]); w.y = cvt_pk_bf16(v0[2], v0[3]); w.z = cvt_pk_bf16(v1[0], v1[1]); w.w = cvt_pk_bf16(v1[2], v1[3]);
                    *(u32x4*)(rowp + bj * HALF) = w; } }
    }
};


struct EpiResGate {
    static constexpr bool PERM = true, AFTER_DRAIN = false, HEADMAP = false;
    bf16_t* X; int ldc; const float* gates; int q;
    __device__ __forceinline__ static float lo(unsigned w) { return __uint_as_float(w << 16); }
    __device__ __forceinline__ static float hi(unsigned w) { return __uint_as_float(w & 0xffff0000u); }
    __device__ __forceinline__ void x32(const pg8_f32x16 (&acc)[2][2][2], const Unit& u, int wr, int wc, int lane) const {
        const int b = u.pm / 33, s = (u.pm % 33 == 0) ? 4 : b;
        const float* gv = gates + (size_t)(s * 6 + q) * 1024;
        int h16 = 16 * (lane >> 5); asm volatile("" : "+v"(h16));
        const int col0 = u.pn * BM + wc * 32 + h16;
#pragma unroll
        for (int bj = 0; bj < 2; ++bj) { f32x4 g[4];
#pragma unroll
            for (int c = 0; c < 4; ++c) g[c] = *(const f32x4*)(gv + col0 + bj * HALF + 4 * c);
#pragma unroll
            for (int ai = 0; ai < 2; ++ai)
#pragma unroll
                for (int tb = 0; tb < 2; ++tb) { u32x4* p = (u32x4*)(X + (size_t)(u.pm * BM + ai * HALF + wr * 64 + tb * 32 + (lane & 31)) * ldc + col0 + bj * HALF); const pg8_f32x16 a = acc[ai][bj][tb];
#pragma unroll
                    for (int hh = 0; hh < 2; ++hh) { const u32x4 w = p[hh];
                        const f32x4 v0 = (f32x4){lo(w.x), hi(w.x), lo(w.y), hi(w.y)} + g[2 * hh] * (f32x4){a[8 * hh], a[8 * hh + 1], a[8 * hh + 2], a[8 * hh + 3]};
                        const f32x4 v1 = (f32x4){lo(w.z), hi(w.z), lo(w.w), hi(w.w)} + g[2 * hh + 1] * (f32x4){a[8 * hh + 4], a[8 * hh + 5], a[8 * hh + 6], a[8 * hh + 7]};
                        u32x4 o; o.x = cvt_pk_bf16(v0[0], v0[1]); o.y = cvt_pk_bf16(v0[2], v0[3]); o.z = cvt_pk_bf16(v1[0], v1[1]); o.w = cvt_pk_bf16(v1[2], v1[3]); p[hh] = o; }
                    asm volatile("" ::: "memory"); } }
    }
    __device__ __forceinline__ void operator()(const f32x4 (&acc)[2][2][4][2], const Unit& u, int wr, int wc, int fr, int fq) const {
        const int b = u.pm / 33, s = (u.pm % 33 == 0) ? 4 : b;
        const float* gv = gates + (size_t)(s * 6 + q) * 1024;
        const int col0 = u.pn * BM + wc * 32 + 8 * fq;
        f32x4 g[2][2];
#pragma unroll
        for (int bj = 0; bj < 2; ++bj)
#pragma unroll
            for (int n = 0; n < 2; ++n) g[bj][n] = *(const f32x4*)(gv + col0 + bj * HALF + 4 * n);
#pragma unroll
        for (int ai = 0; ai < 2; ++ai)
#pragma unroll
            for (int m = 0; m < 4; ++m) { bf16_t* rowp = X + (size_t)(u.pm * BM + ai * HALF + wr * 64 + m * 16 + fr) * ldc + col0;
#pragma unroll
                for (int bj = 0; bj < 2; ++bj) { u32x4* p = (u32x4*)(rowp + bj * HALF); const u32x4 w = *p;
                    const f32x4 v0 = (f32x4){lo(w.x), hi(w.x), lo(w.y), hi(w.y)} + g[bj][0] * acc[ai][bj][m][0], v1 = (f32x4){lo(w.z), hi(w.z), lo(w.w), hi(w.w)} + g[bj][1] * acc[ai][bj][m][1];
                    u32x4 o; o.x = cvt_pk_bf16(v0[0], v0[1]); o.y = cvt_pk_bf16(v0[2], v0[3]); o.z = cvt_pk_bf16(v1[0], v1[1]); o.w = cvt_pk_bf16(v1[2], v1[3]); *p = o; }
                if (m & 1) asm volatile("" ::: "memory"); }
    }
};

typedef unsigned u32x2 __attribute__((ext_vector_type(2)));
struct EpiInProj {
    static constexpr bool PERM = false, AFTER_DRAIN = false, HEADMAP = true;
    bf16_t* O; int ldc; const float* qg; const float* kg; const float* rope; float c2; unsigned char* Q8; unsigned char* K8;
    __device__ __forceinline__ static unsigned pack8(const f32x4 a, float s) { int w = __builtin_amdgcn_cvt_pk_fp8_f32(a[0] * s, a[1] * s, 0, false); w = __builtin_amdgcn_cvt_pk_fp8_f32(a[2] * s, a[3] * s, w, true); return (unsigned)w; }
    __device__ __forceinline__ static float dot4(const f32x4 a) { return (a[0] * a[0] + a[1] * a[1]) + (a[2] * a[2] + a[3] * a[3]); }
    __device__ __forceinline__ static u32x2 pack4(const f32x4 a) { u32x2 w; w.x = cvt_pk_bf16(a[0], a[1]); w.y = cvt_pk_bf16(a[2], a[3]); return w; }
    __device__ __forceinline__ void operator()(const f32x4 (&acc)[2][2][4][2], const Unit& u, int wr, int wc, int fr, int fq) const {
        const int mode = (u.pn < 2) ? 1 : (u.pn == 2) ? (wc < 2 ? 2 : 0) : (u.pn == 3) ? 3 : 0;
        int fq4 = 4 * fq; asm volatile("" : "+v"(fq4));
        const int tb = u.pm % 33; const bool lat = tb != 0;
        bf16_t* const obase = O + (size_t)(u.pm * BM + wr * 64 + fr) * ldc + u.pn * BM + 64 * wc + fq4;
        if (mode == 1 || mode == 2) {
            const float* gp = (mode == 1 ? qg : kg) + fq4; const float gs = (mode == 1) ? c2 : 1.0f; const float sc8 = sqrtf(c2), rs8 = 1.0f / sc8;
            f32x4 g[2][2];
#pragma unroll
            for (int bj = 0; bj < 2; ++bj)
#pragma unroll
                for (int n = 0; n < 2; ++n) g[bj][n] = *(const f32x4*)(gp + 32 * bj + 16 * n) * gs;
#pragma unroll
            for (int ai = 0; ai < 2; ++ai) {
                f32x4 cr = (f32x4){1.f, 1.f, 1.f, 1.f}, sr = (f32x4){0.f, 0.f, 0.f, 0.f};
                if (lat) { const int pr = 4 * (tb - 1) + 2 * ai + wr; cr = *(const f32x4*)(rope + pr * 16 + fq4); sr = *(const f32x4*)(rope + 2048 + pr * 16 + fq4); }
#pragma unroll
                for (int m = 0; m < 4; ++m) {
                    f32x4 x00 = acc[ai][0][m][0], x01 = acc[ai][0][m][1], x10 = acc[ai][1][m][0], x11 = acc[ai][1][m][1];
                    float ss = (dot4(x00) + dot4(x01)) + (dot4(x10) + dot4(x11));
                    ss += __shfl_xor(ss, 16); ss += __shfl_xor(ss, 32);
                    const float rstd = 1.0f / sqrtf(ss * (1.0f / 64.0f) + 1e-6f);
                    x00 = x00 * rstd * g[0][0]; x01 = x01 * rstd * g[0][1]; x10 = x10 * rstd * g[1][0]; x11 = x11 * rstd * g[1][1];
                    f32x4 y00 = x00, y01 = x01, y10 = x10, y11 = x11;
                    if (lat) { const int pc = 16 * m + fr; const f32x4 cc = *(const f32x4*)(rope + pc * 16 + fq4), sc = *(const f32x4*)(rope + 2048 + pc * 16 + fq4);
                        y00 = x00 * cr - x01 * sr; y01 = x01 * cr + x00 * sr; y10 = x10 * cc - x11 * sc; y11 = x11 * cc + x10 * sc; }
                    bf16_t* rowp = obase + (size_t)(ai * HALF + m * 16) * ldc;
                    *(u32x2*)(rowp) = pack4(y00); *(u32x2*)(rowp + 16) = pack4(y01); *(u32x2*)(rowp + 32) = pack4(y10); *(u32x2*)(rowp + 48) = pack4(y11);
                    { const size_t row = (size_t)(u.pm * BM + wr * 64 + fr + ai * HALF + m * 16); const float s8 = (mode == 1) ? rs8 : sc8;
                      unsigned char* p8 = (mode == 1) ? Q8 + row * 512 + u.pn * BM + 64 * wc + fq4 : K8 + row * 128 + 64 * wc + fq4;
                      *(unsigned*)(p8) = pack8(y00, s8); *(unsigned*)(p8 + 16) = pack8(y01, s8); *(unsigned*)(p8 + 32) = pack8(y10, s8); *(unsigned*)(p8 + 48) = pack8(y11, s8); }
                }
            }
        } else {
            const float sc = (mode == 3) ? c2 : 1.0f;
#pragma unroll
            for (int ai = 0; ai < 2; ++ai)
#pragma unroll
                for (int m = 0; m < 4; ++m) { bf16_t* rowp = obase + (size_t)(ai * HALF + m * 16) * ldc;
#pragma unroll
                    for (int bj = 0; bj < 2; ++bj)
#pragma unroll
                        for (int n = 0; n < 2; ++n) *(u32x2*)(rowp + 32 * bj + 16 * n) = pack4(acc[ai][bj][m][n] * sc); }
        }
    }
};
template <bool OUT8> struct EpiSwiGLUT {
    static constexpr bool PERM = true, AFTER_DRAIN = false, HEADMAP = false;
    bf16_t* O; int ldc;
    __device__ __forceinline__ static float swi(float g, float u) { const float e = __builtin_amdgcn_exp2f(-1.4426950408889634f * g); return g * __builtin_amdgcn_rcpf(1.0f + e) * u; }
    __device__ __forceinline__ void x32(const pg8_f32x16 (&acc)[2][2][2], const Unit& u, int wr, int wc, int lane) const {
        static_assert(OUT8, "EpiSwiGLUT::x32 writes the fp8 H1");
        int h16 = 16 * (lane >> 5); asm volatile("" : "+v"(h16));
        const int row0 = u.pm * BM + wr * 64 + (lane & 31), col0 = u.pn * HALF + wc * 32 + h16;
#pragma unroll
        for (int ai = 0; ai < 2; ++ai)
#pragma unroll
            for (int tb = 0; tb < 2; ++tb) { const pg8_f32x16 g = acc[ai][0][tb], v = acc[ai][1][tb]; int w[4];
#pragma unroll
                for (int q = 0; q < 4; ++q) { w[q] = __builtin_amdgcn_cvt_pk_fp8_f32(swi(g[4 * q], v[4 * q]), swi(g[4 * q + 1], v[4 * q + 1]), 0, false); w[q] = __builtin_amdgcn_cvt_pk_fp8_f32(swi(g[4 * q + 2], v[4 * q + 2]), swi(g[4 * q + 3], v[4 * q + 3]), w[q], true); }
                u32x4 w8; w8.x = (unsigned)w[0]; w8.y = (unsigned)w[1]; w8.z = (unsigned)w[2]; w8.w = (unsigned)w[3];
                *(u32x4*)((unsigned char*)O + (size_t)(row0 + ai * HALF + tb * 32) * ldc + col0) = w8; }
    }
    __device__ __forceinline__ void operator()(const f32x4 (&acc)[2][2][4][2], const Unit& u, int wr, int wc, int fr, int fq) const {
        int fq8 = 8 * fq; asm volatile("" : "+v"(fq8));
        const int row0 = u.pm * BM + wr * 64 + fr, col0 = u.pn * HALF + wc * 32 + fq8;
#pragma unroll
        for (int ai = 0; ai < 2; ++ai)
#pragma unroll
            for (int m = 0; m < 4; ++m) {
                const f32x4 g0 = acc[ai][0][m][0], g1 = acc[ai][0][m][1], u0 = acc[ai][1][m][0], u1 = acc[ai][1][m][1];
                const float h0 = swi(g0[0], u0[0]), h1 = swi(g0[1], u0[1]), h2 = swi(g0[2], u0[2]), h3 = swi(g0[3], u0[3]), h4 = swi(g1[0], u1[0]), h5 = swi(g1[1], u1[1]), h6 = swi(g1[2], u1[2]), h7 = swi(g1[3], u1[3]);
                if constexpr (OUT8) { unsigned char* p8 = (unsigned char*)O + (size_t)(row0 + ai * HALF + m * 16) * ldc + col0;
                    int w0 = __builtin_amdgcn_cvt_pk_fp8_f32(h0, h1, 0, false); w0 = __builtin_amdgcn_cvt_pk_fp8_f32(h2, h3, w0, true);
                    int w1 = __builtin_amdgcn_cvt_pk_fp8_f32(h4, h5, 0, false); w1 = __builtin_amdgcn_cvt_pk_fp8_f32(h6, h7, w1, true);
                    u32x2 w8; w8.x = (unsigned)w0; w8.y = (unsigned)w1; *(u32x2*)p8 = w8; }
                else { bf16_t* rowp = O + (size_t)(row0 + ai * HALF + m * 16) * ldc + col0;
                    u32x4 w; w.x = cvt_pk_bf16(h0, h1); w.y = cvt_pk_bf16(h2, h3); w.z = cvt_pk_bf16(h4, h5); w.w = cvt_pk_bf16(h6, h7); *(u32x4*)rowp = w; } }
    }
};
__device__ __forceinline__ void glds_sv(const void* sbase, unsigned voff, unsigned lds_dst) { unsigned keep;
    asm volatile("s_mov_b32 %0, m0\n\ts_mov_b32 m0, %3\n\ts_nop 0\n\tglobal_load_lds_dwordx4 %1, %2\n\ts_mov_b32 m0, %0" : "=&s"(keep) : "v"(voff), "s"(sbase), "s"(lds_dst) : "memory"); }
typedef int pg8_v8i __attribute__((ext_vector_type(8))); typedef int pg8_v4i __attribute__((ext_vector_type(4)));
__device__ __forceinline__ pg8_v8i cat8(const bf16x8 a, const bf16x8 b) { const pg8_v4i x = __builtin_bit_cast(pg8_v4i, a), y = __builtin_bit_cast(pg8_v4i, b); return (pg8_v8i){x[0], x[1], x[2], x[3], y[0], y[1], y[2], y[3]}; }
template <class Epi, class Sched, bool ALIGN_EPI = false, bool SP2 = false, int FP8 = 0  , int WSCALE = 127>
__device__ __forceinline__ void gemm_phase(PG8_LAS unsigned char* lds, const Gemm g, const Sched& S, const Epi& E) {
    int tid_ = threadIdx.x; asm volatile("" : "+v"(tid_));
    const int tid = tid_, wid = __builtin_amdgcn_readfirstlane(tid >> 6), lane = tid & 63, wr = wid >> 2, wc = wid & 3, fr = lane & 15, fq = lane >> 4;
    const int K = g.K, nt = K / BK;
    unsigned voffA[2], voffB[2]; int ra[2]; unsigned ca2[2];
    constexpr bool GATHER = Sched::GATHER;
    unsigned cvA[2][2];
#pragma unroll
    for (int i = 0; i < 2; ++i) { int R, C; stage_rc(tid * 16 + i * 8192, R, C); const int Rb = Epi::HEADMAP ? (64 * (R >> 5) + (R & 31)) : Epi::PERM ? ((R & ~31) + (FP8 == 2 ? perm32x(R & 31) : perm32(R & 31))) : R;
        voffA[i] = (unsigned)(R * K + C) * 2u; voffB[i] = (unsigned)(Rb * K + C) * 2u; ra[i] = R; ca2[i] = (unsigned)C * 2u; }
    const size_t kstep = (size_t)(BK * 2);
    const size_t hstep = (size_t)HALF * K * 2;
    const size_t hstepB = Epi::HEADMAP ? (size_t)32 * K * 2 : hstep;
    const size_t tstep = 2 * hstep;
    const unsigned ldsw = (unsigned)wid * 1024u;
    const int aoff = lds_byte(wr * 64 + fr, fq * 8), boff = lds_byte(wc * 32 + fr, fq * 8);
    const int r32 = lane & 31, hi5 = lane >> 5;
    const int aox1 = lds_byte(wr * 64 + r32, hi5 ? 24 : 0), aox2 = lds_byte(wr * 64 + r32, hi5 ? 16 : 8), box1 = lds_byte(wc * 32 + r32, hi5 ? 24 : 0), box2 = lds_byte(wc * 32 + r32, hi5 ? 16 : 8);
#define PG8_SA(b, h) (((b) * 2 + (h)) * HTB)
#define PG8_SB(b, h) ((4 + (b) * 2 + (h)) * HTB)
#define PG8_LDSADDR(p) ((unsigned)__builtin_amdgcn_readfirstlane((int)(unsigned)(unsigned long long)(p)))
#define PG8_STAGE(bufoff, gbase, voff) do { _Pragma("unroll") for (int _i = 0; _i < 2; ++_i) \
        glds_sv((const char*)(gbase), (voff)[_i], PG8_LDSADDR(lds + (bufoff) + ldsw + _i * 8192)); } while (0)
#define PG8_STAGE_A(bufoff, gbase, h, nx) do { _Pragma("unroll") for (int _i = 0; _i < 2; ++_i) { const unsigned vo_ = GATHER ? cvA[h][_i] : voffA[_i]; \
        glds_sv((const char*)(gbase) + (GATHER ? (size_t)0 : (size_t)(h) * hstep), vo_, PG8_LDSADDR(lds + (bufoff) + ldsw + _i * 8192)); } } while (0)
#define PG8_GNEXT() do { if constexpr (GATHER) { if (last && has_next) { int t2_ = tid; asm volatile("" : "+v"(t2_)); _Pragma("unroll") for (int i_ = 0; i_ < 2; ++i_) { int R_, C_; stage_rc(t2_ * 16 + i_ * 8192, R_, C_); \
        _Pragma("unroll") for (int h_ = 0; h_ < 2; ++h_) cvA[h_][i_] = S.offtab[(ui + 1) * BM + h_ * HALF + R_] + (unsigned)C_ * 2u; } } } } while (0)
#define PG8_LD8(p) ({ const pg8_v4i l_ = *(const PG8_LAS pg8_v4i*)(p), h_ = *(const PG8_LAS pg8_v4i*)((p) + 1024); (pg8_v8i){l_[0], l_[1], l_[2], l_[3], h_[0], h_[1], h_[2], h_[3]}; })
#define PG8_LD8X(p, q) ({ const pg8_v4i l_ = *(const PG8_LAS pg8_v4i*)(p), h_ = *(const PG8_LAS pg8_v4i*)(q); (pg8_v8i){l_[0], l_[1], l_[2], l_[3], h_[0], h_[1], h_[2], h_[3]}; })
#define PG8_LDA(dst, b, h) do { if constexpr (FP8 == 2) { _Pragma("unroll") for (int tb = 0; tb < 2; ++tb) _Pragma("unroll") for (int s_ = 0; s_ < 2; ++s_) dst##X[tb][s_] = PG8_LD8X(lds + PG8_SA(b, h) + aox1 + tb * 4096 + s_ * 1024, lds + PG8_SA(b, h) + aox2 + tb * 4096 + s_ * 1024); } \
        else if constexpr (FP8 == 1) { _Pragma("unroll") for (int m = 0; m < 4; ++m) dst##8[m] = PG8_LD8(lds + PG8_SA(b, h) + aoff + m * 2048); } \
        else { _Pragma("unroll") for (int m = 0; m < 4; ++m) _Pragma("unroll") for (int k = 0; k < 2; ++k) dst[m][k] = *(const PG8_LAS bf16x8*)(lds + PG8_SA(b, h) + aoff + m * 2048 + k * 1024); } } while (0)
#define PG8_LDB(dst, b, h) do { if constexpr (FP8 == 2) { _Pragma("unroll") for (int s_ = 0; s_ < 2; ++s_) dst##X[s_] = PG8_LD8X(lds + PG8_SB(b, h) + box1 + s_ * 1024, lds + PG8_SB(b, h) + box2 + s_ * 1024); } \
        else if constexpr (FP8 == 1) { _Pragma("unroll") for (int n = 0; n < 2; ++n) dst##8[n] = PG8_LD8(lds + PG8_SB(b, h) + boff + n * 2048); } \
        else { _Pragma("unroll") for (int n = 0; n < 2; ++n) _Pragma("unroll") for (int k = 0; k < 2; ++k) dst[n][k] = *(const PG8_LAS bf16x8*)(lds + PG8_SB(b, h) + boff + n * 2048 + k * 1024); } } while (0)
#define PG8_MMA(ai, bj, At, Bt) do { __builtin_amdgcn_s_setprio(1); if constexpr (FP8 == 2) { _Pragma("unroll") for (int s_ = 0; s_ < 2; ++s_) _Pragma("unroll") for (int tb = 0; tb < 2; ++tb) \
        accx[ai][bj][tb] = __builtin_amdgcn_mfma_scale_f32_32x32x64_f8f6f4(Bt##X[s_], At##X[tb][s_], accx[ai][bj][tb], 0, 0, 0, WSCALE * 0x01010101, 0, 0x7F7F7F7F); } \
        else _Pragma("unroll") for (int m = 0; m < 4; ++m) _Pragma("unroll") for (int n = 0; n < 2; ++n) { \
        if constexpr (FP8 == 1) acc[ai][bj][m][n] = __builtin_amdgcn_mfma_scale_f32_16x16x128_f8f6f4(Bt##8[n], At##8[m], acc[ai][bj][m][n], 0, 0, 0, WSCALE * 0x01010101, 0, 0x7F7F7F7F); \
        else { _Pragma("unroll") for (int k = 0; k < 2; ++k) acc[ai][bj][m][n] = __builtin_amdgcn_mfma_f32_16x16x32_bf16(Bt[n][k], At[m][k], acc[ai][bj][m][n], 0, 0, 0); } } __builtin_amdgcn_s_setprio(0); } while (0)
#define PG8_WAIT_V(n) asm volatile("s_waitcnt vmcnt(" #n ")" ::: "memory")
#define PG8_WAIT_L(n) asm volatile("s_waitcnt lgkmcnt(" #n ")" ::: "memory")
#define PG8_BAR __builtin_amdgcn_s_barrier()
#define PG8_SCHED __builtin_amdgcn_sched_barrier(0)
    Unit cur, nxt; int ui = 0;
    if (!S.next(0, cur)) return;
    f32x4 acc[2][2][4][2]; pg8_f32x16 accx[2][2][2];
    float zr_ = 0.f; asm volatile("" : "+v"(zr_));
#pragma unroll
    for (int a = 0; a < 2; ++a)
#pragma unroll
        for (int b = 0; b < 2; ++b)
{
#pragma unroll
            for (int m = 0; m < 4; ++m)
#pragma unroll
                for (int n = 0; n < 2; ++n) acc[a][b][m][n] = (f32x4){zr_, zr_, zr_, zr_};
            if constexpr (FP8 == 2) {
#pragma unroll
                for (int tb = 0; tb < 2; ++tb)
#pragma unroll
                    for (int r = 0; r < 16; ++r) accx[a][b][tb][r] = zr_; } }
    bf16x8 At[4][2], B0[2][2], B1[2][2]; pg8_v8i At8[4], B08[2], B18[2], AtX[2][2], B0X[2], B1X[2];
    const char* cA = GATHER ? (const char*)g.A : (const char*)g.A + (size_t)cur.pm * tstep; const char* cB = (const char*)g.Bt + (size_t)cur.pb * tstep;
    if constexpr (GATHER) {
#pragma unroll
        for (int h = 0; h < 2; ++h)
#pragma unroll
            for (int i = 0; i < 2; ++i) cvA[h][i] = S.offtab[h * HALF + ra[i]] + ca2[i]; }
    S.a_ready(cur);
    if constexpr (SP2) {
        PG8_STAGE(PG8_SB(0, 0), cB, voffB); PG8_STAGE(PG8_SB(0, 1), cB + hstepB, voffB); PG8_STAGE_A(PG8_SA(0, 0), cA, 0, false); PG8_STAGE_A(PG8_SA(0, 1), cA, 1, false);
        if (wr == 1) PG8_BAR;
        PG8_WAIT_V(2); PG8_BAR;
        PG8_STAGE(PG8_SB(1, 0), cB + kstep, voffB); PG8_STAGE_A(PG8_SA(1, 0), cA + kstep, 0, false); PG8_STAGE(PG8_SB(1, 1), cB + hstepB + kstep, voffB);
        PG8_WAIT_V(6); PG8_BAR;
    } else {
        PG8_STAGE(PG8_SB(0, 0), cB, voffB); PG8_STAGE_A(PG8_SA(0, 0), cA, 0, false); PG8_STAGE(PG8_SB(0, 1), cB + hstepB, voffB); PG8_STAGE_A(PG8_SA(0, 1), cA, 1, false);
        if (wr == 1) PG8_BAR;
        PG8_WAIT_V(4); PG8_BAR;
        PG8_STAGE(PG8_SB(1, 0), cB + kstep, voffB); PG8_STAGE_A(PG8_SA(1, 0), cA + kstep, 0, false); PG8_STAGE(PG8_SB(1, 1), cB + hstepB + kstep, voffB);
        PG8_WAIT_V(6); PG8_BAR;
    }
    for (;;) {
        const bool has_next = S.next(ui + 1, nxt);
        const char* nA = GATHER ? (const char*)g.A : has_next ? (const char*)g.A + (size_t)nxt.pm * tstep : cA; const char* nB = has_next ? (const char*)g.Bt + (size_t)nxt.pb * tstep : cB;
#pragma unroll 1
        for (int t = 0; t < nt; t += 2) {
            const bool last = (t == nt - 2);
            const char* a1 = cA + (size_t)(t + 1) * kstep;
            const char* a2 = last ? nA : cA + (size_t)(t + 2) * kstep; const char* b2 = last ? nB : cB + (size_t)(t + 2) * kstep;
            const char* a3 = a2 + kstep; const char* b3 = b2 + kstep;
            if (last && has_next) S.a_ready(nxt);
            if constexpr (SP2) {
            PG8_LDB(B0, 0, 0); PG8_LDB(B1, 0, 1); PG8_SCHED; PG8_LDA(At, 0, 0); PG8_STAGE_A(PG8_SA(1, 1), a1, 1, false); PG8_GNEXT();
            PG8_WAIT_V(8); PG8_WAIT_L(0); PG8_BAR; PG8_MMA(0, 0, At, B0); PG8_MMA(0, 1, At, B1); PG8_BAR; PG8_SCHED;
            PG8_LDA(At, 0, 1); PG8_STAGE(PG8_SB(0, 0), b2, voffB); PG8_STAGE(PG8_SB(0, 1), b2 + hstepB, voffB); PG8_STAGE_A(PG8_SA(0, 0), a2, 0, last);
            PG8_WAIT_V(8); PG8_WAIT_L(0); PG8_BAR; PG8_MMA(1, 0, At, B0); PG8_MMA(1, 1, At, B1); PG8_BAR; PG8_SCHED;
            PG8_LDB(B0, 1, 0); PG8_LDB(B1, 1, 1); PG8_SCHED; PG8_LDA(At, 1, 0); PG8_STAGE_A(PG8_SA(0, 1), a2, 1, last);
            PG8_WAIT_V(8); PG8_WAIT_L(0); PG8_BAR; PG8_MMA(0, 0, At, B0); PG8_MMA(0, 1, At, B1); PG8_BAR; PG8_SCHED;
            PG8_LDA(At, 1, 1); PG8_STAGE(PG8_SB(1, 0), b3, voffB); PG8_STAGE(PG8_SB(1, 1), b3 + hstepB, voffB); PG8_STAGE_A(PG8_SA(1, 0), a3, 0, last);
            PG8_WAIT_V(8); PG8_WAIT_L(0); PG8_BAR; PG8_MMA(1, 0, At, B0); PG8_MMA(1, 1, At, B1); PG8_BAR; PG8_SCHED;
            } else {
            PG8_LDB(B0, 0, 0); PG8_SCHED; PG8_LDA(At, 0, 0); PG8_STAGE_A(PG8_SA(1, 1), a1, 1, false); PG8_GNEXT();
            PG8_WAIT_L(8); PG8_BAR; PG8_WAIT_L(0); PG8_MMA(0, 0, At, B0); PG8_BAR; PG8_SCHED;
            PG8_LDB(B1, 0, 1); PG8_STAGE(PG8_SB(0, 0), b2, voffB);
            PG8_BAR; PG8_WAIT_L(0); PG8_MMA(0, 1, At, B1); PG8_BAR;
            PG8_LDA(At, 0, 1); PG8_STAGE_A(PG8_SA(0, 0), a2, 0, last);
            PG8_BAR; PG8_WAIT_L(0); PG8_MMA(1, 0, At, B0); PG8_BAR; PG8_SCHED;
            PG8_STAGE(PG8_SB(0, 1), b2 + hstepB, voffB);
            PG8_WAIT_V(6); PG8_BAR; PG8_MMA(1, 1, At, B1); PG8_BAR;
            PG8_LDB(B0, 1, 0); PG8_SCHED; PG8_LDA(At, 1, 0); PG8_STAGE_A(PG8_SA(0, 1), a2, 1, last);
            PG8_WAIT_L(8); PG8_BAR; PG8_WAIT_L(0); PG8_MMA(0, 0, At, B0); PG8_BAR; PG8_SCHED;
            PG8_LDB(B1, 1, 1); PG8_STAGE(PG8_SB(1, 0), b3, voffB);
            PG8_BAR; PG8_WAIT_L(0); PG8_MMA(0, 1, At, B1); PG8_BAR;
            PG8_LDA(At, 1, 1); PG8_STAGE_A(PG8_SA(1, 0), a3, 0, last);
            PG8_BAR; PG8_WAIT_L(0); PG8_MMA(1, 0, At, B0); PG8_BAR; PG8_SCHED;
            PG8_STAGE(PG8_SB(1, 1), b3 + hstepB, voffB);
            PG8_WAIT_V(6); PG8_BAR; PG8_MMA(1, 1, At, B1); PG8_BAR;
            }
        }
        if constexpr (ALIGN_EPI) { if (wr == 0) PG8_BAR; }
        if constexpr (!Epi::AFTER_DRAIN) { if constexpr (FP8 == 2) E.x32(accx, cur, wr, wc, lane); else E(acc, cur, wr, wc, fr, fq); S.done(cur); }
        if (!has_next) break;
#pragma unroll
        for (int a = 0; a < 2; ++a)
#pragma unroll
            for (int b = 0; b < 2; ++b)
{
#pragma unroll
                for (int m = 0; m < 4; ++m)
#pragma unroll
                    for (int n = 0; n < 2; ++n) acc[a][b][m][n] = (f32x4){zr_, zr_, zr_, zr_};
                if constexpr (FP8 == 2) {
#pragma unroll
                    for (int tb = 0; tb < 2; ++tb)
#pragma unroll
                        for (int r = 0; r < 16; ++r) accx[a][b][tb][r] = zr_; } }
        cur = nxt; cA = nA; cB = nB; ++ui;
        if constexpr (ALIGN_EPI) { if (wr == 1) PG8_BAR; }
    }
    PG8_WAIT_V(0);
    if constexpr (!ALIGN_EPI) { if (wr == 0) PG8_BAR; }
    PG8_BAR;
    if constexpr (Epi::AFTER_DRAIN) { E.fused(acc, cur, wr, wc, fr, fq, lds, wid, lane); S.done(cur); }
#undef PG8_SA
#undef PG8_SB
#undef PG8_STAGE
#undef PG8_STAGE_A
#undef PG8_LDA
#undef PG8_LD8
#undef PG8_LD8X
#undef PG8_LDB
#undef PG8_MMA
#undef PG8_WAIT_V
#undef PG8_WAIT_L
#undef PG8_BAR
#undef PG8_SCHED
}
}


#include <hip/hip_bf16.h>
#include <cmath>
namespace attn_body {
using bf16=__hip_bfloat16;
using bf16x8=__attribute__((ext_vector_type(8)))short;
using s16x4=__attribute__((ext_vector_type(4)))short;
using f32x16=__attribute__((ext_vector_type(16)))float;
using u32x4=__attribute__((ext_vector_type(4)))unsigned;
constexpr int D=64,KP=2048,OP=1024;
constexpr int NW=8,QBLK=32,QB=QBLK*NW,KVBLK=64;
__device__ __forceinline__ int crow(int r,int hi){return (r&3)+8*(r>>2)+4*hi;}
#define SBAR() __builtin_amdgcn_sched_barrier(0)
typedef __attribute__((address_space(3))) const float* lds_cfptr;
__device__ __forceinline__ void na_mask(f32x16&p0,f32x16&p1,bool rowok,int bidx,int d0,lds_cfptr tab){
  const float NEG=-INFINITY;
  if(!rowok){
    #pragma unroll
    for(int r=0;r<16;++r){p0[r]=NEG;p1[r]=NEG;}
  } else {
    #pragma unroll
    for(int r=0;r<16;++r){ const int c=(r&3)+8*(r>>2);
      const bool v0=(unsigned)(d0+c)<16u, v1=(unsigned)(d0+c+32)<16u;
      const float b0=tab[v0?bidx+c:0], b1=tab[v1?bidx+c+32:0];
      p0[r]=v0?p0[r]+b0:NEG; p1[r]=v1?p1[r]+b1:NEG; }
  }
}

constexpr int NSLOT=3, SLOTB=8192;
constexpr int LDS_K=0, LDS_V=NSLOT*SLOTB, LDS_WS=2*NSLOT*SLOTB, LDS_OST=LDS_WS+NW*64*4, LDS_BYTES=LDS_OST+NW*4096;
constexpr float C2=0.125f*1.4426950408889634f;
__device__ __forceinline__ void glds16(const void*gsrc,unsigned lds_dst){unsigned keep;
  asm volatile("s_mov_b32 %0, m0\n\ts_mov_b32 m0, %2\n\ts_nop 0\n\tglobal_load_lds_dwordx4 %1, off\n\ts_mov_b32 m0, %0":"=&s"(keep):"v"(gsrc),"s"(lds_dst):"memory");}
__device__ __forceinline__ float max3f(float a,float b,float c){float r;asm("v_max3_f32 %0, %1, %2, %3":"=v"(r):"v"(a),"v"(b),"v"(c));return r;}
__device__ __forceinline__ float max2f(float a,float b){float r;asm("v_max_f32_e32 %0, %1, %2":"=v"(r):"v"(a),"v"(b));return r;}
__device__ __forceinline__ float fadd_s(float a,float b){float r;asm("v_add_f32_e32 %0, %1, %2":"=v"(r):"v"(a),"v"(b));return r;}
__device__ __forceinline__ float fsub_s(float a,float b){float r;asm("v_sub_f32_e32 %0, %1, %2":"=v"(r):"v"(a),"v"(b));return r;}
typedef float f32x2_t __attribute__((ext_vector_type(2))); typedef __bf16 bf16x2_t __attribute__((ext_vector_type(2)));
__device__ __forceinline__ unsigned cvtpk_s(float lo,float hi){f32x2_t v={lo,hi};bf16x2_t b=__builtin_convertvector(v,bf16x2_t);return __builtin_bit_cast(unsigned,b);}
#define WAIT_BAR(N) asm volatile("s_waitcnt vmcnt(" #N ") lgkmcnt(0)\n\ts_barrier":::"memory")

__device__ __forceinline__ void qkt(f32x16&p0,f32x16&p1,const char*Kslot,const bf16x8*qr,const f32x16&negm,int r32,int hi){
  const char*kb=Kslot+hi*1024+r32*16;
  #pragma unroll
  for(int d0=0;d0<4;++d0){
    const bf16x8 b0=*reinterpret_cast<const bf16x8*>(kb+d0*2048);
    const bf16x8 b1=*reinterpret_cast<const bf16x8*>(kb+d0*2048+512);
    if(d0==0){p0=__builtin_amdgcn_mfma_f32_32x32x16_bf16(b0,qr[0],negm,0,0,0);p1=__builtin_amdgcn_mfma_f32_32x32x16_bf16(b1,qr[0],negm,0,0,0);}
    else{p0=__builtin_amdgcn_mfma_f32_32x32x16_bf16(b0,qr[d0],p0,0,0,0);p1=__builtin_amdgcn_mfma_f32_32x32x16_bf16(b1,qr[d0],p1,0,0,0);}}
}
typedef __attribute__((address_space(3))) const char* lds_cptr;
typedef short v4i16_t __attribute__((ext_vector_type(4)));
__device__ __forceinline__ void kload8(bf16x8*kf,lds_cptr kp){
  kf[0]=*(const __attribute__((address_space(3))) bf16x8*)(kp);      kf[1]=*(const __attribute__((address_space(3))) bf16x8*)(kp+512);
  kf[2]=*(const __attribute__((address_space(3))) bf16x8*)(kp+2048); kf[3]=*(const __attribute__((address_space(3))) bf16x8*)(kp+2560);
  kf[4]=*(const __attribute__((address_space(3))) bf16x8*)(kp+4096); kf[5]=*(const __attribute__((address_space(3))) bf16x8*)(kp+4608);
  kf[6]=*(const __attribute__((address_space(3))) bf16x8*)(kp+6144); kf[7]=*(const __attribute__((address_space(3))) bf16x8*)(kp+6656);
}
__device__ __forceinline__ void kload2(bf16x8*kf,lds_cptr kp,int j){ kf[2*j]=*(const __attribute__((address_space(3))) bf16x8*)(kp+j*2048); kf[2*j+1]=*(const __attribute__((address_space(3))) bf16x8*)(kp+j*2048+512); }
__device__ __forceinline__ s16x4 vtr(lds_cptr p){ return __builtin_bit_cast(s16x4,__builtin_amdgcn_ds_read_tr16_b64_v4i16((__attribute__((address_space(3))) v4i16_t*)p)); }
__device__ __forceinline__ float rowmax(const f32x16&p0,const f32x16&p1){
  float a=max3f(p0[0],p0[1],p1[0]),b=max3f(p0[2],p0[3],p1[1]);a=max3f(a,p1[2],p1[3]);
  #pragma unroll
  for(int r=4;r<16;r+=4){a=max3f(a,p0[r],p0[r+1]);b=max3f(b,p0[r+2],p0[r+3]);a=max3f(a,p1[r],p1[r+1]);b=max3f(b,p1[r+2],p1[r+3]);}
  const float m=max2f(a,b);
  auto rr=__builtin_amdgcn_permlane32_swap(__float_as_uint(m),__float_as_uint(m),false,false);
  return max2f(__uint_as_float(rr[0]),__uint_as_float(rr[1]));
}
__device__ __forceinline__ void pv(f32x16*o,int vb,bf16x8 pa0,bf16x8 pa1,bf16x8 pa2,bf16x8 pa3){
  #pragma unroll
  for(int d0=0;d0<2;++d0){s16x4 lo[4],hi[4];
    #pragma unroll
    for(int ks=0;ks<4;++ks){
      asm volatile("ds_read_b64_tr_b16 %0,%1 offset:%c2":"=&v"(lo[ks]):"v"(vb),"i"(d0*4096+ks*1024):"memory");
      asm volatile("ds_read_b64_tr_b16 %0,%1 offset:%c2":"=&v"(hi[ks]):"v"(vb),"i"(d0*4096+ks*1024+512):"memory");}
    asm volatile("s_waitcnt lgkmcnt(0)":::"memory");SBAR();
    #define PK(k) (bf16x8){lo[k][0],lo[k][1],lo[k][2],lo[k][3],hi[k][0],hi[k][1],hi[k][2],hi[k][3]}
    o[d0]=__builtin_amdgcn_mfma_f32_32x32x16_bf16(pa0,PK(0),o[d0],0,0,0);
    o[d0]=__builtin_amdgcn_mfma_f32_32x32x16_bf16(pa1,PK(1),o[d0],0,0,0);
    o[d0]=__builtin_amdgcn_mfma_f32_32x32x16_bf16(pa2,PK(2),o[d0],0,0,0);
    o[d0]=__builtin_amdgcn_mfma_f32_32x32x16_bf16(pa3,PK(3),o[d0],0,0,0);
    #undef PK
  }
}

constexpr bool OUT_FP8 = true;
__device__ __forceinline__ void attn_st16(void* p, const u32x4 v) {
  if constexpr (OUT_FP8) { typedef unsigned u2_ __attribute__((ext_vector_type(2)));
    auto lo = [](unsigned w) { return __uint_as_float(w << 16); }; auto hi = [](unsigned w) { return __uint_as_float(w & 0xffff0000u); };
    int w0 = __builtin_amdgcn_cvt_pk_fp8_f32(lo(v.x), hi(v.x), 0, false); w0 = __builtin_amdgcn_cvt_pk_fp8_f32(lo(v.y), hi(v.y), w0, true);
    int w1 = __builtin_amdgcn_cvt_pk_fp8_f32(lo(v.z), hi(v.z), 0, false); w1 = __builtin_amdgcn_cvt_pk_fp8_f32(lo(v.w), hi(v.w), w1, true);
    u2_ o; o.x = (unsigned)w0; o.y = (unsigned)w1; *(__attribute__((address_space(1))) u2_*)((unsigned long long)p >> 1) = o; }
  else *(u32x4*)p = v; }
#ifndef ATTN_STORE16
#define ATTN_STORE16(p,v) attn_st16((p),(v))
#endif
constexpr bool LSUM_MFMA=false;
template<int THRL,bool NA,bool FIXM,int DBG=0> __device__ __forceinline__ void attn_unit(const bf16*Qu,const bf16*__restrict__ Kh,const bf16*__restrict__ Vh,bf16*Ou,const int NT,const int tskip,const int gr0,const int kr0,const float*rpbh,const float m0,char*shm){
  int tid_=threadIdx.x; asm volatile("":"+v"(tid_));
  const int tid=tid_,lane=tid&63,r32=lane&31,hi=lane>>5; const int wid=__builtin_amdgcn_readfirstlane(tid>>6);
  const bf16*Qw=Qu+(long)(wid*QBLK)*KP;
  const unsigned lds0=(unsigned)(uintptr_t)shm;
  float*wsf=(float*)(shm+LDS_WS)+wid*64;
  const bf16*ksrc=Kh+(long)lane*KP+wid*8;
  const bf16*vsrc=Vh+(long)(16*(wid&3)+(lane>>2))*KP+(wid>>2)*32+(lane&3)*8;
  const unsigned kdst=lds0+LDS_K+wid*1024, vdst=lds0+LDS_V+wid*1024;
  #define TROW(t) ((long)(((t)<4)?(t):(t)+tskip)*(KVBLK*KP))
  #define DMA_K(t,slot) glds16(ksrc+TROW(t),(unsigned)__builtin_amdgcn_readfirstlane(kdst+(slot)))
  #define DMA_V(t,slot) glds16(vsrc+TROW(t),(unsigned)__builtin_amdgcn_readfirstlane(vdst+(slot)))
  const int vb0=(int)(lds0+LDS_V)+((lane>>4)&1)*32+(lane&3)*8+(4*hi+((lane&15)>>2))*64;
  const char*Kbase=shm+LDS_K; bf16x8 kf[8];
  const lds_cptr shm3=(lds_cptr)shm; const lds_cptr kp0=shm3+LDS_K+hi*1024+r32*16; const lds_cptr vp0=shm3+LDS_V+((lane>>4)&1)*32+(lane&3)*8+(4*hi+((lane&15)>>2))*64;
  DMA_K(0,0);DMA_V(0,0);DMA_K(1,SLOTB);
  bf16x8 qr[4];
  #pragma unroll
  for(int d0=0;d0<4;++d0)qr[d0]=*reinterpret_cast<const bf16x8*>(&Qw[(long)r32*KP+d0*16+hi*8]);
  float mhat=0.f,l_reg=0.f;f32x16 o[2];o[0]=f32x16{};o[1]=f32x16{};f32x16 negm=f32x16{}; if constexpr(!FIXM){ asm volatile("":"+v"(negm)); }
  constexpr bool LM=FIXM&&LSUM_MFMA;
  f32x16 lacc=f32x16{}; const f32x16 zero16=f32x16{}; const bf16x8 onesv={(short)0x3F80,(short)0x3F80,(short)0x3F80,(short)0x3F80,(short)0x3F80,(short)0x3F80,(short)0x3F80,(short)0x3F80}; (void)m0;
  #define CIN (FIXM?zero16:negm)
  const int gr_=gr0+(wid>>1), gc_=32*(wid&1)+r32, rs_=min(max(gr_-4,0),120), cs_=min(max(gc_-8,0),48), bb_=15-gc_+4*hi, d0_=4*hi-cs_;
  const lds_cfptr tab=(lds_cfptr)(shm3+LDS_BYTES);
  if constexpr(NA){ __attribute__((address_space(3))) float*tw=(__attribute__((address_space(3))) float*)(shm3+LDS_BYTES); for(int i=tid;i<465;i+=NW*64)tw[i]=rpbh[i]*1.4426950408889634f; }
  #define CMASK(P0,P1,t) do{ if constexpr(NA){ if((t)>=4){ const int kr_=kr0+(t)-4; na_mask(P0,P1,(kr_>=rs_&&kr_<rs_+8),(kr_-gr_+7)*31+bb_,d0_,tab); } } }while(0)
  bool resc=false;
  #define START(P0,P1) do{ resc=false; if constexpr(!FIXM) \
    { const float rm=rowmax(P0,P1); const float dl=rm; mhat=fadd_s(mhat,dl); \
      _Pragma("unroll") for(int r=0;r<16;++r){P0[r]=fsub_s(P0[r],dl);P1[r]=fsub_s(P1[r],dl);} \
      _Pragma("unroll") for(int r=0;r<16;++r)negm[r]=-mhat; asm volatile("":"+v"(negm)); } \
    _Pragma("unroll") for(int r=0;r<16;++r)P0[r]=__builtin_amdgcn_exp2f(P0[r]); }while(0)
  #define RESC() do{ if(resc){ asm volatile("s_waitcnt lgkmcnt(0)":::"memory"); \
      _Pragma("unroll") for(int d_=0;d_<2;++d_) _Pragma("unroll") for(int r=0;r<16;++r)o[d_][r]*=wsf[crow(r,hi)]; } }while(0)
  f32x16 pA0,pA1,pB0,pB1;
  int sl_prev=0,sl_cur=0,sl_next=SLOTB;
  #define ROT() do{sl_prev=sl_cur;sl_cur=sl_next;sl_next=(sl_next==(NSLOT-1)*SLOTB)?0:sl_next+SLOTB;}while(0)
  DMA_K(2,2*SLOTB);
  WAIT_BAR(3);
  qkt(pA0,pA1,Kbase,qr,CIN,r32,hi);asm volatile("s_nop 15\n\ts_nop 7":"+v"(pA0),"+v"(pA1));CMASK(pA0,pA1,0);
  START(pA0,pA1);
  _Pragma("unroll") for(int r=0;r<16;++r)pA1[r]=__builtin_amdgcn_exp2f(pA1[r]);
  WAIT_BAR(0);
  DMA_K(3,0);DMA_V(1,SLOTB);
  ROT();
  kload8(kf,kp0+sl_cur);
  WAIT_BAR(2);
  s16x4 vlo[8],vhi[8]; u32x4 pw0,pw1,pw2,pw3;
  #define PKW(P,B) cvtpk_s(P[B],P[B+1])
  #define PAF(k) __builtin_bit_cast(bf16x8,pw##k)
  #define VFR(i) (bf16x8){vlo[i][0],vlo[i][1],vlo[i][2],vlo[i][3],vhi[i][0],vhi[i][1],vhi[i][2],vhi[i][3]}
  #define PIN(x) asm volatile("":"+v"(x))
  #define MX3(a,b,c) __builtin_fmaxf(__builtin_fmaxf((a),(b)),(c))
  #define GAPA(MF,A0,A1,A2,A3,W0,W1,PW) do{ MF; if constexpr(!LM&&DBG!=2&&DBG!=3){ sacc+=A0; sacc+=A1; sacc+=A2; sacc+=A3; PIN(sacc); } W0; W1; PIN(PW); SBAR(); }while(0)
  #define EX(v) ((DBG==1||DBG==3)?(v):__builtin_amdgcn_exp2f(v))
  #define GAPB(MF,X,B) do{ MF; X[B]=EX(X[B]); X[B+1]=EX(X[B+1]); X[B+2]=EX(X[B+2]); X[B+3]=EX(X[B+3]); PIN(X); SBAR(); }while(0)
  #define GAPB3(MF,X,B) do{ MF; X[B]=EX(X[B]); X[B+1]=EX(X[B+1]); X[B+2]=EX(X[B+2]); PIN(X); SBAR(); }while(0)
  #define GAPB2(MF,X,B) do{ MF; X[B]=EX(X[B]); X[B+1]=EX(X[B+1]); PIN(X); SBAR(); }while(0)
  #define LMF(k) lacc=__builtin_amdgcn_mfma_f32_32x32x16_bf16(PAF(k),onesv,lacc,0,0,0)
  #define VRD(i) do{ vlo[i]=vtr(vp_+(((i)>>2)*4096+((i)&3)*1024)); vhi[i]=vtr(vp_+(((i)>>2)*4096+((i)&3)*1024+512)); }while(0)
  #define KRD(G,j) do{ if(G){ kload2(kf,kp0+sl_next,j); SBAR(); } }while(0)
  #define STEP(C0,C1,P0,P1,t,GK,GV,GL) do{ SBAR(); \
    const lds_cptr vp_=vp0+sl_prev; \
    VRD(0); SBAR(); float sacc=0.f; if constexpr(!LM) sacc=(P0[0]+P0[1]); \
    GAPA(C0=__builtin_amdgcn_mfma_f32_32x32x16_bf16(kf[0],qr[0],CIN,0,0,0), P0[2],P0[3],P0[4],P0[5],     pw0[0]=PKW(P0,0), pw0[1]=PKW(P0,2), pw0); \
    VRD(4); SBAR(); GAPA(C1=__builtin_amdgcn_mfma_f32_32x32x16_bf16(kf[1],qr[0],CIN,0,0,0), P0[6],P0[7],P0[8],P0[9],     pw0[2]=PKW(P0,4), pw0[3]=PKW(P0,6), pw0); \
    VRD(1); SBAR(); GAPA(C0=__builtin_amdgcn_mfma_f32_32x32x16_bf16(kf[2],qr[1],C0,0,0,0),   P0[10],P0[11],P0[12],P0[13], pw1[0]=PKW(P0,8), pw1[1]=PKW(P0,10), pw1); \
    VRD(5); SBAR(); GAPA(C1=__builtin_amdgcn_mfma_f32_32x32x16_bf16(kf[3],qr[1],C1,0,0,0),   P0[14],P0[15],P1[0],P1[1],   pw1[2]=PKW(P0,12),pw1[3]=PKW(P0,14), pw1); \
    VRD(2); SBAR(); GAPA(C0=__builtin_amdgcn_mfma_f32_32x32x16_bf16(kf[4],qr[2],C0,0,0,0),   P1[2],P1[3],P1[4],P1[5],     pw2[0]=PKW(P1,0), pw2[1]=PKW(P1,2), pw2); \
    VRD(6); SBAR(); GAPA(C1=__builtin_amdgcn_mfma_f32_32x32x16_bf16(kf[5],qr[2],C1,0,0,0),   P1[6],P1[7],P1[8],P1[9],     pw2[2]=PKW(P1,4), pw2[3]=PKW(P1,6), pw2); \
    VRD(3); SBAR(); GAPA(C0=__builtin_amdgcn_mfma_f32_32x32x16_bf16(kf[6],qr[3],C0,0,0,0),   P1[10],P1[11],P1[12],P1[13], pw3[0]=PKW(P1,8), pw3[1]=PKW(P1,10), pw3); \
    VRD(7); SBAR(); GAPA(C1=__builtin_amdgcn_mfma_f32_32x32x16_bf16(kf[7],qr[3],C1,0,0,0),   P1[14],P1[15],0.f,0.f,       pw3[2]=PKW(P1,12),pw3[3]=PKW(P1,14), pw3); \
    if constexpr(!LM) l_reg+=sacc; \
    if(GK){DMA_K((t)+3,sl_cur);} if(GV){DMA_V((t)+1,sl_next);} \
    CMASK(C0,C1,t); \
    if constexpr(!FIXM) { float a=MX3(C0[0],C0[1],C1[0]),b=MX3(C0[2],C0[3],C1[1]); a=MX3(a,C1[2],C1[3]); \
      _Pragma("unroll") for(int r=4;r<16;r+=4){a=MX3(a,C0[r],C0[r+1]);b=MX3(b,C0[r+2],C0[r+3]);a=MX3(a,C1[r],C1[r+1]);b=MX3(b,C1[r+2],C1[r+3]);} \
      float rm=__builtin_fmaxf(a,b); { auto rr=__builtin_amdgcn_permlane32_swap(__float_as_uint(rm),__float_as_uint(rm),false,false); rm=__builtin_fmaxf(__uint_as_float(rr[0]),__uint_as_float(rr[1])); } \
      resc=false; \
      if(__builtin_expect(__any(rm>(float)THRL),0)){ const float dl=__builtin_fmaxf(rm,0.f); mhat+=dl; \
        _Pragma("unroll") for(int r=0;r<16;++r){C0[r]-=dl;C1[r]-=dl;} \
        _Pragma("unroll") for(int r=0;r<16;++r)negm[r]=-mhat; asm volatile("":"+v"(negm)); \
        const float f=__builtin_amdgcn_exp2f(-dl); l_reg*=f; if(hi==0)wsf[r32]=f; resc=true; } } \
    SBAR(); \
    if constexpr(LM){ \
    GAPB3(o[0]=__builtin_amdgcn_mfma_f32_32x32x16_bf16(PAF(0),VFR(0),o[0],0,0,0), C0,0); \
    GAPB3(o[1]=__builtin_amdgcn_mfma_f32_32x32x16_bf16(PAF(0),VFR(4),o[1],0,0,0), C0,3); \
    GAPB2(LMF(0), C0,6); \
    KRD(GL,0); GAPB3(o[0]=__builtin_amdgcn_mfma_f32_32x32x16_bf16(PAF(1),VFR(1),o[0],0,0,0), C0,8); \
    KRD(GL,1); GAPB3(o[1]=__builtin_amdgcn_mfma_f32_32x32x16_bf16(PAF(1),VFR(5),o[1],0,0,0), C0,11); \
    GAPB2(LMF(1), C0,14); \
    KRD(GL,2); GAPB3(o[0]=__builtin_amdgcn_mfma_f32_32x32x16_bf16(PAF(2),VFR(2),o[0],0,0,0), C1,0); \
    KRD(GL,3); GAPB3(o[1]=__builtin_amdgcn_mfma_f32_32x32x16_bf16(PAF(2),VFR(6),o[1],0,0,0), C1,3); \
    GAPB2(LMF(2), C1,6); \
    GAPB3(o[0]=__builtin_amdgcn_mfma_f32_32x32x16_bf16(PAF(3),VFR(3),o[0],0,0,0), C1,8); \
    GAPB3(o[1]=__builtin_amdgcn_mfma_f32_32x32x16_bf16(PAF(3),VFR(7),o[1],0,0,0), C1,11); \
    GAPB2(LMF(3), C1,14); \
    } else { \
    GAPB(o[0]=__builtin_amdgcn_mfma_f32_32x32x16_bf16(PAF(0),VFR(0),o[0],0,0,0), C0,0); \
    GAPB(o[1]=__builtin_amdgcn_mfma_f32_32x32x16_bf16(PAF(0),VFR(4),o[1],0,0,0), C0,4); \
    KRD(GL,0); GAPB(o[0]=__builtin_amdgcn_mfma_f32_32x32x16_bf16(PAF(1),VFR(1),o[0],0,0,0), C0,8); \
    KRD(GL,1); GAPB(o[1]=__builtin_amdgcn_mfma_f32_32x32x16_bf16(PAF(1),VFR(5),o[1],0,0,0), C0,12); \
    KRD(GL,2); GAPB(o[0]=__builtin_amdgcn_mfma_f32_32x32x16_bf16(PAF(2),VFR(2),o[0],0,0,0), C1,0); \
    KRD(GL,3); GAPB(o[1]=__builtin_amdgcn_mfma_f32_32x32x16_bf16(PAF(2),VFR(6),o[1],0,0,0), C1,4); \
    GAPB(o[0]=__builtin_amdgcn_mfma_f32_32x32x16_bf16(PAF(3),VFR(3),o[0],0,0,0), C1,8); \
    GAPB(o[1]=__builtin_amdgcn_mfma_f32_32x32x16_bf16(PAF(3),VFR(7),o[1],0,0,0), C1,12); \
    } \
    }while(0)
  int t=1;
  for(;t+5<NT;t+=2){
    STEP(pB0,pB1,pA0,pA1,t,true,true,true);     WAIT_BAR(2); RESC(); ROT();
    STEP(pA0,pA1,pB0,pB1,t+1,true,true,true);   WAIT_BAR(2); RESC(); ROT();
  }
  #define ENDW(tt) do{ if((tt)+3<NT){WAIT_BAR(2);} else if((tt)+2<NT){WAIT_BAR(1);} else {WAIT_BAR(0);} }while(0)
  for(;t+1<NT;t+=2){
    STEP(pB0,pB1,pA0,pA1,t,(t+3<NT),(t+1<NT),(t+1<NT));       ENDW(t);   RESC(); ROT();
    STEP(pA0,pA1,pB0,pB1,t+1,(t+4<NT),(t+2<NT),(t+2<NT));     ENDW(t+1); RESC(); ROT();
  }
  STEP(pB0,pB1,pA0,pA1,NT-1,false,false,false); RESC();
  { if constexpr(!LM){ float sacc=pB0[0]+pB0[1]; _Pragma("unroll") for(int r=2;r<16;++r)sacc+=pB0[r]; _Pragma("unroll") for(int r=0;r<16;++r)sacc+=pB1[r]; l_reg+=sacc; }
    pw0=(u32x4){PKW(pB0,0),PKW(pB0,2),PKW(pB0,4),PKW(pB0,6)};pw1=(u32x4){PKW(pB0,8),PKW(pB0,10),PKW(pB0,12),PKW(pB0,14)};pw2=(u32x4){PKW(pB1,0),PKW(pB1,2),PKW(pB1,4),PKW(pB1,6)};pw3=(u32x4){PKW(pB1,8),PKW(pB1,10),PKW(pB1,12),PKW(pB1,14)};
    SBAR(); if constexpr(LM){ LMF(0); LMF(1); LMF(2); LMF(3); } pv(o,vb0+sl_cur,PAF(0),PAF(1),PAF(2),PAF(3)); }
  #undef PKW
  #undef PAF
  #undef VFR
  #undef PIN
  #undef MX3
  #undef GAPA
  #undef GAPB
  #undef GAPB3
  #undef GAPB2
  #undef LMF
  #undef EX
  #undef VRD
  #undef KRD
  #undef STEP
  #undef ENDW
  float rli[16];
  if constexpr(LM){
    #pragma unroll
    for(int r=0;r<16;++r)rli[r]=__builtin_amdgcn_rcpf(lacc[r]);
  } else {
    {auto rr=__builtin_amdgcn_permlane32_swap(__float_as_uint(l_reg),__float_as_uint(l_reg),false,false);l_reg=__uint_as_float(rr[0])+__uint_as_float(rr[1]);}
    if(hi==0)wsf[32+r32]=l_reg;asm volatile("s_waitcnt lgkmcnt(0)":::"memory");
    #pragma unroll
    for(int r=0;r<16;++r)rli[r]=__builtin_amdgcn_rcpf(wsf[32+crow(r,hi)]);
  }
  bf16*Ow=Ou+(long)(wid*QBLK)*OP;
  { bf16*stg=(bf16*)(shm+LDS_OST)+wid*2048;
    #pragma unroll
    for(int r=0;r<16;++r){const int orow=crow(r,hi);
      #pragma unroll
      for(int d0=0;d0<2;++d0)stg[orow*64+d0*32+r32]=__float2bfloat16(o[d0][r]*rli[r]);}
    asm volatile("s_waitcnt lgkmcnt(0)":::"memory");
    #pragma unroll
    for(int i=0;i<4;++i){const int row=i*8+(lane>>3),ch=lane&7; const u32x4 v=*(const u32x4*)(stg+row*64+ch*8); ATTN_STORE16(Ow+(long)row*OP+ch*8,v);} }
  asm volatile("s_waitcnt lgkmcnt(0)\n\ts_barrier":::"memory");
  #undef DMA_K
  #undef DMA_V
  #undef TROW
  #undef CMASK
  #undef CIN
  #undef START
  #undef RESC
  #undef ROT
}
template<int B> __device__ __forceinline__ void ex4(f32x16&X){ X[B]=__builtin_amdgcn_exp2f(X[B]); X[B+1]=__builtin_amdgcn_exp2f(X[B+1]); X[B+2]=__builtin_amdgcn_exp2f(X[B+2]); X[B+3]=__builtin_amdgcn_exp2f(X[B+3]); }
template<int B> __device__ __forceinline__ void ad4(float&l,const f32x16&X){ l+=X[B]; l+=X[B+1]; l+=X[B+2]; l+=X[B+3]; }
template<int B,int W> __device__ __forceinline__ void pk2v(u32x4&w,const f32x16&X){ w[W]=cvtpk_s(X[B],X[B+1]); w[W+1]=cvtpk_s(X[B+2],X[B+3]); }
__device__ __forceinline__ bf16x8 vfrag(lds_cptr vp,int off){ const s16x4 lo=vtr(vp+off),hi=vtr(vp+off+512); return (bf16x8){lo[0],lo[1],lo[2],lo[3],hi[0],hi[1],hi[2],hi[3]}; }
template<int DBG=0> __device__ __forceinline__ void attn_unit64(const bf16*Qu,const bf16*__restrict__ Kh,const bf16*__restrict__ Vh,bf16*Ou,const int NT,char*shm){
  int tid_=threadIdx.x; asm volatile("":"+v"(tid_));
  const int tid=tid_,lane=tid&63,r32=lane&31,hi=lane>>5; const int wid=__builtin_amdgcn_readfirstlane(tid>>6);
  const bf16*Qw=Qu+(long)(wid*64)*KP;
  const unsigned lds0=(unsigned)(uintptr_t)shm;
  float*wsf=(float*)(shm+LDS_WS)+wid*64;
  const bf16*ksrc=Kh+(long)lane*KP+wid*8;
  const bf16*vsrc=Vh+(long)(16*(wid&3)+(lane>>2))*KP+(wid>>2)*32+(lane&3)*8;
  const unsigned kdst=lds0+LDS_K+wid*1024, vdst=lds0+LDS_V+wid*1024;
  #define DMA_K(t,slot) glds16(ksrc+(long)(t)*(KVBLK*KP),(unsigned)__builtin_amdgcn_readfirstlane(kdst+(slot)))
  #define DMA_V(t,slot) glds16(vsrc+(long)(t)*(KVBLK*KP),(unsigned)__builtin_amdgcn_readfirstlane(vdst+(slot)))
  #define MF(a,b,c) __builtin_amdgcn_mfma_f32_32x32x16_bf16(a,b,c,0,0,0)
  const lds_cptr shm3=(lds_cptr)shm; const lds_cptr kp0=shm3+LDS_K+hi*1024+r32*16; const lds_cptr vp0=shm3+LDS_V+((lane>>4)&1)*32+(lane&3)*8+(4*hi+((lane&15)>>2))*64;
  DMA_K(0,0);DMA_V(0,0);DMA_K(1,SLOTB);
  bf16x8 qa[4],qb[4];
  #pragma unroll
  for(int d0=0;d0<4;++d0){ qa[d0]=*reinterpret_cast<const bf16x8*>(&Qw[(long)r32*KP+d0*16+hi*8]); qb[d0]=*reinterpret_cast<const bf16x8*>(&Qw[(long)(32+r32)*KP+d0*16+hi*8]); }
  DMA_K(2,2*SLOTB);DMA_V(1,SLOTB);
  f32x16 oa[2],ob[2]; oa[0]=f32x16{};oa[1]=f32x16{};ob[0]=f32x16{};ob[1]=f32x16{}; float la=0.f,lb=0.f; const f32x16 zero16=f32x16{};
  f32x16 Ca0,Ca1,Cb0,Cb1; u32x4 pa0,pa1,pa2,pa3,pb0,pb1,pb2,pb3;
  bf16x8 kf[8]; bf16x8 vfp={0,0,0,0,0,0,0,0}; bool first_=true; (void)first_; (void)vfp;
  #define QKT(ks) do{ if(DBG!=14||first_){ kload8(kf,kp0+(ks)); first_=false; } \
    Ca0=MF(kf[0],qa[0],zero16); Cb0=MF(kf[0],qb[0],zero16); Ca1=MF(kf[1],qa[0],zero16); Cb1=MF(kf[1],qb[0],zero16); \
    Ca0=MF(kf[2],qa[1],Ca0); Cb0=MF(kf[2],qb[1],Cb0); Ca1=MF(kf[3],qa[1],Ca1); Cb1=MF(kf[3],qb[1],Cb1); \
    Ca0=MF(kf[4],qa[2],Ca0); Cb0=MF(kf[4],qb[2],Cb0); Ca1=MF(kf[5],qa[2],Ca1); Cb1=MF(kf[5],qb[2],Cb1); \
    Ca0=MF(kf[6],qa[3],Ca0); Cb0=MF(kf[6],qb[3],Cb0); Ca1=MF(kf[7],qa[3],Ca1); Cb1=MF(kf[7],qb[3],Cb1); }while(0)
  #define PAF(w) __builtin_bit_cast(bf16x8,w)
  WAIT_BAR(4);
  QKT(0);
  { ex4<0>(Ca0);ex4<4>(Ca0);ex4<8>(Ca0);ex4<12>(Ca0);ex4<0>(Ca1);ex4<4>(Ca1);ex4<8>(Ca1);ex4<12>(Ca1);
    ex4<0>(Cb0);ex4<4>(Cb0);ex4<8>(Cb0);ex4<12>(Cb0);ex4<0>(Cb1);ex4<4>(Cb1);ex4<8>(Cb1);ex4<12>(Cb1);
    ad4<0>(la,Ca0);ad4<4>(la,Ca0);ad4<8>(la,Ca0);ad4<12>(la,Ca0);ad4<0>(la,Ca1);ad4<4>(la,Ca1);ad4<8>(la,Ca1);ad4<12>(la,Ca1);
    ad4<0>(lb,Cb0);ad4<4>(lb,Cb0);ad4<8>(lb,Cb0);ad4<12>(lb,Cb0);ad4<0>(lb,Cb1);ad4<4>(lb,Cb1);ad4<8>(lb,Cb1);ad4<12>(lb,Cb1);
    pk2v<0,0>(pa0,Ca0);pk2v<4,2>(pa0,Ca0);pk2v<8,0>(pa1,Ca0);pk2v<12,2>(pa1,Ca0);pk2v<0,0>(pa2,Ca1);pk2v<4,2>(pa2,Ca1);pk2v<8,0>(pa3,Ca1);pk2v<12,2>(pa3,Ca1);
    pk2v<0,0>(pb0,Cb0);pk2v<4,2>(pb0,Cb0);pk2v<8,0>(pb1,Cb0);pk2v<12,2>(pb1,Cb0);pk2v<0,0>(pb2,Cb1);pk2v<4,2>(pb2,Cb1);pk2v<8,0>(pb3,Cb1);pk2v<12,2>(pb3,Cb1); }
  WAIT_BAR(2);
  int sk=SLOTB, sv=0;
  #define PIN(x) asm volatile("":"+v"(x))
  #define GAPV(L,k,d0,vf,E,A,P) do{ o##L[d0]=MF(PAF(p##L##k),vf,o##L[d0]); if(DBG!=13){ E; A; P; } SBAR(); }while(0)
  for(int t=1;t<NT;++t){
    if(DBG!=12){ if(t+2<NT){DMA_K(t+2,sv);} if(t+1<NT){DMA_V(t+1,(sk==2*SLOTB)?0:sk+SLOTB);} }
    SBAR();
    QKT(sk);
    SBAR();
    { const lds_cptr vp_=vp0+sv; bf16x8 vf=vfp;
      if(DBG!=14||t==1){vf=vfrag(vp_,0); vfp=vf;}            GAPV(a,0,0,vf, ex4<0>(Ca0),  (void)0,          (void)0); GAPV(b,0,0,vf, ex4<0>(Cb0),  (void)0,          (void)0);
      if(DBG!=14||t==1){vf=vfrag(vp_,4096); vfp=vf;}         GAPV(a,0,1,vf, ex4<4>(Ca0),  ad4<0>(la,Ca0),   (void)0); GAPV(b,0,1,vf, ex4<4>(Cb0),  ad4<0>(lb,Cb0),   (void)0);
      if(DBG!=14||t==1){vf=vfrag(vp_,1024); vfp=vf;}         GAPV(a,1,0,vf, ex4<8>(Ca0),  ad4<4>(la,Ca0),   (pk2v<0,0>(pa0,Ca0))); GAPV(b,1,0,vf, ex4<8>(Cb0),  ad4<4>(lb,Cb0),   (pk2v<0,0>(pb0,Cb0)));
      if(DBG!=14||t==1){vf=vfrag(vp_,4096+1024); vfp=vf;}    GAPV(a,1,1,vf, ex4<12>(Ca0), ad4<8>(la,Ca0),   (pk2v<4,2>(pa0,Ca0))); GAPV(b,1,1,vf, ex4<12>(Cb0), ad4<8>(lb,Cb0),   (pk2v<4,2>(pb0,Cb0)));
      if(DBG!=14||t==1){vf=vfrag(vp_,2048); vfp=vf;}         GAPV(a,2,0,vf, ex4<0>(Ca1),  ad4<12>(la,Ca0),  (pk2v<8,0>(pa1,Ca0))); GAPV(b,2,0,vf, ex4<0>(Cb1),  ad4<12>(lb,Cb0),  (pk2v<8,0>(pb1,Cb0)));
      if(DBG!=14||t==1){vf=vfrag(vp_,4096+2048); vfp=vf;}    GAPV(a,2,1,vf, ex4<4>(Ca1),  ad4<0>(la,Ca1),   (pk2v<12,2>(pa1,Ca0))); GAPV(b,2,1,vf, ex4<4>(Cb1),  ad4<0>(lb,Cb1),   (pk2v<12,2>(pb1,Cb0)));
      if(DBG!=14||t==1){vf=vfrag(vp_,3072); vfp=vf;}         GAPV(a,3,0,vf, ex4<8>(Ca1),  ad4<4>(la,Ca1),   (pk2v<0,0>(pa2,Ca1))); GAPV(b,3,0,vf, ex4<8>(Cb1),  ad4<4>(lb,Cb1),   (pk2v<0,0>(pb2,Cb1)));
      if(DBG!=14||t==1){vf=vfrag(vp_,4096+3072); vfp=vf;}    GAPV(a,3,1,vf, ex4<12>(Ca1), ad4<8>(la,Ca1),   (pk2v<4,2>(pa2,Ca1))); GAPV(b,3,1,vf, ex4<12>(Cb1), ad4<8>(lb,Cb1),   (pk2v<4,2>(pb2,Cb1)));
      if(DBG!=13){ ad4<12>(la,Ca1); ad4<12>(lb,Cb1);
      (pk2v<8,0>(pa3,Ca1)); (pk2v<12,2>(pa3,Ca1)); (pk2v<8,0>(pb3,Cb1)); (pk2v<12,2>(pb3,Cb1)); } }
    if(DBG==11){ asm volatile("s_waitcnt lgkmcnt(0)":::"memory"); } else if(DBG==12){ WAIT_BAR(0); } else { if(t+2<NT){WAIT_BAR(2);} else if(t+1<NT){WAIT_BAR(1);} else {WAIT_BAR(0);} }
    sv=sk; sk=(sk==2*SLOTB)?0:sk+SLOTB;
  }
  { const lds_cptr vp_=vp0+sv; bf16x8 vf;
    vf=vfrag(vp_,0);         oa[0]=MF(PAF(pa0),vf,oa[0]); ob[0]=MF(PAF(pb0),vf,ob[0]);
    vf=vfrag(vp_,4096);      oa[1]=MF(PAF(pa0),vf,oa[1]); ob[1]=MF(PAF(pb0),vf,ob[1]);
    vf=vfrag(vp_,1024);      oa[0]=MF(PAF(pa1),vf,oa[0]); ob[0]=MF(PAF(pb1),vf,ob[0]);
    vf=vfrag(vp_,4096+1024); oa[1]=MF(PAF(pa1),vf,oa[1]); ob[1]=MF(PAF(pb1),vf,ob[1]);
    vf=vfrag(vp_,2048);      oa[0]=MF(PAF(pa2),vf,oa[0]); ob[0]=MF(PAF(pb2),vf,ob[0]);
    vf=vfrag(vp_,4096+2048); oa[1]=MF(PAF(pa2),vf,oa[1]); ob[1]=MF(PAF(pb2),vf,ob[1]);
    vf=vfrag(vp_,3072);      oa[0]=MF(PAF(pa3),vf,oa[0]); ob[0]=MF(PAF(pb3),vf,ob[0]);
    vf=vfrag(vp_,4096+3072); oa[1]=MF(PAF(pa3),vf,oa[1]); ob[1]=MF(PAF(pb3),vf,ob[1]); }
  #define EPI64(L,rowoff) do{ \
    { auto rr=__builtin_amdgcn_permlane32_swap(__float_as_uint(l##L),__float_as_uint(l##L),false,false); l##L=__uint_as_float(rr[0])+__uint_as_float(rr[1]); } \
    if(hi==0)wsf[32+r32]=l##L; asm volatile("s_waitcnt lgkmcnt(0)":::"memory"); \
    float rli[16]; _Pragma("unroll") for(int r=0;r<16;++r)rli[r]=__builtin_amdgcn_rcpf(wsf[32+crow(r,hi)]); \
    bf16*Ow=Ou+(long)(wid*64+(rowoff))*OP; bf16*stg=(bf16*)(shm+LDS_OST)+wid*2048; \
    _Pragma("unroll") for(int r=0;r<16;++r){ const int orow=crow(r,hi); _Pragma("unroll") for(int d0=0;d0<2;++d0)stg[orow*64+d0*32+r32]=__float2bfloat16(o##L[d0][r]*rli[r]); } \
    asm volatile("s_waitcnt lgkmcnt(0)":::"memory"); \
    _Pragma("unroll") for(int i=0;i<4;++i){ const int row=i*8+(lane>>3),ch=lane&7; const u32x4 v=*(const u32x4*)(stg+row*64+ch*8); ATTN_STORE16(Ow+(long)row*OP+ch*8,v); } \
    asm volatile("s_waitcnt lgkmcnt(0)":::"memory"); }while(0)
  EPI64(a,0); EPI64(b,32);
  asm volatile("s_waitcnt lgkmcnt(0)\n\ts_barrier":::"memory");
  #undef EPI64
  #undef GAPV
  #undef PIN
  #undef PAF
  #undef QKT
  #undef MF
  #undef DMA_K
  #undef DMA_V
}
typedef int v8i_t __attribute__((ext_vector_type(8))); typedef int v4i_t __attribute__((ext_vector_type(4)));
template<int DBG=0> __device__ __forceinline__ void attn_unit64f8(const unsigned char*Q8u,const unsigned char*__restrict__ K8h,const bf16*__restrict__ Vh,bf16*Ou,const int NT,char*shm){
  int tid_=threadIdx.x; asm volatile("":"+v"(tid_));
  const int tid=tid_,lane=tid&63,r32=lane&31,hi=lane>>5; const int wid=__builtin_amdgcn_readfirstlane(tid>>6);
  const unsigned char*Q8w=Q8u+(long)(wid*64)*512;
  const unsigned lds0=(unsigned)(uintptr_t)shm;
  float*wsf=(float*)(shm+LDS_WS)+wid*64;
  const unsigned char*k8src=K8h+(long)lane*128+(wid&3)*16;
  const bf16*vsrc=Vh+(long)(16*(wid&3)+(lane>>2))*KP+(wid>>2)*32+(lane&3)*8;
  const unsigned kdst=lds0+LDS_K+wid*1024, vdst=lds0+LDS_V+wid*1024;
  #define DMA_K(t,slot) do{ if(wid<4){ glds16(k8src+(long)(t)*(KVBLK*128),(unsigned)__builtin_amdgcn_readfirstlane(kdst+(slot))); } }while(0)
  #define DMA_V(t,slot) glds16(vsrc+(long)(t)*(KVBLK*KP),(unsigned)__builtin_amdgcn_readfirstlane(vdst+(slot)))
  #define MF(a,b,c) __builtin_amdgcn_mfma_f32_32x32x16_bf16(a,b,c,0,0,0)
  const lds_cptr shm3=(lds_cptr)shm; const lds_cptr kp8=shm3+LDS_K+(2*hi)*1024+r32*16; const lds_cptr vp0=shm3+LDS_V+((lane>>4)&1)*32+(lane&3)*8+(4*hi+((lane&15)>>2))*64;
  DMA_K(0,0);DMA_V(0,0);DMA_K(1,SLOTB);
  v8i_t qa8,qb8;
  { const v4i_t a0=*reinterpret_cast<const v4i_t*>(Q8w+(long)r32*512+32*hi), a1=*reinterpret_cast<const v4i_t*>(Q8w+(long)r32*512+32*hi+16), b0=*reinterpret_cast<const v4i_t*>(Q8w+(long)(32+r32)*512+32*hi), b1=*reinterpret_cast<const v4i_t*>(Q8w+(long)(32+r32)*512+32*hi+16);
    qa8=(v8i_t){a0[0],a0[1],a0[2],a0[3],a1[0],a1[1],a1[2],a1[3]}; qb8=(v8i_t){b0[0],b0[1],b0[2],b0[3],b1[0],b1[1],b1[2],b1[3]}; }
  DMA_K(2,2*SLOTB);DMA_V(1,SLOTB);
  f32x16 oa[2],ob[2]; oa[0]=f32x16{};oa[1]=f32x16{};ob[0]=f32x16{};ob[1]=f32x16{}; float la=0.f,lb=0.f; const f32x16 zero16=f32x16{};
  f32x16 Ca0,Ca1,Cb0,Cb1; u32x4 pa0,pa1,pa2,pa3,pb0,pb1,pb2,pb3;
  bf16x8 vfp={0,0,0,0,0,0,0,0}; (void)vfp;
  #define MF8(a,b,c) __builtin_amdgcn_mfma_scale_f32_32x32x64_f8f6f4(a,b,c,0,0,0,0x7F7F7F7F,0,0x7F7F7F7F)
  #define KF8(ks,n) ({ const v4i_t lo_=*(const __attribute__((address_space(3))) v4i_t*)(kp8+(ks)+(n)*512), hi_=*(const __attribute__((address_space(3))) v4i_t*)(kp8+(ks)+(n)*512+1024); (v8i_t){lo_[0],lo_[1],lo_[2],lo_[3],hi_[0],hi_[1],hi_[2],hi_[3]}; })
  #define QKT(ks) do{ const v8i_t k0_=KF8(ks,0), k1_=KF8(ks,1); Ca0=MF8(k0_,qa8,zero16); Cb0=MF8(k0_,qb8,zero16); Ca1=MF8(k1_,qa8,zero16); Cb1=MF8(k1_,qb8,zero16); }while(0)
  #define WAIT_KV(N03,N47) do{ if(wid<4){WAIT_BAR(N03);} else {WAIT_BAR(N47);} }while(0)
  #define PAF(w) __builtin_bit_cast(bf16x8,w)
  WAIT_KV(4,2);
  QKT(0);
  { ex4<0>(Ca0);ex4<4>(Ca0);ex4<8>(Ca0);ex4<12>(Ca0);ex4<0>(Ca1);ex4<4>(Ca1);ex4<8>(Ca1);ex4<12>(Ca1);
    ex4<0>(Cb0);ex4<4>(Cb0);ex4<8>(Cb0);ex4<12>(Cb0);ex4<0>(Cb1);ex4<4>(Cb1);ex4<8>(Cb1);ex4<12>(Cb1);
    ad4<0>(la,Ca0);ad4<4>(la,Ca0);ad4<8>(la,Ca0);ad4<12>(la,Ca0);ad4<0>(la,Ca1);ad4<4>(la,Ca1);ad4<8>(la,Ca1);ad4<12>(la,Ca1);
    ad4<0>(lb,Cb0);ad4<4>(lb,Cb0);ad4<8>(lb,Cb0);ad4<12>(lb,Cb0);ad4<0>(lb,Cb1);ad4<4>(lb,Cb1);ad4<8>(lb,Cb1);ad4<12>(lb,Cb1);
    pk2v<0,0>(pa0,Ca0);pk2v<4,2>(pa0,Ca0);pk2v<8,0>(pa1,Ca0);pk2v<12,2>(pa1,Ca0);pk2v<0,0>(pa2,Ca1);pk2v<4,2>(pa2,Ca1);pk2v<8,0>(pa3,Ca1);pk2v<12,2>(pa3,Ca1);
    pk2v<0,0>(pb0,Cb0);pk2v<4,2>(pb0,Cb0);pk2v<8,0>(pb1,Cb0);pk2v<12,2>(pb1,Cb0);pk2v<0,0>(pb2,Cb1);pk2v<4,2>(pb2,Cb1);pk2v<8,0>(pb3,Cb1);pk2v<12,2>(pb3,Cb1); }
  WAIT_KV(2,1);
  int sk=SLOTB, sv=0;
  #define PIN(x) asm volatile("":"+v"(x))
  #define GAPV(L,k,d0,vf,E,A,P) do{ o##L[d0]=MF(PAF(p##L##k),vf,o##L[d0]); if(DBG!=13){ E; A; P; } SBAR(); }while(0)
  for(int t=1;t<NT;++t){
    if(DBG!=12){ if(t+2<NT){DMA_K(t+2,sv);} if(t+1<NT){DMA_V(t+1,(sk==2*SLOTB)?0:sk+SLOTB);} }
    SBAR();
    QKT(sk);
    SBAR();
    { const lds_cptr vp_=vp0+sv; bf16x8 vf=vfp;
      if(DBG!=14||t==1){vf=vfrag(vp_,0); vfp=vf;}            GAPV(a,0,0,vf, ex4<0>(Ca0),  (void)0,          (void)0); GAPV(b,0,0,vf, ex4<0>(Cb0),  (void)0,          (void)0);
      if(DBG!=14||t==1){vf=vfrag(vp_,4096); vfp=vf;}         GAPV(a,0,1,vf, ex4<4>(Ca0),  ad4<0>(la,Ca0),   (void)0); GAPV(b,0,1,vf, ex4<4>(Cb0),  ad4<0>(lb,Cb0),   (void)0);
      if(DBG!=14||t==1){vf=vfrag(vp_,1024); vfp=vf;}         GAPV(a,1,0,vf, ex4<8>(Ca0),  ad4<4>(la,Ca0),   (pk2v<0,0>(pa0,Ca0))); GAPV(b,1,0,vf, ex4<8>(Cb0),  ad4<4>(lb,Cb0),   (pk2v<0,0>(pb0,Cb0)));
      if(DBG!=14||t==1){vf=vfrag(vp_,4096+1024); vfp=vf;}    GAPV(a,1,1,vf, ex4<12>(Ca0), ad4<8>(la,Ca0),   (pk2v<4,2>(pa0,Ca0))); GAPV(b,1,1,vf, ex4<12>(Cb0), ad4<8>(lb,Cb0),   (pk2v<4,2>(pb0,Cb0)));
      if(DBG!=14||t==1){vf=vfrag(vp_,2048); vfp=vf;}         GAPV(a,2,0,vf, ex4<0>(Ca1),  ad4<12>(la,Ca0),  (pk2v<8,0>(pa1,Ca0))); GAPV(b,2,0,vf, ex4<0>(Cb1),  ad4<12>(lb,Cb0),  (pk2v<8,0>(pb1,Cb0)));
      if(DBG!=14||t==1){vf=vfrag(vp_,4096+2048); vfp=vf;}    GAPV(a,2,1,vf, ex4<4>(Ca1),  ad4<0>(la,Ca1),   (pk2v<12,2>(pa1,Ca0))); GAPV(b,2,1,vf, ex4<4>(Cb1),  ad4<0>(lb,Cb1),   (pk2v<12,2>(pb1,Cb0)));
      if(DBG!=14||t==1){vf=vfrag(vp_,3072); vfp=vf;}         GAPV(a,3,0,vf, ex4<8>(Ca1),  ad4<4>(la,Ca1),   (pk2v<0,0>(pa2,Ca1))); GAPV(b,3,0,vf, ex4<8>(Cb1),  ad4<4>(lb,Cb1),   (pk2v<0,0>(pb2,Cb1)));
      if(DBG!=14||t==1){vf=vfrag(vp_,4096+3072); vfp=vf;}    GAPV(a,3,1,vf, ex4<12>(Ca1), ad4<8>(la,Ca1),   (pk2v<4,2>(pa2,Ca1))); GAPV(b,3,1,vf, ex4<12>(Cb1), ad4<8>(lb,Cb1),   (pk2v<4,2>(pb2,Cb1)));
      if(DBG!=13){ ad4<12>(la,Ca1); ad4<12>(lb,Cb1);
      (pk2v<8,0>(pa3,Ca1)); (pk2v<12,2>(pa3,Ca1)); (pk2v<8,0>(pb3,Cb1)); (pk2v<12,2>(pb3,Cb1)); } }
    if(DBG==11){ asm volatile("s_waitcnt lgkmcnt(0)":::"memory"); } else if(DBG==12){ WAIT_BAR(0); } else { if(t+2<NT){WAIT_KV(2,1);} else if(t+1<NT){WAIT_BAR(1);} else {WAIT_BAR(0);} }
    sv=sk; sk=(sk==2*SLOTB)?0:sk+SLOTB;
  }
  { const lds_cptr vp_=vp0+sv; bf16x8 vf;
    vf=vfrag(vp_,0);         oa[0]=MF(PAF(pa0),vf,oa[0]); ob[0]=MF(PAF(pb0),vf,ob[0]);
    vf=vfrag(vp_,4096);      oa[1]=MF(PAF(pa0),vf,oa[1]); ob[1]=MF(PAF(pb0),vf,ob[1]);
    vf=vfrag(vp_,1024);      oa[0]=MF(PAF(pa1),vf,oa[0]); ob[0]=MF(PAF(pb1),vf,ob[0]);
    vf=vfrag(vp_,4096+1024); oa[1]=MF(PAF(pa1),vf,oa[1]); ob[1]=MF(PAF(pb1),vf,ob[1]);
    vf=vfrag(vp_,2048);      oa[0]=MF(PAF(pa2),vf,oa[0]); ob[0]=MF(PAF(pb2),vf,ob[0]);
    vf=vfrag(vp_,4096+2048); oa[1]=MF(PAF(pa2),vf,oa[1]); ob[1]=MF(PAF(pb2),vf,ob[1]);
    vf=vfrag(vp_,3072);      oa[0]=MF(PAF(pa3),vf,oa[0]); ob[0]=MF(PAF(pb3),vf,ob[0]);
    vf=vfrag(vp_,4096+3072); oa[1]=MF(PAF(pa3),vf,oa[1]); ob[1]=MF(PAF(pb3),vf,ob[1]); }
  #define EPI64(L,rowoff) do{ \
    { auto rr=__builtin_amdgcn_permlane32_swap(__float_as_uint(l##L),__float_as_uint(l##L),false,false); l##L=__uint_as_float(rr[0])+__uint_as_float(rr[1]); } \
    if(hi==0)wsf[32+r32]=l##L; asm volatile("s_waitcnt lgkmcnt(0)":::"memory"); \
    float rli[16]; _Pragma("unroll") for(int r=0;r<16;++r)rli[r]=__builtin_amdgcn_rcpf(wsf[32+crow(r,hi)]); \
    bf16*Ow=Ou+(long)(wid*64+(rowoff))*OP; bf16*stg=(bf16*)(shm+LDS_OST)+wid*2048; \
    _Pragma("unroll") for(int r=0;r<16;++r){ const int orow=crow(r,hi); _Pragma("unroll") for(int d0=0;d0<2;++d0)stg[orow*64+d0*32+r32]=__float2bfloat16(o##L[d0][r]*rli[r]); } \
    asm volatile("s_waitcnt lgkmcnt(0)":::"memory"); \
    _Pragma("unroll") for(int i=0;i<4;++i){ const int row=i*8+(lane>>3),ch=lane&7; const u32x4 v=*(const u32x4*)(stg+row*64+ch*8); ATTN_STORE16(Ow+(long)row*OP+ch*8,v); } \
    asm volatile("s_waitcnt lgkmcnt(0)":::"memory"); }while(0)
  EPI64(a,0); EPI64(b,32);
  asm volatile("s_waitcnt lgkmcnt(0)\n\ts_barrier":::"memory");
  #undef EPI64
  #undef GAPV
  #undef PIN
  #undef PAF
  #undef QKT
  #undef KF8
  #undef MF8
  #undef WAIT_KV
  #undef MF
  #undef DMA_K
  #undef DMA_V
}
template<int DBG=0> __device__ __forceinline__ void attn_unit64f8pv(const unsigned char*Q8u,const unsigned char*__restrict__ K8h,const unsigned char*__restrict__ VT8h,bf16*Ou,const int NT,char*shm){
  int tid_=threadIdx.x; asm volatile("":"+v"(tid_));
  const int tid=tid_,lane=tid&63,r32=lane&31,hi=lane>>5; const int wid=__builtin_amdgcn_readfirstlane(tid>>6);
  const unsigned char*Q8w=Q8u+(long)(wid*64)*512;
  const unsigned lds0=(unsigned)(uintptr_t)shm;
  float*wsf=(float*)(shm+LDS_WS)+wid*64;
  const unsigned char*dsrc=(wid<4)?K8h+(long)lane*128+(wid&3)*16:VT8h+(long)lane*64+(wid&3)*16;
  const long dstep=(wid<4)?(long)KVBLK*128:4096;
  const unsigned ddst=lds0+((wid<4)?LDS_K:LDS_V)+(wid&3)*1024;
  #define DMA1(t,slot) glds16(dsrc+(long)(t)*dstep,(unsigned)__builtin_amdgcn_readfirstlane(ddst+(slot)))
  const lds_cptr shm3=(lds_cptr)shm; const lds_cptr kp8=shm3+LDS_K+(2*hi)*1024+r32*16; const lds_cptr vp8=shm3+LDS_V+(2*hi)*1024+r32*16;
  DMA1(0,0);
  v8i_t qa8,qb8;
  { const v4i_t a0=*reinterpret_cast<const v4i_t*>(Q8w+(long)r32*512+32*hi), a1=*reinterpret_cast<const v4i_t*>(Q8w+(long)r32*512+32*hi+16), b0=*reinterpret_cast<const v4i_t*>(Q8w+(long)(32+r32)*512+32*hi), b1=*reinterpret_cast<const v4i_t*>(Q8w+(long)(32+r32)*512+32*hi+16);
    qa8=(v8i_t){a0[0],a0[1],a0[2],a0[3],a1[0],a1[1],a1[2],a1[3]}; qb8=(v8i_t){b0[0],b0[1],b0[2],b0[3],b1[0],b1[1],b1[2],b1[3]}; }
  DMA1(1,SLOTB);
  if(wid<4){ DMA1(2,2*SLOTB); }
  f32x16 oa[2],ob[2]; oa[0]=f32x16{};oa[1]=f32x16{};ob[0]=f32x16{};ob[1]=f32x16{}; float la=0.f,lb=0.f; const f32x16 zero16=f32x16{};
  f32x16 Ca0,Ca1,Cb0,Cb1; v8i_t pa8,pb8;
  f32x16 lsa=f32x16{},lsb=f32x16{}; const v8i_t ones8={0x38383838,0x38383838,0x38383838,0x38383838,0x38383838,0x38383838,0x38383838,0x38383838}; (void)la; (void)lb;
  #define MF8(a,b,c) __builtin_amdgcn_mfma_scale_f32_32x32x64_f8f6f4(a,b,c,0,0,0,0x7F7F7F7F,0,0x7F7F7F7F)
  #define MF8P(a,b,c) __builtin_amdgcn_mfma_scale_f32_32x32x64_f8f6f4(a,b,c,1,0,0,0x7F7F7F7F,0,0x7F7F7F7F)
  #define FR8(base,slot,n) ({ const v4i_t lo_=*(const __attribute__((address_space(3))) v4i_t*)((base)+(slot)+(n)*512), hi_=*(const __attribute__((address_space(3))) v4i_t*)((base)+(slot)+(n)*512+1024); (v8i_t){lo_[0],lo_[1],lo_[2],lo_[3],hi_[0],hi_[1],hi_[2],hi_[3]}; })
  #define QKT(ks) do{ const v8i_t k0_=FR8(kp8,ks,0), k1_=FR8(kp8,ks,1); Ca0=MF8(k0_,qa8,zero16); Cb0=MF8(k0_,qb8,zero16); Ca1=MF8(k1_,qa8,zero16); Cb1=MF8(k1_,qb8,zero16); }while(0)
  #define PVT(vs) do{ const v8i_t v0_=FR8(vp8,vs,0), v1_=FR8(vp8,vs,1); oa[0]=MF8P(pa8,v0_,oa[0]); ob[0]=MF8P(pb8,v0_,ob[0]); oa[1]=MF8P(pa8,v1_,oa[1]); ob[1]=MF8P(pb8,v1_,ob[1]); lsa=MF8P(pa8,ones8,lsa); lsb=MF8P(pb8,ones8,lsb); }while(0)
  #define PK8(x0,x1,x2,x3) ({ int w_=__builtin_amdgcn_cvt_pk_bf8_f32(x0,x1,0,false); w_=__builtin_amdgcn_cvt_pk_bf8_f32(x2,x3,w_,true); w_; })
  #define SOFTMAX(C0,C1,l,P8) do{ \
    ex4<0>(C0);ex4<4>(C0);ex4<8>(C0);ex4<12>(C0);ex4<0>(C1);ex4<4>(C1);ex4<8>(C1);ex4<12>(C1); \
    P8=(v8i_t){PK8(C0[0],C0[1],C0[2],C0[3]),PK8(C0[4],C0[5],C0[6],C0[7]),PK8(C0[8],C0[9],C0[10],C0[11]),PK8(C0[12],C0[13],C0[14],C0[15]), \
               PK8(C1[0],C1[1],C1[2],C1[3]),PK8(C1[4],C1[5],C1[6],C1[7]),PK8(C1[8],C1[9],C1[10],C1[11]),PK8(C1[12],C1[13],C1[14],C1[15])}; }while(0)
  if(wid<4){WAIT_BAR(2);} else {WAIT_BAR(1);}
  QKT(0);
  SOFTMAX(Ca0,Ca1,la,pa8); SOFTMAX(Cb0,Cb1,lb,pb8);
  if(wid<4){WAIT_BAR(1);} else {WAIT_BAR(1);}
  int sk=SLOTB, sv=0;
  for(int t=1;t<NT;++t){
    const bool iss=(wid<4)?(t+2<NT):(t+1<NT);
    if(iss){ if(wid<4){DMA1(t+2,sv);} else {DMA1(t+1,(sk==2*SLOTB)?0:sk+SLOTB);} }
    SBAR();
    QKT(sk);
    PVT(sv);
    SBAR();
    SOFTMAX(Ca0,Ca1,la,pa8); SOFTMAX(Cb0,Cb1,lb,pb8);
    if(iss){WAIT_BAR(1);} else {WAIT_BAR(0);}
    sv=sk; sk=(sk==2*SLOTB)?0:sk+SLOTB;
  }
  PVT(sv);
  #define EPI64(L,rowoff) do{ \
    float rli[16]; _Pragma("unroll") for(int r=0;r<16;++r)rli[r]=__builtin_amdgcn_rcpf(ls##L[r]); \
    bf16*Ow=Ou+(long)(wid*64+(rowoff))*OP; bf16*stg=(bf16*)(shm+LDS_OST)+wid*2048; \
    _Pragma("unroll") for(int r=0;r<16;++r){ const int orow=crow(r,hi); _Pragma("unroll") for(int d0=0;d0<2;++d0)stg[orow*64+d0*32+r32]=__float2bfloat16(o##L[d0][r]*rli[r]); } \
    asm volatile("s_waitcnt lgkmcnt(0)":::"memory"); \
    _Pragma("unroll") for(int i=0;i<4;++i){ const int row=i*8+(lane>>3),ch=lane&7; const u32x4 v=*(const u32x4*)(stg+row*64+ch*8); ATTN_STORE16(Ow+(long)row*OP+ch*8,v); } \
    asm volatile("s_waitcnt lgkmcnt(0)":::"memory"); }while(0)
  EPI64(a,0); EPI64(b,32);
  asm volatile("s_waitcnt lgkmcnt(0)\n\ts_barrier":::"memory");
  #undef EPI64
  #undef SOFTMAX
  #undef PK8
  #undef PVT
  #undef QKT
  #undef FR8
  #undef MF8P
  #undef MF8
  #undef DMA1
}
constexpr int ATTN_LDS_BYTES=LDS_BYTES;
#undef SBAR
#undef WAIT_BAR
}

constexpr int NWAVES = 8;
constexpr int DM = 1024, NBATCH = 4, SEQL = 8192, CTXL = 256, TPB = SEQL + CTXL, NROW = NBATCH * TPB, DEPTH = 4;
constexpr int INW = 2048, NEXP = 16, EDIM = 2048, CAPL = 1024, CAPC = 32, ETILES = 17, ESLOTS = ETILES * 256, EUSED = NBATCH * (CAPL + CAPC);
constexpr int COL_QA = 0, COL_KA = 512, COL_VA = 640, COL_QB = 768, COL_KB = 1024, COL_VB = 1280, COL_CV = 1536, COL_CG = 1792;
constexpr int MIX_A = 0, MIX_B = 512, MIX_C = 768;
constexpr float LOG2E = 1.4426950408889634f, C2 = 0.125f * LOG2E, EPS = 1e-6f;
constexpr int NPL = 9;
constexpr bool MOE_DOWN_FP8 = true;
constexpr bool MOE_UP_FP8 = true;
constexpr bool ATTN_FP8_PV = true;
constexpr bool ATTN_FP8_QK = true;
constexpr int ATTN_DBG = 0;
constexpr int WGM_IN = 4, WGM_OUT = 8, WGM_G1 = 8, WGM_G2 = 8;
constexpr int PROBE_KIND = -1, PROBE_MULT = 4;
constexpr int REP_P0 = 1, REP_INPROJ = 1, REP_ATTN = 1, REP_CONV = 1, REP_NORM2 = 1, REP_TOPK = 1, REP_DISPATCH = 1, REP_G1 = 1, REP_G2 = 1;
constexpr int PH_FINAL = 1 + DEPTH * NPL, NPH = PH_FINAL + 1;
enum { LP_NORM1 = 0, LP_INPROJ = 1, LP_VT = 2, LP_MIX = 3, LP_OUTPROJ = 4, LP_NORM2 = 5, LP_TOPK = 6, LP_G1 = 7, LP_G2 = 8 };

constexpr size_t MiB = 1u << 20;
constexpr size_t WS_CTL = 0, CTL_ZERO_BYTES = 65536;
constexpr size_t WS_MODV = 1 * MiB;
constexpr size_t WS_ROPE = 2 * MiB;
constexpr size_t WS_WIN = 4 * MiB;
constexpr size_t WS_WOUT = 20 * MiB;
constexpr size_t WS_WGU = 32 * MiB;
constexpr size_t WS_WD = 544 * MiB;
constexpr size_t WS_X = 800 * MiB;
constexpr size_t WS_HN = 932 * MiB;
constexpr size_t WS_P = 998 * MiB;
constexpr size_t WS_MIX = 1130 * MiB;
constexpr size_t WS_AFF = 1196 * MiB;
constexpr size_t WS_SLOT = 1199 * MiB;
constexpr size_t WS_IDX = 1202 * MiB;
constexpr size_t WS_XE = 1204 * MiB;
constexpr size_t WS_H1 = 1340 * MiB;
constexpr size_t WS_Y = 1612 * MiB;
constexpr size_t WS_RW = 1748 * MiB;
constexpr size_t WS_RC = 1750 * MiB;
constexpr size_t WS_Q8 = 1752 * MiB;
constexpr size_t WS_K8 = 1770 * MiB;
constexpr size_t WS_VT8 = 1776 * MiB;
constexpr size_t WS_END = 1782 * MiB;
constexpr int CW_TMO = 0, CW_CODE = 1, CW_BAR = 4096;

constexpr int RING_OFF = 0, RING_BYTES = 155648;
constexpr int GTAB_OFF = 131072, GTAB_UNITS = 17;
constexpr int LDSCTL_OFF = RING_BYTES, MISC_OFF = LDSCTL_OFF + 320;
constexpr int LDS_BYTES = 159744;
static_assert(MISC_OFF + 128 <= LDS_BYTES, "LDS map");

#define GAS __attribute__((address_space(1)))
#define LAS __attribute__((address_space(3)))
typedef unsigned short bf16;
typedef unsigned v4u __attribute__((ext_vector_type(4)));
typedef float f32x4 __attribute__((ext_vector_type(4)));
typedef short bf16x8 __attribute__((ext_vector_type(8)));
typedef GAS unsigned gu32;
typedef GAS unsigned long long gu64;
#define RLX_AGENT __ATOMIC_RELAXED, __HIP_MEMORY_SCOPE_AGENT
#define LDS_WAIT() asm volatile("s_waitcnt lgkmcnt(0)" ::: "memory")
#define VM_WAIT() asm volatile("s_waitcnt vmcnt(0)" ::: "memory")
__device__ __forceinline__ unsigned long long rt() { return __builtin_amdgcn_s_memrealtime(); }
__device__ __forceinline__ unsigned f2bf(float f) { unsigned u = __builtin_bit_cast(unsigned, f); return (u + 0x7fffu + ((u >> 16) & 1u)) >> 16; }
__device__ __forceinline__ unsigned pk2(float lo, float hi) { return f2bf(lo) | (f2bf(hi) << 16); }

#define XB_TMO      128
#define XB_XCNT(j)  (256  + 64 * (j))
#define XB_XSUB(j)  (1280 + 64 * (j))
#define XB_XGEN(j)  (2304 + 64 * (j))
#define XB_TOP      3328
#define XB_TOPGEN   3392
#define XCD_BAR_WORDS 3456
#define XB_SPIN_CAP (1u << 18)

__device__ __forceinline__ unsigned xb_ld(unsigned* p)              { return __hip_atomic_load(p, __ATOMIC_RELAXED, __HIP_MEMORY_SCOPE_AGENT); }
__device__ __forceinline__ unsigned xb_add(unsigned* p, unsigned v) { return __hip_atomic_fetch_add(p, v, __ATOMIC_RELAXED, __HIP_MEMORY_SCOPE_AGENT); }
__device__ __forceinline__ unsigned xb_xcc_id() { return (unsigned)__builtin_amdgcn_s_getreg((3 << 11) | 20) & 0xFu; }
#define XB_SPIN(cond, bar) do { unsigned _sp = 0; while (cond) { __builtin_amdgcn_s_sleep(1); \
    if ((++_sp & 255u) == 0u) { if (xb_ld(&(bar)[XB_TMO])) break; if (_sp > XB_SPIN_CAP) { atomicAdd(&(bar)[XB_TMO], 1u); break; } } } } while (0)

struct XcdBarrier {
    unsigned* bar; unsigned x;
    volatile LAS unsigned* st;
};

__device__ __forceinline__ XcdBarrier xcd_barrier_post(unsigned* bar, volatile LAS unsigned* st) {
    XcdBarrier b; b.bar = bar; b.x = xb_xcc_id(); b.st = st;
    if (threadIdx.x == 0) (void)xb_add(&bar[XB_XCNT(b.x)], 1u);
    return b;
}
__device__ __forceinline__ void xcd_barrier_complete(unsigned* bar, unsigned x, unsigned& nloc, unsigned& nx) {
    const unsigned G = gridDim.x * gridDim.y * gridDim.z;
    unsigned sum, cnt, mine, sp = 0u;
    for (;;) {
        sum = 0u; cnt = 0u; mine = 0u;
#pragma unroll
        for (unsigned j = 0; j < 16; ++j) { const unsigned c = xb_ld(&bar[XB_XCNT(j)]); sum += c; cnt += (c > 0u) ? 1u : 0u; mine = (j == x) ? c : mine; }
        if (sum == G) break;
        __builtin_amdgcn_s_sleep(1);
        if ((++sp & 255u) == 0u) { if (xb_ld(&bar[XB_TMO])) break; if (sp > XB_SPIN_CAP) { atomicAdd(&bar[XB_TMO], 1u); break; } }
    }
    nloc = mine > 0u ? mine : 1u; nx = cnt > 0u ? cnt : 1u;
}

__device__ __forceinline__ void xcd_barrier(const XcdBarrier& b) {
    asm volatile("s_waitcnt vmcnt(0)" ::: "memory");
    __syncthreads();
    if (threadIdx.x == 0) {
        unsigned* bar = b.bar;
        __builtin_amdgcn_s_waitcnt(0);
        unsigned nloc = b.st[0], nx = b.st[1];
        if (nloc == 0u) { xcd_barrier_complete(bar, b.x, nloc, nx); b.st[0] = nloc; b.st[1] = nx; }
        const unsigned old = xb_add(&bar[XB_XSUB(b.x)], 1u);
        const unsigned gen = old / nloc;
        if (old + 1u == (gen + 1u) * nloc) {
            __builtin_amdgcn_fence(__ATOMIC_RELEASE, "agent");
            asm volatile("s_waitcnt vmcnt(0)" ::: "memory");
            const unsigned og = xb_add(&bar[XB_TOP], 1u);
            const unsigned tg = og / nx;
            if (og + 1u == (tg + 1u) * nx) xb_add(&bar[XB_TOPGEN], 1u);
            else XB_SPIN(xb_ld(&bar[XB_TOPGEN]) == tg, bar);
            __builtin_amdgcn_fence(__ATOMIC_ACQUIRE, "agent");
            xb_add(&bar[XB_XGEN(b.x)], 1u);
            asm volatile("s_waitcnt vmcnt(0)" ::: "memory");
        } else {
            XB_SPIN(xb_ld(&bar[XB_XGEN(b.x)]) == gen, bar);
            __builtin_amdgcn_fence(__ATOMIC_ACQUIRE, "agent");
            asm volatile("s_waitcnt vmcnt(0)" ::: "memory");
        }
    }
    __syncthreads();
}


typedef unsigned u2v __attribute__((ext_vector_type(2)));
__device__ __forceinline__ float bf2f(unsigned short b) { return __uint_as_float((unsigned)b << 16); }
__device__ __forceinline__ float bflo(unsigned w) { return __uint_as_float(w << 16); }
__device__ __forceinline__ float bfhi(unsigned w) { return __uint_as_float(w & 0xffff0000u); }
__device__ __forceinline__ float fexp2(float x) { return __builtin_amdgcn_exp2f(x); }
__device__ __forceinline__ float fsigmoid(float x) { return __builtin_amdgcn_rcpf(1.0f + fexp2(-LOG2E * x)); }

struct Frame {
    LAS unsigned char* lds;
    volatile LAS unsigned* MISC;
    gu32* ctl;
    int tid, lane, wave;
    int vcu, G, bx;
    const float* in[22];
    float* out;
    unsigned char* ws;
};
#define WSP(T, off) ((T*)(F.ws + (off)))

__device__ __forceinline__ float wave_sum(float v) {
#pragma unroll
    for (int o = 1; o < 64; o <<= 1) v += __shfl_xor(v, o);
    return v;
}

__device__ __forceinline__ void tr_item(const float* W0, int N, bf16* Wt0, int K, LAS float* scr, int lane) {
    f32x4 v[16];
    const int n4 = (lane & 15) * 4, k4 = lane >> 4;
#pragma unroll
    for (int i = 0; i < 16; ++i) v[i] = __builtin_nontemporal_load((const GAS f32x4*)(W0 + (size_t)(4 * i + k4) * N + n4));
#pragma unroll
    for (int i = 0; i < 16; ++i) { LAS float* d = scr + (4 * i + k4) * 65 + n4; d[0] = v[i].x; d[1] = v[i].y; d[2] = v[i].z; d[3] = v[i].w; }
    LDS_WAIT(); asm volatile("" ::: "memory");
    const int c = lane & 7;
#pragma unroll
    for (int j = 0; j < 8; ++j) { const int n = (lane >> 3) + 8 * j; const LAS float* s = scr + (8 * c) * 65 + n;
        v4u o; o.x = pk2(s[0 * 65], s[1 * 65]); o.y = pk2(s[2 * 65], s[3 * 65]); o.z = pk2(s[4 * 65], s[5 * 65]); o.w = pk2(s[6 * 65], s[7 * 65]);
        *(GAS v4u*)(Wt0 + (size_t)n * K + 8 * c) = o; }
    LDS_WAIT(); asm volatile("" ::: "memory");
}
__device__ __forceinline__ void tr_item8(const float* W0, int N, unsigned char* Wt0, int K, float mul, LAS float* scr, int lane) {
    f32x4 v[16];
    const int n4 = (lane & 15) * 4, k4 = lane >> 4;
#pragma unroll
    for (int i = 0; i < 16; ++i) v[i] = __builtin_nontemporal_load((const GAS f32x4*)(W0 + (size_t)(4 * i + k4) * N + n4));
#pragma unroll
    for (int i = 0; i < 16; ++i) { LAS float* d = scr + (4 * i + k4) * 65 + n4; d[0] = v[i].x; d[1] = v[i].y; d[2] = v[i].z; d[3] = v[i].w; }
    LDS_WAIT(); asm volatile("" ::: "memory");
    const int c = lane & 7;
#pragma unroll
    for (int j = 0; j < 8; ++j) { const int n = (lane >> 3) + 8 * j; const LAS float* s = scr + (8 * c) * 65 + n;
        int w0 = __builtin_amdgcn_cvt_pk_fp8_f32(s[0 * 65] * mul, s[1 * 65] * mul, 0, false); w0 = __builtin_amdgcn_cvt_pk_fp8_f32(s[2 * 65] * mul, s[3 * 65] * mul, w0, true);
        int w1 = __builtin_amdgcn_cvt_pk_fp8_f32(s[4 * 65] * mul, s[5 * 65] * mul, 0, false); w1 = __builtin_amdgcn_cvt_pk_fp8_f32(s[6 * 65] * mul, s[7 * 65] * mul, w1, true);
        u2v o; o.x = (unsigned)w0; o.y = (unsigned)w1; *(GAS u2v*)(Wt0 + (size_t)n * K + 8 * c) = o; }
    LDS_WAIT(); asm volatile("" ::: "memory");
}
__device__ __forceinline__ void sincos_d(double a, double& s, double& c) {
    const double n = __builtin_rint(a * 0.63661977236758134308);
    double r = __builtin_fma(-n, 1.57079632679489655800e+00, a); r = __builtin_fma(-n, 6.12323399573676603587e-17, r);
    const double r2 = r * r;
    double sp = -7.6471637318198164759e-13; sp = sp * r2 + 1.6059043836821614599e-10; sp = sp * r2 - 2.5052108385441718775e-08; sp = sp * r2 + 2.7557319223985890653e-06;
    sp = sp * r2 - 1.9841269841269841270e-04; sp = sp * r2 + 8.3333333333333333333e-03; sp = sp * r2 - 1.6666666666666666667e-01; const double sr = r + r * r2 * sp;
    double cp = 4.7794773323873852974e-14; cp = cp * r2 - 1.1470745597729724714e-11; cp = cp * r2 + 2.0876756987868098979e-09; cp = cp * r2 - 2.7557319223985890653e-07;
    cp = cp * r2 + 2.4801587301587301587e-05; cp = cp * r2 - 1.3888888888888888889e-03; cp = cp * r2 + 4.1666666666666666667e-02; cp = cp * r2 - 0.5; const double cr = 1.0 + r2 * cp;
    const int q = ((int)n) & 3;
    s = (q == 0) ? sr : (q == 1) ? cr : (q == 2) ? -sr : -cr;
    c = (q == 0) ? cr : (q == 1) ? -sr : (q == 2) ? -cr : sr;
}
constexpr int LI_IN = 16 * 32, LI_OUT = 16 * 16, LI_G = NEXP * 16 * 32, LI_D = NEXP * 32 * 16, LITEMS = LI_IN + LI_OUT + 2 * LI_G + LI_D;
__device__ __forceinline__ void conv_item(Frame& F, int L, int it) {
    LAS float* scr = (LAS float*)(F.lds + F.wave * 16640);
    int r = it;
    if (r < LI_IN) { const int kb = r >> 5, nb = r & 31;
        tr_item(F.in[8] + (size_t)L * 1024 * 2048 + (size_t)(64 * kb) * 2048 + 64 * nb, 2048, WSP(bf16, WS_WIN) + (size_t)L * 2048 * 1024 + (size_t)(64 * nb) * 1024 + 64 * kb, 1024, scr, F.lane); return; }
    r -= LI_IN;
    if (r < LI_OUT) { const int kb = r >> 4, nb = r & 15;
        if (attn_body::OUT_FP8) tr_item8(F.in[16] + (size_t)L * 1024 * 1024 + (size_t)(64 * kb) * 1024 + 64 * nb, 1024, WSP(unsigned char, WS_WOUT) + (size_t)L * 1024 * 1024 + (size_t)(64 * nb) * 1024 + 64 * kb, 1024, 64.0f, scr, F.lane);
        else tr_item(F.in[16] + (size_t)L * 1024 * 1024 + (size_t)(64 * kb) * 1024 + 64 * nb, 1024, WSP(bf16, WS_WOUT) + (size_t)L * 1024 * 1024 + (size_t)(64 * nb) * 1024 + 64 * kb, 1024, scr, F.lane);
        return; }
    r -= LI_OUT;
    if (r < 2 * LI_G) { const int up = r >= LI_G ? 1 : 0; if (up) r -= LI_G; const int mat = L * NEXP + (r >> 9), t = r & 511, kb = t >> 5, nb = t & 31;
        const int n0 = 64 * nb, drow = (n0 >> 7) * 256 + up * 128 + (n0 & 127);
        if (MOE_UP_FP8) tr_item8((up ? F.in[19] : F.in[18]) + (size_t)mat * 1024 * 2048 + (size_t)(64 * kb) * 2048 + n0, 2048, WSP(unsigned char, WS_WGU) + (size_t)mat * 4096 * 1024 + (size_t)drow * 1024 + 64 * kb, 1024, 64.0f, scr, F.lane);
        else tr_item((up ? F.in[19] : F.in[18]) + (size_t)mat * 1024 * 2048 + (size_t)(64 * kb) * 2048 + n0, 2048, WSP(bf16, WS_WGU) + (size_t)mat * 4096 * 1024 + (size_t)drow * 1024 + 64 * kb, 1024, scr, F.lane);
        return; }
    r -= 2 * LI_G;
    { const int mat = L * NEXP + (r >> 9), t = r & 511, kb = t >> 4, nb = t & 15;
        if (MOE_DOWN_FP8) tr_item8(F.in[20] + (size_t)mat * 2048 * 1024 + (size_t)(64 * kb) * 1024 + 64 * nb, 1024, WSP(unsigned char, WS_WD) + (size_t)mat * 1024 * 2048 + (size_t)(64 * nb) * 2048 + 64 * kb, 2048, 64.0f, scr, F.lane);
        else tr_item(F.in[20] + (size_t)mat * 2048 * 1024 + (size_t)(64 * kb) * 1024 + 64 * nb, 1024, WSP(bf16, WS_WD) + (size_t)mat * 1024 * 2048 + (size_t)(64 * nb) * 2048 + 64 * kb, 2048, scr, F.lane); }
}
constexpr int FQ_A = 3, FQ_B = 3, FQ_C = 2, FQ_D = 6;
constexpr int FILL_A0 = 0, FILL_B0 = FILL_A0 + 224 * NWAVES * FQ_A, FILL_C0 = FILL_B0 + 240 * NWAVES * FQ_B, FILL_D0 = FILL_C0 + 128 * NWAVES * FQ_C, FILL_R0 = FILL_D0 + 192 * NWAVES * FQ_D;
static_assert(FILL_R0 <= LITEMS, "filler quotas exceed a layer's items");
__device__ __forceinline__ void fill_convert(Frame& F, int L, int c0, int base, int q) {
    if (L >= DEPTH || F.bx < c0) return;
    const int nfw = (F.G - c0) * NWAVES, fw = (F.bx - c0) * NWAVES + F.wave;
    for (int k = 0; k < q; ++k) conv_item(F, L, base + fw + k * nfw);
}
__device__ __forceinline__ void fill_rest(Frame& F, int L) {
    if (L >= DEPTH) return;
    for (int it = FILL_R0 + F.bx * NWAVES + F.wave; it < LITEMS; it += F.G * NWAVES) conv_item(F, L, it);
}
__device__ __forceinline__ void p0_prologue(Frame& F) {
    {
        LAS float* sil = (LAS float*)F.lds;
        LAS float* part = sil + 8192;
        for (int i = F.tid; i < 5 * 1024; i += NWAVES * 64) { const int s = i >> 10, k = i & 1023; const float c = (s < 4) ? F.in[1][s * 1024 + k] : F.in[3][k]; sil[k * 8 + s] = c * fsigmoid(c); }
        __syncthreads();
        for (int it = F.bx; it < DEPTH * 96; it += F.G) {
            const int l = it / 96, j0 = (it % 96) * 64;
            const float* wa = F.in[4] + (size_t)l * 1024 * 6144 + j0 + F.lane;
            float a0 = 0.f, a1 = 0.f, a2 = 0.f, a3 = 0.f, a4 = 0.f;
            const int kb = F.wave * 128;
#pragma unroll 8
            for (int k = 0; k < 128; ++k) { const float w = wa[(size_t)(kb + k) * 6144]; const f32x4 sv = *(const LAS f32x4*)(sil + (kb + k) * 8); const float s4 = sil[(kb + k) * 8 + 4];
                a0 += w * sv.x; a1 += w * sv.y; a2 += w * sv.z; a3 += w * sv.w; a4 += w * s4; }
            LAS float* pw = part + F.wave * 320 + F.lane; pw[0] = a0; pw[64] = a1; pw[128] = a2; pw[192] = a3; pw[256] = a4;
            __syncthreads();
            if (F.wave < 5) { const int s = F.wave; float t = 0.f;
#pragma unroll
                for (int w = 0; w < 8; ++w) t += part[w * 320 + s * 64 + F.lane];
                const int j = j0 + F.lane, q = j >> 10, kk = j & 1023; t += F.in[5][l * 6144 + j];
                if (q == 1) t = F.in[6][l * 1024 + kk] * (1.0f + t); else if (q == 4) t = F.in[7][l * 1024 + kk] * (1.0f + t);
                WSP(float, WS_MODV)[(size_t)((l * 5 + s) * 6 + q) * 1024 + kk] = t; }
            __syncthreads();
        }
    }
    if (F.bx == F.G - 1) {
        for (int i = F.tid; i < 2048; i += NWAVES * 64) { const int pos = i >> 4, j = i & 15;
            double inv = 1.0; for (int q = 0; q < j; ++q) inv *= 0.56234132519034908039;
            double s, c; sincos_d((double)pos * (double)(float)inv, s, c);
            WSP(float, WS_ROPE)[i] = (float)c; WSP(float, WS_ROPE)[2048 + i] = (float)s; }
    }
    { const int gw = F.vcu * NWAVES + F.wave, NGW = F.G * NWAVES;
      for (int it = gw; it < LITEMS; it += NGW) conv_item(F, 0, it); }
}

__device__ __forceinline__ int row_set(int r) { const int b = r / TPB, t = r - b * TPB; return t < CTXL ? 4 : b; }
__device__ __forceinline__ void ld_x(Frame& F, int r, f32x4 (&v)[4]) {
    const GAS u2v* xr = (const GAS u2v*)(WSP(const bf16, WS_X) + (size_t)r * DM) + F.lane;
#pragma unroll
    for (int j = 0; j < 4; ++j) { const u2v w = xr[64 * j]; v[j] = (f32x4){bflo(w.x), bfhi(w.x), bflo(w.y), bfhi(w.y)}; }
}
__device__ __forceinline__ void st_x(Frame& F, int r, const f32x4 (&v)[4]) {
    GAS u2v* xr = (GAS u2v*)(WSP(bf16, WS_X) + (size_t)r * DM) + F.lane;
#pragma unroll
    for (int j = 0; j < 4; ++j) { u2v w; w.x = pk2(v[j].x, v[j].y); w.y = pk2(v[j].z, v[j].w); xr[64 * j] = w; }
}
__device__ __forceinline__ void ld_in(Frame& F, int r, f32x4 (&v)[4]) {
    const int b = r / TPB, t = r - b * TPB;
    const GAS f32x4* src = (const GAS f32x4*)(t < CTXL ? F.in[2] + ((size_t)b * CTXL + t) * DM : F.in[0] + ((size_t)b * SEQL + (t - CTXL)) * DM) + F.lane;
#pragma unroll
    for (int j = 0; j < 4; ++j) v[j] = src[64 * j];
}
__device__ __forceinline__ void ld_slot(Frame& F, int r, int& sl, float& af) {
    sl = (F.lane < 16) ? WSP(const int, WS_SLOT)[(size_t)r * 16 + F.lane] : -1;
    af = (F.lane < 16) ? WSP(const float, WS_AFF)[(size_t)r * 16 + F.lane] : 0.f;
}
__device__ __forceinline__ void combine_moe(Frame& F, int lprev, int s, int sl, float af, f32x4 (&v)[4]) {
    f32x4 acc[4];
#pragma unroll
    for (int j = 0; j < 4; ++j) acc[j] = (f32x4){0.f, 0.f, 0.f, 0.f};
#pragma unroll
    for (int e = 0; e < NEXP; ++e) {
        const int se = __builtin_amdgcn_readlane(sl, e);
        if (se >= 0) { const float ge = __uint_as_float(__builtin_amdgcn_readlane(__float_as_uint(af), e));
            const GAS u2v* yr = (const GAS u2v*)(WSP(const bf16, WS_Y) + ((size_t)e * ESLOTS + se) * DM) + F.lane;
#pragma unroll
            for (int j = 0; j < 4; ++j) { const u2v w = yr[64 * j]; acc[j] = acc[j] + ge * (f32x4){bflo(w.x), bfhi(w.x), bflo(w.y), bfhi(w.y)}; } }
    }
    const GAS f32x4* g2 = (const GAS f32x4*)(WSP(const float, WS_MODV) + (size_t)((lprev * 5 + s) * 6 + 5) * 1024) + F.lane;
#pragma unroll
    for (int j = 0; j < 4; ++j) v[j] = v[j] + g2[64 * j] * acc[j];
}
__device__ __forceinline__ float row_rstd(const f32x4 (&v)[4]) {
    float s = 0.f;
#pragma unroll
    for (int j = 0; j < 4; ++j) s += (v[j].x * v[j].x + v[j].y * v[j].y) + (v[j].z * v[j].z + v[j].w * v[j].w);
    return 1.0f / sqrtf(wave_sum(s) * (1.0f / DM) + EPS);
}
__device__ __forceinline__ void norm1_finish(Frame& F, int l, int r, int s, const f32x4 (&v)[4]) {
    st_x(F, r, v);
    const float rstd = row_rstd(v);
    const GAS f32x4* A = (const GAS f32x4*)(WSP(const float, WS_MODV) + (size_t)((l * 5 + s) * 6 + 1) * 1024) + F.lane;
    const GAS f32x4* B = (const GAS f32x4*)(WSP(const float, WS_MODV) + (size_t)((l * 5 + s) * 6 + 0) * 1024) + F.lane;
    GAS u2v* o = (GAS u2v*)(WSP(bf16, WS_HN) + (size_t)r * DM) + F.lane;
#pragma unroll
    for (int j = 0; j < 4; ++j) { const f32x4 h = v[j] * rstd * A[64 * j] + B[64 * j]; u2v w; w.x = pk2(h.x, h.y); w.y = pk2(h.z, h.w); o[64 * j] = w; }
}
__device__ __forceinline__ void build_router_tab(Frame& F, int l, int c0);
__device__ __forceinline__ void ph_norm1(Frame& F, int l) {
    if (l == 0) build_router_tab(F, 0, 0);
    for (int ch = F.bx; ch < 256; ch += F.G) {
        for (int i = F.wave; i < 132; i += 2 * NWAVES) {
            const bool vB = i + NWAVES < 132;
            const int rA = ch * 132 + i, rB = vB ? rA + NWAVES : rA, sA = row_set(rA), sB = row_set(rB);
            f32x4 a[4], b[4];
            if (l == 0) { ld_in(F, rA, a); ld_in(F, rB, b); }
            else { int slA, slB; float afA, afB;
                ld_slot(F, rA, slA, afA); ld_slot(F, rB, slB, afB); ld_x(F, rA, a); ld_x(F, rB, b);
                combine_moe(F, l - 1, sA, slA, afA, a); combine_moe(F, l - 1, sB, slB, afB, b); }
            norm1_finish(F, l, rA, sA, a);
            if (vB) norm1_finish(F, l, rB, sB, b);
        }
    }
}
__device__ __forceinline__ void build_router_tab(Frame& F, int l, int c0) {
    if (l >= DEPTH || F.bx < c0 || F.bx >= c0 + 20) return;
    const int s = (F.bx - c0) >> 2, qd = (F.bx - c0) & 3;
    const float* A2 = WSP(const float, WS_MODV) + (size_t)((l * 5 + s) * 6 + 4) * 1024; const float* B2 = WSP(const float, WS_MODV) + (size_t)((l * 5 + s) * 6 + 3) * 1024;
    const float* wr = F.in[17] + (size_t)l * 1024 * 16;
    bf16* th = WSP(bf16, WS_RW) + (size_t)(l * 5 + s) * 32768; bf16* tl = th + 16384;
    for (int idx = F.tid; idx < 256 * 16; idx += NWAVES * 64) { const int k = 256 * qd + (idx >> 4), e = idx & 15;
        const float v = A2[k] * wr[k * 16 + e]; const unsigned h = f2bf(v); const float lo = v - __uint_as_float(h << 16);
        const int off = (((k >> 5) * 64 + ((k >> 3) & 3) * 16 + e) << 3) + (k & 7);
        th[off] = (bf16)h; tl[off] = (bf16)f2bf(lo); }
    if (qd == 0) {
        LAS float* part = (LAS float*)F.lds;
        { const int e = F.tid & 15, kg = F.tid >> 4; float a = 0.f;
#pragma unroll 16
          for (int k = 32 * kg; k < 32 * kg + 32; ++k) a += B2[k] * wr[k * 16 + e];
          part[kg * 16 + e] = a; }
        __syncthreads();
        if (F.tid < 16) { float a = 0.f; for (int kg = 0; kg < 32; ++kg) a += part[kg * 16 + F.tid]; WSP(float, WS_RC)[(l * 5 + s) * 16 + F.tid] = a; }
        __syncthreads();
    }
}
__device__ __forceinline__ void norm2_load(Frame& F, int g, v4u (&xa)[32]) {
    const int fr = F.lane & 15, kq = F.lane >> 4; const size_t r = (size_t)16 * g + fr;
    const GAS v4u* xp = (const GAS v4u*)(WSP(const bf16, WS_X) + r * DM + 8 * kq);
#pragma unroll
    for (int st = 0; st < 32; ++st) xa[st] = xp[4 * st];
}
__device__ __forceinline__ void norm2_group(Frame& F, int l, int g, int s, const LAS unsigned char* tab, v4u (&xa)[32]) {
    int ln = F.lane; asm volatile("" : "+v"(ln));
    const int fr = ln & 15, kq = ln >> 4; const size_t r = (size_t)16 * g + fr;
    float ss = 0.f;
#pragma unroll
    for (int st = 0; st < 32; ++st) { const v4u w = xa[st];
        ss += (bflo(w.x) * bflo(w.x) + bfhi(w.x) * bfhi(w.x)) + (bflo(w.y) * bflo(w.y) + bfhi(w.y) * bfhi(w.y)) + (bflo(w.z) * bflo(w.z) + bfhi(w.z) * bfhi(w.z)) + (bflo(w.w) * bflo(w.w) + bfhi(w.w) * bfhi(w.w)); }
    ss += __shfl_xor(ss, 16); ss += __shfl_xor(ss, 32);
    const float rstd = 1.0f / sqrtf(ss * (1.0f / DM) + EPS);
    f32x4 acc = (f32x4){0.f, 0.f, 0.f, 0.f};
#pragma unroll
    for (int st = 0; st < 32; ++st) { const bf16x8 bh = *(const LAS bf16x8*)(tab + (st * 64 + ln) * 16), bl = *(const LAS bf16x8*)(tab + 32768 + (st * 64 + ln) * 16);
        const bf16x8 a = __builtin_bit_cast(bf16x8, xa[st]);
        acc = __builtin_amdgcn_mfma_f32_16x16x32_bf16(a, bh, acc, 0, 0, 0); acc = __builtin_amdgcn_mfma_f32_16x16x32_bf16(a, bl, acc, 0, 0, 0);
        if ((st & 3) == 3) asm volatile("" ::: "memory"); }
    const float cj = WSP(const float, WS_RC)[(l * 5 + s) * 16 + fr];
#pragma unroll
    for (int e = 0; e < 4; ++e) { const float rs = __shfl(rstd, 4 * kq + e); const float lg = acc[e] * rs + cj;
        float mx = lg; mx = fmaxf(mx, __shfl_xor(mx, 1)); mx = fmaxf(mx, __shfl_xor(mx, 2)); mx = fmaxf(mx, __shfl_xor(mx, 4)); mx = fmaxf(mx, __shfl_xor(mx, 8));
        const float ex = fexp2((lg - mx) * LOG2E); float sm = ex; sm += __shfl_xor(sm, 1); sm += __shfl_xor(sm, 2); sm += __shfl_xor(sm, 4); sm += __shfl_xor(sm, 8);
        WSP(float, WS_AFF)[((size_t)16 * g + 4 * kq + e) * 16 + fr] = ex / sm; }
    const GAS f32x4* A = (const GAS f32x4*)(WSP(const float, WS_MODV) + (size_t)((l * 5 + s) * 6 + 4) * 1024 + 8 * kq);
    const GAS f32x4* B = (const GAS f32x4*)(WSP(const float, WS_MODV) + (size_t)((l * 5 + s) * 6 + 3) * 1024 + 8 * kq);
    GAS v4u* op = (GAS v4u*)(WSP(bf16, WS_HN) + r * DM + 8 * kq);
    GAS u2v* op8 = (GAS u2v*)(WSP(unsigned char, WS_HN) + r * DM + 8 * kq);
#pragma unroll
    for (int st = 0; st < 32; ++st) { v4u w = xa[st]; asm volatile("" : "+v"(w));     const f32x4 a0 = A[8 * st], a1 = A[8 * st + 1], b0 = B[8 * st], b1 = B[8 * st + 1];
        if (MOE_UP_FP8) { int o0 = __builtin_amdgcn_cvt_pk_fp8_f32(bflo(w.x) * rstd * a0.x + b0.x, bfhi(w.x) * rstd * a0.y + b0.y, 0, false); o0 = __builtin_amdgcn_cvt_pk_fp8_f32(bflo(w.y) * rstd * a0.z + b0.z, bfhi(w.y) * rstd * a0.w + b0.w, o0, true);
            int o1 = __builtin_amdgcn_cvt_pk_fp8_f32(bflo(w.z) * rstd * a1.x + b1.x, bfhi(w.z) * rstd * a1.y + b1.y, 0, false); o1 = __builtin_amdgcn_cvt_pk_fp8_f32(bflo(w.w) * rstd * a1.z + b1.z, bfhi(w.w) * rstd * a1.w + b1.w, o1, true);
            u2v o8; o8.x = (unsigned)o0; o8.y = (unsigned)o1; op8[4 * st] = o8; }
        else { v4u o; o.x = pk2(bflo(w.x) * rstd * a0.x + b0.x, bfhi(w.x) * rstd * a0.y + b0.y); o.y = pk2(bflo(w.y) * rstd * a0.z + b0.z, bfhi(w.y) * rstd * a0.w + b0.w);
            o.z = pk2(bflo(w.z) * rstd * a1.x + b1.x, bfhi(w.z) * rstd * a1.y + b1.y); o.w = pk2(bflo(w.w) * rstd * a1.z + b1.z, bfhi(w.w) * rstd * a1.w + b1.w);
            op[4 * st] = o; }
        if (st & 1) asm volatile("" ::: "memory"); }
}
__device__ __forceinline__ int group_set(int g) { const int r = 16 * g, b = r / TPB, t = r - b * TPB; return t < CTXL ? 4 : b; }
__device__ __forceinline__ void ph_norm2(Frame& F, int l) {
    for (int c = F.bx; c < 256; c += F.G) {
        const int g_lo = (33 * c) >> 2, g_hi = (33 * (c + 1)) >> 2, sA = group_set(g_lo), sB = group_set(g_hi - 1);
        v4u xa[32]; norm2_load(F, g_lo + F.wave, xa);
        { const GAS v4u* src = (const GAS v4u*)(WSP(const bf16, WS_RW) + (size_t)(l * 5 + sA) * 32768); LAS v4u* dst = (LAS v4u*)F.lds;
          for (int i = F.tid; i < 4096; i += NWAVES * 64) dst[i] = src[i];
          if (sB != sA) { const GAS v4u* src2 = (const GAS v4u*)(WSP(const bf16, WS_RW) + (size_t)(l * 5 + sB) * 32768); for (int i = F.tid; i < 4096; i += NWAVES * 64) dst[4096 + i] = src2[i]; } }
        __syncthreads();
        for (int g = g_lo + F.wave; g < g_hi; g += NWAVES) { const int s = group_set(g); if (g != g_lo + F.wave) norm2_load(F, g, xa); norm2_group(F, l, g, s, (const LAS unsigned char*)F.lds + (s == sA ? 0 : 65536), xa); }
        __syncthreads();
    }
}
__device__ __forceinline__ void final_finish(Frame& F, int r, const f32x4 (&v)[4]) {
    const int b = r / TPB, t = r - b * TPB;
    const float rstd = row_rstd(v);
    const GAS f32x4* g = (const GAS f32x4*)F.in[21] + F.lane;
    GAS f32x4* o = (GAS f32x4*)(F.out + ((size_t)b * SEQL + (t - CTXL)) * DM) + F.lane;
#pragma unroll
    for (int j = 0; j < 4; ++j) o[64 * j] = v[j] * rstd * g[64 * j];
}
__device__ __forceinline__ void ph_final(Frame& F) {
    for (int ch = F.bx; ch < 256; ch += F.G) {
        for (int i = F.wave; i < 132; i += 2 * NWAVES) {
            const bool vB = i + NWAVES < 132;
            const int rA = ch * 132 + i, rB = vB ? rA + NWAVES : rA;
            const int bA = rA / TPB, tA = rA - bA * TPB, bB = rB / TPB, tB = rB - bB * TPB;
            f32x4 a[4], b[4]; int slA, slB; float afA, afB;
            ld_slot(F, rA, slA, afA); ld_slot(F, rB, slB, afB); ld_x(F, rA, a); ld_x(F, rB, b);
            if (tA >= CTXL) combine_moe(F, DEPTH - 1, bA, slA, afA, a);
            if (tB >= CTXL) combine_moe(F, DEPTH - 1, bB, slB, afB, b);
            if (tA >= CTXL) final_finish(F, rA, a);
            if (vB && tB >= CTXL) final_finish(F, rB, b);
        }
    }
}

__device__ __forceinline__ void ph_conv(Frame& F, int l) {
    LAS float* U = (LAS float*)F.lds;
    const float* cw = F.in[12] + (size_t)l * 31 * 256 + 4 * F.lane;
    f32x4 w[31];
#pragma unroll
    for (int j = 0; j < 31; ++j) w[j] = *(const GAS f32x4*)(cw + j * 256);
    const f32x4 cbv = *(const GAS f32x4*)(F.in[13] + l * 256 + 4 * F.lane), lgv = *(const GAS f32x4*)(F.in[14] + l * 256 + 4 * F.lane), lbv = *(const GAS f32x4*)(F.in[15] + l * 256 + 4 * F.lane);
    const bf16* P = WSP(const bf16, WS_P);
    for (int tile = F.bx; tile < NROW / 66; tile += F.G) {
        const int r0 = tile * 66, b = r0 / TPB, t0 = r0 - b * TPB, seam = b * TPB + CTXL;
        const bool straddle = (t0 < CTXL) && (t0 + 66 > CTXL);
        for (int part = 0; part < (straddle ? 2 : 1); ++part) {
            const bool ctxpart = straddle ? (part == 0) : (t0 < CTXL);
            const int seg_lo = ctxpart ? b * TPB : seam, seg_hi = ctxpart ? seam : (b + 1) * TPB;
            const int p_lo = r0 > seg_lo ? r0 : seg_lo, p_hi = (r0 + 66) < seg_hi ? (r0 + 66) : seg_hi;
            for (int it = F.tid; it < 96 * 32; it += NWAVES * 64) { const int lr = it >> 5, chn = (it & 31) * 8, r = r0 - 15 + lr;
                f32x4 u0 = (f32x4){0.f, 0.f, 0.f, 0.f}, u1 = u0;
                if (r >= seg_lo && r < seg_hi) { const v4u cv = *(const GAS v4u*)(P + (size_t)r * INW + COL_CV + chn), cg = *(const GAS v4u*)(P + (size_t)r * INW + COL_CG + chn);
                    u0.x = bflo(cv.x) * fsigmoid(bflo(cg.x)); u0.y = bfhi(cv.x) * fsigmoid(bfhi(cg.x)); u0.z = bflo(cv.y) * fsigmoid(bflo(cg.y)); u0.w = bfhi(cv.y) * fsigmoid(bfhi(cg.y));
                    u1.x = bflo(cv.z) * fsigmoid(bflo(cg.z)); u1.y = bfhi(cv.z) * fsigmoid(bfhi(cg.z)); u1.z = bflo(cv.w) * fsigmoid(bflo(cg.w)); u1.w = bfhi(cv.w) * fsigmoid(bfhi(cg.w)); }
                *(LAS f32x4*)(U + lr * 256 + chn) = u0; *(LAS f32x4*)(U + lr * 256 + chn + 4) = u1; }
            __syncthreads();
            for (int i = (p_lo - r0) + F.wave; i < p_hi - r0; i += NWAVES) {
                f32x4 y = cbv;
#pragma unroll
                for (int j = 0; j < 31; ++j) y = y + w[j] * *(const LAS f32x4*)(U + (i + j) * 256 + 4 * F.lane);
                const float mean = wave_sum((y.x + y.y) + (y.z + y.w)) * (1.0f / 256.0f);
                const f32x4 d = y - mean;
                const float var = wave_sum((d.x * d.x + d.y * d.y) + (d.z * d.z + d.w * d.w)) * (1.0f / 256.0f);
                const float rstd = 1.0f / sqrtf(var + EPS);
                f32x4 z = d * rstd * lgv + lbv;
                z.x *= fsigmoid(z.x); z.y *= fsigmoid(z.y); z.z *= fsigmoid(z.z); z.w *= fsigmoid(z.w);
                if (attn_body::OUT_FP8) { int w8 = __builtin_amdgcn_cvt_pk_fp8_f32(z.x, z.y, 0, false); w8 = __builtin_amdgcn_cvt_pk_fp8_f32(z.z, z.w, w8, true);
                    *(GAS unsigned*)(WSP(unsigned char, WS_MIX) + (size_t)(r0 + i) * DM + MIX_C + 4 * F.lane) = (unsigned)w8; }
                else { u2v o; o.x = pk2(z.x, z.y); o.y = pk2(z.z, z.w);
                    *(GAS u2v*)(WSP(bf16, WS_MIX) + (size_t)(r0 + i) * DM + MIX_C + 4 * F.lane) = o; }
            }
            __syncthreads();
        }
    }
}

__device__ __forceinline__ int block_excl_scan(Frame& F, int v, LAS int* sc) {
    int inc = v;
#pragma unroll
    for (int o = 1; o < 64; o <<= 1) { const int t = __shfl_up(inc, o); if (F.lane >= o) inc += t; }
    if (F.lane == 63) sc[F.wave] = inc;
    __syncthreads();
    int base = 0;
#pragma unroll
    for (int w = 0; w < NWAVES; ++w) base += (w < F.wave) ? sc[w] : 0;
    __syncthreads();
    return base + inc - v;
}
__device__ __forceinline__ void topk_unit(Frame& F, int kind, int b, int e) {
    LAS unsigned* vals = (LAS unsigned*)F.lds;
    LAS unsigned* hist = vals + 8192;
    LAS int* sc = (LAS int*)(hist + 256);
    const int n = kind ? CTXL : SEQL, cap = kind ? CAPC : CAPL;
    const int row0 = b * TPB + (kind ? 0 : CTXL), slot0 = kind ? NBATCH * CAPL + b * CAPC : b * CAPL;
    const float* aff = WSP(const float, WS_AFF);
    for (int i = F.tid; i < n; i += NWAVES * 64) vals[i] = __float_as_uint(aff[(size_t)(row0 + i) * 16 + e]);
    __syncthreads();
    unsigned prefix = 0u; int need = cap;
    for (int round = 0; round < 4; ++round) {
        const int shift = 24 - 8 * round;
        if (F.tid < 256) hist[F.tid] = 0u;
        __syncthreads();
        for (int i = F.tid; i < n; i += NWAVES * 64) { const unsigned v = vals[i]; const bool match = (round == 0) || ((v >> (shift + 8)) == prefix); if (match) atomicAdd((unsigned*)&hist[(v >> shift) & 255u], 1u); }
        __syncthreads();
        if (F.wave == 0) {
            const unsigned h0 = hist[4 * F.lane], h1 = hist[4 * F.lane + 1], h2 = hist[4 * F.lane + 2], h3 = hist[4 * F.lane + 3];
            const unsigned s = h0 + h1 + h2 + h3; unsigned suf = s;
#pragma unroll
            for (int o = 1; o < 64; o <<= 1) { const unsigned t = __shfl_down(suf, o); if (F.lane + o < 64) suf += t; }
            const unsigned above = suf - s;
            if (above < (unsigned)need && (unsigned)need <= above + s) {
                unsigned a = above; int bin, nn;
                if ((unsigned)need <= a + h3) { bin = 3; nn = need - (int)a; } else { a += h3;
                if ((unsigned)need <= a + h2) { bin = 2; nn = need - (int)a; } else { a += h2;
                if ((unsigned)need <= a + h1) { bin = 1; nn = need - (int)a; } else { a += h1; bin = 0; nn = need - (int)a; } } }
                sc[0] = 4 * F.lane + bin; sc[1] = nn; }
        }
        __syncthreads();
        prefix = (prefix << 8) | (unsigned)sc[0]; need = sc[1];
        __syncthreads();
    }
    const unsigned T = prefix;
    const int cnt = kind ? (F.tid < CTXL ? 1 : 0) : 16, start = kind ? F.tid : 16 * F.tid;
    int ngt = 0, neq = 0;
    for (int i = 0; i < cnt; ++i) { const unsigned v = vals[start + i]; ngt += v > T ? 1 : 0; neq += v == T ? 1 : 0; }
    const int eqpre = block_excl_scan(F, neq, sc);
    int take = need - eqpre; take = take < 0 ? 0 : (take > neq ? neq : take);
    int pos = block_excl_scan(F, ngt + take, sc);
    int* idx = WSP(int, WS_IDX) + (size_t)e * ESLOTS + slot0;
    int* slot = WSP(int, WS_SLOT);
    for (int i = 0; i < cnt; ++i) { const unsigned v = vals[start + i]; int sl = -1;
        if (v > T) sl = pos++; else if (v == T && take > 0) { sl = pos++; --take; }
        const int r = row0 + start + i;
        slot[(size_t)r * 16 + e] = sl >= 0 ? slot0 + sl : -1;
        if (sl >= 0) idx[sl] = r; }
    if (kind == 1 && b == 0 && F.tid < ESLOTS - EUSED) WSP(int, WS_IDX)[(size_t)e * ESLOTS + EUSED + F.tid] = 0;
    __syncthreads();
}
__device__ __forceinline__ void ph_topk(Frame& F) {
    for (int u = F.bx; u < 2 * NBATCH * NEXP; u += F.G) topk_unit(F, u / (NBATCH * NEXP), (u % (NBATCH * NEXP)) / NEXP, u % NEXP);
}

__device__ __forceinline__ void ph_vt8(Frame& F) {
    LAS unsigned char* scr = (LAS unsigned char*)(F.lds + F.wave * 4352);
    const bf16* P = WSP(const bf16, WS_P);
    const int gw = F.vcu * NWAVES + F.wave, NGW = F.G * NWAVES;
    for (int it = gw; it < NBATCH * 2 * (TPB / 64); it += NGW) {
        const int tile = it % (TPB / 64), bk = it / (TPB / 64), b = bk >> 1, kvh = bk & 1;
        const int kk = F.lane, c = kk >> 5, k5 = kk & 31, h = (k5 >> 2) & 1, pos = 32 * h + 16 * c + 4 * (k5 >> 3) + (k5 & 3);
        const GAS v4u* vr = (const GAS v4u*)(P + ((size_t)b * TPB + 64 * tile + kk) * INW + COL_VA + kvh * 64);
        v4u w[8];
#pragma unroll
        for (int i = 0; i < 8; ++i) w[i] = vr[i];
#pragma unroll
        for (int i = 0; i < 8; ++i) {
#pragma unroll
            for (int e = 0; e < 4; ++e) { const unsigned x = w[i][e]; const int p2 = __builtin_amdgcn_cvt_pk_fp8_f32(bflo(x), bfhi(x), 0, false);
                scr[(8 * i + 2 * e) * 68 + pos] = (unsigned char)(p2 & 0xff); scr[(8 * i + 2 * e + 1) * 68 + pos] = (unsigned char)((p2 >> 8) & 0xff); } }
        LDS_WAIT(); asm volatile("" ::: "memory");
        { const LAS unsigned* rr = (const LAS unsigned*)(scr + F.lane * 68);
          GAS v4u* o = (GAS v4u*)(WSP(unsigned char, WS_VT8) + (size_t)it * 4096 + F.lane * 64);
#pragma unroll
          for (int q = 0; q < 4; ++q) { v4u v; v.x = rr[4 * q]; v.y = rr[4 * q + 1]; v.z = rr[4 * q + 2]; v.w = rr[4 * q + 3]; o[q] = v; } }
        LDS_WAIT(); asm volatile("" ::: "memory");
    }
}

__device__ __forceinline__ void ph_attn(Frame& F, int l, bool last, char* shm) {
    typedef attn_body::bf16 abf;
    const abf* P = (const abf*)WSP(const bf16, WS_P); abf* MIX = attn_body::OUT_FP8 ? (abf*)((unsigned long long)WSP(unsigned char, WS_MIX) << 1) : (abf*)WSP(bf16, WS_MIX);
    float m0; bool fixm;
    { float gq = fabsf(F.in[9][l * 64 + F.lane]), gk = fabsf(F.in[10][l * 64 + F.lane]);
#pragma unroll
      for (int o = 1; o < 64; o <<= 1) { gq = fmaxf(gq, __shfl_xor(gq, o)); gk = fmaxf(gk, __shfl_xor(gk, o)); }
      m0 = __uint_as_float(__builtin_amdgcn_readfirstlane(__float_as_uint(64.0f * C2 * 1.014f * gq * gk))); fixm = m0 <= 60.0f; }
    for (int L = F.vcu; L < 7 * 256; L += F.G) {
        const int i = L >> 8, v = L & 255, x = v >> 5, j = v & 31;
        if (i == 4 || i == 5) {
            const int b = x >> 1, h = (x & 1) * 2 + (i - 4), gr0 = 4 * j, kr0 = gr0 - 4 < 0 ? 0 : (gr0 - 4 > 116 ? 116 : gr0 - 4);
            const size_t row0 = (size_t)b * TPB + CTXL + 256 * j, k0 = (size_t)b * TPB;
            attn_body::attn_unit<8, true, false>(P + row0 * INW + COL_QB + h * 64, P + k0 * INW + COL_KB + h * 64, P + k0 * INW + COL_VB + h * 64, MIX + row0 * DM + MIX_B + h * 64, 16, kr0, gr0, kr0,
                                          F.in[11] + (size_t)(l * 4 + h) * 465, 0.f, shm);
        } else {
            size_t row0, k0; int qc, kc, vc, oc, NT; bool isA = true;
            if (i < 4 && fixm) {
                if (i >= 2) continue;
                const int b = x >> 1, kvh = x & 1, idx = i * 32 + j, h = kvh * 4 + (idx >> 4), qb = idx & 15; const size_t r0 = (size_t)b * TPB + CTXL + 512 * qb, kk0 = (size_t)b * TPB;
                if (ATTN_FP8_QK && ATTN_FP8_PV && m0 <= 17.0f)     attn_body::attn_unit64f8pv<0>(WSP(const unsigned char, WS_Q8) + r0 * 512 + h * 64, WSP(const unsigned char, WS_K8) + kk0 * 128 + kvh * 64, WSP(const unsigned char, WS_VT8) + (size_t)((b * 2 + kvh) * (TPB / 64)) * 4096, MIX + r0 * DM + MIX_A + h * 64, TPB / 64, shm);
                else if (ATTN_FP8_QK) attn_body::attn_unit64f8<0>(WSP(const unsigned char, WS_Q8) + r0 * 512 + h * 64, WSP(const unsigned char, WS_K8) + kk0 * 128 + kvh * 64, P + kk0 * INW + COL_VA + kvh * 64, MIX + r0 * DM + MIX_A + h * 64, TPB / 64, shm);
                else attn_body::attn_unit64<0>(P + r0 * INW + COL_QA + h * 64, P + kk0 * INW + COL_KA + kvh * 64, P + kk0 * INW + COL_VA + kvh * 64, MIX + r0 * DM + MIX_A + h * 64, TPB / 64, shm);
                continue; }
            if (i < 4) { const int b = x >> 1, kvh = x & 1, h = kvh * 4 + i; row0 = (size_t)b * TPB + CTXL + 256 * j; k0 = (size_t)b * TPB; qc = COL_QA + h * 64; kc = COL_KA + kvh * 64; vc = COL_VA + kvh * 64; oc = MIX_A + h * 64; NT = TPB / 64; }
            else { int u = j * 8 + x; if (last || u >= 48) continue;
                if (u < 32) { const int b = u >> 3, h = u & 7; row0 = k0 = (size_t)b * TPB; qc = COL_QA + h * 64; kc = COL_KA + (h >> 2) * 64; vc = COL_VA + (h >> 2) * 64; oc = MIX_A + h * 64; }
                else { isA = false; u -= 32; const int b = u >> 2, h = u & 3; row0 = k0 = (size_t)b * TPB; qc = COL_QB + h * 64; kc = COL_KB + h * 64; vc = COL_VB + h * 64; oc = MIX_B + h * 64; }
                NT = CTXL / 64; }
            if (isA && fixm) attn_body::attn_unit<8, false, true>(P + row0 * INW + qc, P + k0 * INW + kc, P + k0 * INW + vc, MIX + row0 * DM + oc, NT, 0, 0, 0, nullptr, m0, shm);
            else attn_body::attn_unit<8, false, false>(P + row0 * INW + qc, P + k0 * INW + kc, P + k0 * INW + vc, MIX + row0 * DM + oc, NT, 0, 0, 0, nullptr, 0.f, shm);
        }
    }
}

template <int DBG> __device__ __forceinline__ void ph_attn_dbg(Frame& F, float m0, char* shm) {
    typedef attn_body::bf16 abf;
    const abf* P = (const abf*)WSP(const bf16, WS_P); abf* DUM = (abf*)WSP(bf16, WS_H1);
    for (int L = F.vcu; L < 2 * 256; L += F.G) {
        const int i = L >> 8, v = L & 255, x = v >> 5, j = v & 31, b = x >> 1, kvh = x & 1, idx = i * 32 + j, h = kvh * 4 + (idx >> 4), qb = idx & 15;
        const size_t r0 = (size_t)b * TPB + CTXL + 512 * qb, kk0 = (size_t)b * TPB;
        attn_body::attn_unit64<DBG>(P + r0 * INW + COL_QA + h * 64, P + kk0 * INW + COL_KA + kvh * 64, P + kk0 * INW + COL_VA + kvh * 64, DUM + r0 * DM + h * 64, TPB / 64, shm);
    }
}

struct Args { const float* in[22]; float* out; unsigned char* ws; int ph_lo, ph_hi; };
__global__ void __launch_bounds__(NWAVES * 64, 2) mk_fwd(Args args) {
    extern __shared__ __attribute__((aligned(16))) unsigned char lds[];
    asm volatile("s_setreg_imm32_b32 hwreg(HW_REG_MODE, 23, 1), 1");
    Frame F;
    F.lds = (LAS unsigned char*)lds;
    F.MISC = (volatile LAS unsigned*)(F.lds + MISC_OFF);
    F.tid = threadIdx.x; F.lane = F.tid & 63; F.wave = __builtin_amdgcn_readfirstlane(F.tid >> 6);
    F.G = gridDim.x; F.bx = blockIdx.x; { const int bx = blockIdx.x; F.vcu = (F.G % 8 == 0) ? (bx % 8) * (F.G / 8) + bx / 8 : bx; }
    F.ws = args.ws; F.ctl = (gu32*)(args.ws + WS_CTL); F.out = args.out;
#pragma unroll
    for (int i = 0; i < 22; ++i) F.in[i] = args.in[i];
    for (int u = F.tid; u < (LDS_BYTES - LDSCTL_OFF) / 4; u += NWAVES * 64) ((LAS unsigned*)(F.lds + LDSCTL_OFF))[u] = 0u;
    __syncthreads();
    const int lo = args.ph_lo, hi = args.ph_hi;
    const bool multi = (hi - lo) > 1;
    XcdBarrier bar; bar.bar = (unsigned*)(F.ctl + CW_BAR); bar.x = 0; bar.st = nullptr;
    if (multi) bar = xcd_barrier_post((unsigned*)(F.ctl + CW_BAR), F.MISC + 8);
#define IN(k) (lo <= (k) && (k) < hi)
#define PHB() do { int t_ = threadIdx.x; asm volatile("" : "+v"(t_)); F.tid = t_; F.lane = t_ & 63; F.wave = __builtin_amdgcn_readfirstlane(t_ >> 6); int b_ = blockIdx.x, g_ = gridDim.x; asm volatile("" : "+s"(b_), "+s"(g_)); F.bx = b_; F.G = g_; F.vcu = (g_ % 8 == 0) ? (b_ % 8) * (g_ / 8) + b_ / 8 : b_; } while (0)
    unsigned long long tprev_ = 0ull, pacc_ = 0ull; if (PROBE_KIND >= 0) tprev_ = rt();
#define SEAM(k) do { if (IN((k) + 1)) xcd_barrier(bar); if (PROBE_KIND >= 0) { const unsigned long long now_ = rt(); const int kind_ = ((k) == 0) ? 8 : ((k) - 1) % NPL; if (kind_ == PROBE_KIND) pacc_ += now_ - tprev_; tprev_ = now_; } } while (0)

    if (IN(0)) { PHB(); p0_prologue(F); if (REP_P0 > 1) { PHB(); p0_prologue(F); } SEAM(0); }
    for (int l = 0; l < DEPTH; ++l) {
        const int pb = 1 + l * NPL;
        if (IN(pb + LP_NORM1)) { PHB(); ph_norm1(F, l); SEAM(pb + LP_NORM1); }
        if (IN(pb + LP_INPROJ)) {
            PHB(); pg8::Gemm g{WSP(const bf16, WS_HN), WSP(const bf16, WS_WIN) + (size_t)l * INW * DM, NROW, INW, DM}; pg8::StaticOrder S; S.init(NROW, INW, F.G, F.bx, 0, 0, 0, WGM_IN);
            pg8::EpiInProj E{WSP(bf16, WS_P), INW, F.in[9] + l * 64, F.in[10] + l * 64, WSP(const float, WS_ROPE), C2, WSP(unsigned char, WS_Q8), WSP(unsigned char, WS_K8)};
            pg8::gemm_phase<pg8::EpiInProj, pg8::StaticOrder, true, true>(F.lds + RING_OFF, g, S, E); if (REP_INPROJ > 1) { pg8::gemm_phase<pg8::EpiInProj, pg8::StaticOrder, true, true>(F.lds + RING_OFF, g, S, E); }
            PHB(); fill_convert(F, l + 1, 32, FILL_A0, FQ_A);
            SEAM(pb + LP_INPROJ);
        }
        if (IN(pb + LP_VT)) { if (ATTN_FP8_PV) { PHB(); ph_vt8(F); } SEAM(pb + LP_VT); }
        if (IN(pb + LP_MIX)) { PHB(); ph_attn(F, l, l == DEPTH - 1, (char*)lds + RING_OFF); if (REP_ATTN > 1) { PHB(); ph_attn(F, l, l == DEPTH - 1, (char*)lds + RING_OFF); } PHB(); ph_conv(F, l); if (REP_CONV > 1) { PHB(); ph_conv(F, l); }
            if (ATTN_DBG != 0) { __syncthreads(); const unsigned long long t0_ = rt(); PHB(); ph_attn_dbg<ATTN_DBG>(F, 16.0f, (char*)lds + RING_OFF); pacc_ += rt() - t0_; }
            SEAM(pb + LP_MIX); }
        if (IN(pb + LP_OUTPROJ)) {
            PHB(); pg8::Gemm g{WSP(const bf16, WS_MIX), WSP(const bf16, WS_WOUT) + (size_t)l * DM * (attn_body::OUT_FP8 ? DM / 2 : DM), NROW, DM, attn_body::OUT_FP8 ? DM / 2 : DM}; pg8::StaticOrder S; S.init(NROW, DM, F.G, F.bx, 0, l == DEPTH - 1 ? 33 : 0, 1, WGM_OUT);
            pg8::EpiResGate E{WSP(bf16, WS_X), DM, WSP(const float, WS_MODV) + (size_t)l * 5 * 6 * 1024, 2};
            if constexpr (attn_body::OUT_FP8) pg8::gemm_phase<pg8::EpiResGate, pg8::StaticOrder, true, false, 2, 121>(F.lds + RING_OFF, g, S, E);
            else pg8::gemm_phase<pg8::EpiResGate, pg8::StaticOrder, true, true>(F.lds + RING_OFF, g, S, E);
            PHB(); fill_convert(F, l + 1, 16, FILL_B0, FQ_B);
            SEAM(pb + LP_OUTPROJ);
        }
        if (IN(pb + LP_NORM2)) { PHB(); ph_norm2(F, l); if (REP_NORM2 > 1) { PHB(); ph_norm2(F, l); } SEAM(pb + LP_NORM2); }
        if (IN(pb + LP_TOPK)) { PHB(); ph_topk(F); if (REP_TOPK > 1) { PHB(); ph_topk(F); } PHB(); build_router_tab(F, l + 1, 236); __syncthreads(); fill_convert(F, l + 1, 128, FILL_C0, FQ_C); fill_rest(F, l + 1); SEAM(pb + LP_TOPK); }
        if (IN(pb + LP_G1)) {
            PHB(); pg8::Gemm g{WSP(const bf16, WS_HN), WSP(const bf16, WS_WGU) + (size_t)l * NEXP * 4096 * (MOE_UP_FP8 ? DM / 2 : DM), NEXP * ESLOTS, 4096, MOE_UP_FP8 ? DM / 2 : DM}; pg8::GatherOrder S;
            S.init(NEXP * ESLOTS, 4096, F.G, F.bx, ETILES, l == DEPTH - 1 ? ETILES : 0, 0, WGM_G1);
            S.offtab = (const LAS unsigned*)(F.lds + GTAB_OFF);
            { LAS unsigned* tab = (LAS unsigned*)(F.lds + GTAB_OFF); pg8::Unit u; const int* idx = WSP(const int, WS_IDX);
              for (int i = 0; i < GTAB_UNITS && S.next(i, u); ++i) if (F.tid < 256) tab[i * 256 + F.tid] = (unsigned)idx[(size_t)u.pm * 256 + F.tid] * (unsigned)(MOE_UP_FP8 ? DM : DM * 2);
              __syncthreads(); }
            pg8::EpiSwiGLUT<MOE_DOWN_FP8> E{WSP(bf16, WS_H1), EDIM};
            if constexpr (MOE_UP_FP8) pg8::gemm_phase<pg8::EpiSwiGLUT<MOE_DOWN_FP8>, pg8::GatherOrder, true, false, 2, 121>(F.lds + RING_OFF, g, S, E);
            else pg8::gemm_phase<pg8::EpiSwiGLUT<MOE_DOWN_FP8>, pg8::GatherOrder, true, true>(F.lds + RING_OFF, g, S, E);
            SEAM(pb + LP_G1);
        }
        if (IN(pb + LP_G2)) {
            PHB(); pg8::StaticOrder S; S.init(NEXP * ESLOTS, DM, F.G, F.bx, ETILES, l == DEPTH - 1 ? ETILES : 0, 0, WGM_G2);
            pg8::EpiBf16<0> E{WSP(bf16, WS_Y), DM, nullptr, 0, 0, 1.f};
            if (MOE_DOWN_FP8) { pg8::Gemm g{WSP(const bf16, WS_H1), WSP(const bf16, WS_WD) + (size_t)l * NEXP * DM * (EDIM / 2), NEXP * ESLOTS, DM, EDIM / 2};
                pg8::gemm_phase<pg8::EpiBf16<0>, pg8::StaticOrder, true, false, 2, 121>(F.lds + RING_OFF, g, S, E); }
            else { pg8::Gemm g{WSP(const bf16, WS_H1), WSP(const bf16, WS_WD) + (size_t)l * NEXP * DM * EDIM, NEXP * ESLOTS, DM, EDIM};
                pg8::gemm_phase<pg8::EpiBf16<0>, pg8::StaticOrder, true, true>(F.lds + RING_OFF, g, S, E); }
            PHB(); fill_convert(F, l + 1, 64, FILL_D0, FQ_D);
            SEAM(pb + LP_G2);
        }
    }
    if (IN(PH_FINAL)) { PHB(); ph_final(F); }
    if (PROBE_KIND >= 0 || ATTN_DBG != 0) { if (PROBE_KIND == 9) pacc_ += rt() - tprev_; if (blockIdx.x == 0) { const unsigned long long tend_ = rt() + (unsigned long long)PROBE_MULT * pacc_; while (rt() < tend_) __builtin_amdgcn_s_sleep(20); } }
#undef IN
#undef SEAM
}

extern "C" void kernel_launch(void* const* d_in, const int* in_sizes, int n_in, void* d_out, int out_size, void* d_ws, size_t ws_size, hipStream_t stream) {
    static int grid = 0;
    if (grid == 0) {
        if (n_in != 22 || in_sizes[0] != NBATCH * SEQL * DM || out_size != NBATCH * SEQL * DM || ws_size < WS_END) {
            fprintf(stderr, "kernel_launch: unexpected shapes (n_in %d, in0 %d, out %d, ws %zu; need ws >= %zu); nothing launched\n", n_in, n_in > 0 ? in_sizes[0] : -1, out_size, ws_size, (size_t)WS_END); grid = -1; return; }
        int dev = 0, cus = 0, per_cu = 0;
        if (hipGetDevice(&dev) != hipSuccess || hipDeviceGetAttribute(&cus, hipDeviceAttributeMultiprocessorCount, dev) != hipSuccess) { grid = -1; return; }
        if (hipFuncSetAttribute((const void*)mk_fwd, hipFuncAttributeMaxDynamicSharedMemorySize, LDS_BYTES) != hipSuccess) { fprintf(stderr, "kernel_launch: hipFuncSetAttribute failed\n"); grid = -1; return; }
        if (hipOccupancyMaxActiveBlocksPerMultiprocessor(&per_cu, (const void*)mk_fwd, NWAVES * 64, LDS_BYTES) != hipSuccess || per_cu < 1)
            fprintf(stderr, "kernel_launch: note: occupancy query reports %d workgroups per CU\n", per_cu);
        (void)hipGetLastError();
        if (cus != 256) { fprintf(stderr, "kernel_launch: built for a 256-CU device (one workgroup per CU, static unit deals); found %d CUs; nothing launched\n", cus); grid = -1; return; }
        grid = cus;
    }
    if (grid < 0) return;
    (void)hipMemsetAsync((char*)d_ws + WS_CTL, 0, CTL_ZERO_BYTES, stream);
    Args a{};
    for (int i = 0; i < 22; ++i) a.in[i] = (const float*)d_in[i];
    a.out = (float*)d_out; a.ws = (unsigned char*)d_ws;
    unsigned char* ws = (unsigned char*)d_ws;
#ifndef MK_PER_PHASE
    a.ph_lo = 0; a.ph_hi = NPH;
    hipLaunchKernelGGL(mk_fwd, dim3(grid), dim3(NWAVES * 64), LDS_BYTES, stream, a);
#else
    for (int ph = 0; ph < NPH; ++ph) { a.ph_lo = ph; a.ph_hi = ph + 1; hipLaunchKernelGGL(mk_fwd, dim3(grid), dim3(NWAVES * 64), LDS_BYTES, stream, a); }
#endif
}
```
